# Optimizing an MI355X kernel written in HIP

```python
import math
import jax, jax.numpy as jnp
from jax import lax
import numpy as np

D_MODEL = 2048
BATCH = 1
SEQ = 16384
DEPTH = 1

CHUNK = 128
GM_GROUP_DIM = 128
GM_WIDTH = D_MODEL // 2
GM_GROUPS = GM_WIDTH // GM_GROUP_DIM
RET_HEADS = 8
RET_QK_WIDTH = D_MODEL // 2
RET_V_WIDTH = D_MODEL
RET_QK_DIM = RET_QK_WIDTH // RET_HEADS
RET_V_DIM = RET_V_WIDTH // RET_HEADS
N_EXPERTS = 32
TOP_K = 4
D_FF = D_MODEL
SWIGLU_LIMIT = 7.0
SWIGLU_ALPHA = 1.702
MOE_BLOCK = 128
ROPE_BASE = 10000.0
EPS = 1e-6
IN_SPLITS = (GM_WIDTH, GM_WIDTH, RET_QK_WIDTH, RET_QK_WIDTH, RET_V_WIDTH, RET_V_WIDTH, D_MODEL, D_MODEL)
IN_WIDTH = sum(IN_SPLITS)

kernel_name = "hybrid_gmlp_retention_moe_block"


def rms_norm(x, g):
    xf = x.astype(jnp.float32)
    y = xf * lax.rsqrt(jnp.mean(xf * xf, axis=-1, keepdims=True) + EPS)
    return (y * g.astype(jnp.float32)).astype(x.dtype)


def rope(t, cos, sin):
    half = t.shape[-1] // 2
    t1, t2 = t[..., :half], t[..., half:]
    c = cos[None, :, None, :]
    s = sin[None, :, None, :]
    return jnp.concatenate([t1 * c - t2 * s, t2 * c + t1 * s], axis=-1)


def spatial_gating(u, v, ln_g, ln_b, ws, bs):
    B, S, W = u.shape
    N = S // CHUNK
    vf = v.astype(jnp.float32)
    mu = jnp.mean(vf, axis=-1, keepdims=True)
    var = jnp.mean(jnp.square(vf - mu), axis=-1, keepdims=True)
    vn = (vf - mu) * lax.rsqrt(var + EPS) * ln_g.astype(jnp.float32) + ln_b.astype(jnp.float32)
    vn = vn.reshape(B, N, CHUNK, GM_GROUPS, GM_GROUP_DIM)
    causal = jnp.tril(jnp.ones((CHUNK, CHUNK), dtype=bool))
    w = jnp.where(causal[None], ws.astype(jnp.float32), 0.0)
    mixed = jnp.einsum('gts,bnsgd->bntgd', w, vn) + bs.astype(jnp.float32).T[None, None, :, :, None]
    return u * mixed.reshape(B, S, W).astype(u.dtype)


def retention(q, k, v):
    B, S, _ = q.shape
    N = S // CHUNK
    H, dk, dv = RET_HEADS, RET_QK_DIM, RET_V_DIM
    pos = jnp.arange(S, dtype=jnp.float32)
    inv_freq = ROPE_BASE ** (-jnp.arange(0, dk, 2, dtype=jnp.float32) / dk)
    ang = pos[:, None] * inv_freq[None, :]
    cos, sin = jnp.cos(ang), jnp.sin(ang)
    qh = rope(q.astype(jnp.float32).reshape(B, S, H, dk), cos, sin)
    kh = rope(k.astype(jnp.float32).reshape(B, S, H, dk), cos, sin) * (dk ** -0.5)
    vh = v.astype(jnp.float32).reshape(B, S, H, dv)

    log_gamma = jnp.log1p(-jnp.exp2(-5.0 - jnp.arange(H, dtype=jnp.float32)))
    idx = jnp.arange(CHUNK, dtype=jnp.float32)
    diff = idx[:, None] - idx[None, :]
    decay_in = jnp.where(diff[None] >= 0, jnp.exp(log_gamma[:, None, None] * jnp.maximum(diff, 0.0)[None]), 0.0)
    xi = jnp.exp(log_gamma[None, :] * (idx[:, None] + 1.0))
    zeta = jnp.exp(log_gamma[None, :] * (CHUNK - 1.0 - idx[:, None]))
    chunk_decay = jnp.exp(log_gamma * CHUNK)

    def to_chunks(t):
        return jnp.moveaxis(t.reshape(B, N, CHUNK, H, t.shape[-1]), 1, 0)

    def step(state, qkv):
        qc, kc, vc = qkv
        scores = jnp.einsum('bthd,bshd->bhts', qc, kc) * decay_in[None]
        o = jnp.einsum('bhts,bshe->bthe', scores, vc) \
            + jnp.einsum('bthd,bhde->bthe', qc, state) * xi[None, :, :, None]
        state = state * chunk_decay[None, :, None, None] \
            + jnp.einsum('bshd,bshe->bhde', kc * zeta[None, :, :, None], vc)
        return state, o

    state0 = jnp.zeros((B, H, dk, dv), jnp.float32)
    _, o = lax.scan(step, state0, (to_chunks(qh), to_chunks(kh), to_chunks(vh)))
    o = jnp.moveaxis(o, 0, 1).reshape(B, S, H, dv)
    mu = jnp.mean(o, axis=-1, keepdims=True)
    var = jnp.mean(jnp.square(o - mu), axis=-1, keepdims=True)
    o = (o - mu) * lax.rsqrt(var + EPS)
    return o.reshape(B, S, H * dv)


def moe_ffn(h, router_w, router_b, w_gate_up, b_gate_up, w_down, b_down):
    B, S, D = h.shape
    T = B * S
    ht = h.reshape(T, D)
    logits = (ht @ router_w + router_b).astype(jnp.float32)
    top_v, top_i = lax.top_k(logits, TOP_K)
    gate_w = jax.nn.softmax(top_v, axis=-1)

    flat_e = top_i.reshape(-1).astype(jnp.int32)
    flat_tok = jnp.repeat(jnp.arange(T, dtype=jnp.int32), TOP_K)
    flat_w = gate_w.reshape(-1)
    order = jnp.argsort(flat_e)
    se, stok, sw = flat_e[order], flat_tok[order], flat_w[order]
    counts = jnp.zeros((N_EXPERTS,), jnp.int32).at[flat_e].add(1)
    padded = (counts + MOE_BLOCK - 1) // MOE_BLOCK * MOE_BLOCK
    pad_end = jnp.cumsum(padded)
    pad_start = pad_end - padded
    sort_start = jnp.cumsum(counts) - counts
    rank = jnp.arange(T * TOP_K, dtype=jnp.int32) - sort_start[se]
    dest = pad_start[se] + rank
    n_blocks = (T * TOP_K + MOE_BLOCK - 1) // MOE_BLOCK + N_EXPERTS
    rows = n_blocks * MOE_BLOCK
    row_tok = jnp.full((rows,), T, jnp.int32).at[dest].set(stok)
    row_w = jnp.zeros((rows,), jnp.float32).at[dest].set(sw)
    block_start = jnp.arange(n_blocks, dtype=jnp.int32) * MOE_BLOCK
    block_e = jnp.minimum(jnp.searchsorted(pad_end, block_start, side='right'), N_EXPERTS - 1).astype(jnp.int32)
    h_pad = jnp.concatenate([ht, jnp.zeros((1, D), ht.dtype)], axis=0)

    def block_step(acc, blk):
        tok, w, e = blk
        xb = h_pad[tok]
        gu = xb @ w_gate_up[e] + b_gate_up[e]
        gate, up = gu[:, :D_FF], gu[:, D_FF:]
        gate = jnp.minimum(gate, SWIGLU_LIMIT)
        up = jnp.clip(up, -SWIGLU_LIMIT, SWIGLU_LIMIT)
        glu = gate * jax.nn.sigmoid(gate * SWIGLU_ALPHA)
        yb = ((up + 1.0) * glu) @ w_down[e] + b_down[e]
        acc = acc.at[tok].add(yb.astype(jnp.float32) * w[:, None])
        return acc, None

    acc0 = jnp.zeros((T + 1, D), jnp.float32)
    acc, _ = lax.scan(block_step, acc0,
                      (row_tok.reshape(n_blocks, MOE_BLOCK), row_w.reshape(n_blocks, MOE_BLOCK), block_e))
    return acc[:T].astype(h.dtype).reshape(B, S, D)


def setup_inputs(seed: int = 0) -> dict:
    key = jax.random.key(seed)
    ks = jax.random.split(key, 20)
    f32 = jnp.float32
    L, D = DEPTH, D_MODEL

    def nrm(k, shape, scale):
        return jax.random.normal(k, shape, f32) * scale

    return {
        "x": jax.random.normal(ks[0], (BATCH, SEQ, D), f32),
        "norm1_g": 1.0 + nrm(ks[1], (L, D), 0.01),
        "w_in": nrm(ks[2], (L, D, IN_WIDTH), D ** -0.5),
        "gm_ln_g": 1.0 + nrm(ks[3], (L, GM_WIDTH), 0.01),
        "gm_ln_b": nrm(ks[4], (L, GM_WIDTH), 0.01),
        "gm_ws": nrm(ks[5], (L, GM_GROUPS, CHUNK, CHUNK), CHUNK ** -0.5),
        "gm_b": 1.0 + nrm(ks[6], (L, GM_GROUPS, CHUNK), 0.01),
        "w_proj_a": nrm(ks[7], (L, GM_WIDTH, D), GM_WIDTH ** -0.5),
        "w_proj_r": nrm(ks[8], (L, RET_V_WIDTH, D), RET_V_WIDTH ** -0.5),
        "w_out": nrm(ks[9], (L, D, D), D ** -0.5),
        "norm2_g": 1.0 + nrm(ks[10], (L, D), 0.01),
        "router_w": nrm(ks[11], (L, D, N_EXPERTS), D ** -0.5),
        "router_b": nrm(ks[12], (L, N_EXPERTS), 0.01),
        "w_gate_up": nrm(ks[13], (L, N_EXPERTS, D, 2 * D_FF), D ** -0.5),
        "b_gate_up": nrm(ks[14], (L, N_EXPERTS, 2 * D_FF), 0.01),
        "w_down": nrm(ks[15], (L, N_EXPERTS, D_FF, D), D_FF ** -0.5),
        "b_down": nrm(ks[16], (L, N_EXPERTS, D), 0.01),
        "final_norm_g": 1.0 + nrm(ks[17], (D,), 0.01),
    }


def reference(x, norm1_g, w_in, gm_ln_g, gm_ln_b, gm_ws, gm_b, w_proj_a, w_proj_r, w_out,
              norm2_g, router_w, router_b, w_gate_up, b_gate_up, w_down, b_down, final_norm_g):
    split_pts = list(np.cumsum(IN_SPLITS)[:-1])
    for l in range(DEPTH):
        h = rms_norm(x, norm1_g[l])
        proj = h @ w_in[l]
        a_u, a_v, r_q, r_k, r_v, r_g, gate_a, gate_r = jnp.split(proj, split_pts, axis=-1)
        a_u = jax.nn.gelu(a_u, approximate=False)
        a_v = jax.nn.gelu(a_v, approximate=False)
        y_a = spatial_gating(a_u, a_v, gm_ln_g[l], gm_ln_b[l], gm_ws[l], gm_b[l]) @ w_proj_a[l]
        ret = retention(r_q, r_k, r_v)
        y_r = (ret * jax.nn.silu(r_g.astype(jnp.float32))).astype(x.dtype) @ w_proj_r[l]
        merged = jax.nn.sigmoid(gate_a) * y_a + jax.nn.sigmoid(gate_r) * y_r
        x = x + merged @ w_out[l]
        h2 = rms_norm(x, norm2_g[l])
        x = x + moe_ffn(h2, router_w[l], router_b[l], w_gate_up[l], b_gate_up[l], w_down[l], b_down[l])
    return rms_norm(x, final_norm_g)
```

```cpp
#include <hip/hip_runtime.h>
#include <cstdio>
#include <cstdint>

#ifndef MK_N_LAUNCHES
#define MK_N_LAUNCHES 1
#endif
#ifndef MK_PHASES
#define MK_PHASES 0xFFFF
#endif
#ifndef MK_NCONV
#define MK_NCONV 64
#endif
#ifndef MK_CONV_IN_P0
#define MK_CONV_IN_P0 0
#endif
#ifndef MK_RSYNC
#define MK_RSYNC 0
#endif
#ifndef MK_NSCAN
#define MK_NSCAN 0
#endif
#ifndef MK_HM
#define MK_HM 1
#endif
#ifndef MK_HM_TEST
#define MK_HM_TEST 0
#endif
#ifndef MK_DUP
#define MK_DUP 0
#endif

#define GAS __attribute__((address_space(1)))
#define LAS __attribute__((address_space(3)))
typedef unsigned short bf16_t;
typedef short bf16x8 __attribute__((ext_vector_type(8)));
typedef short s16x4 __attribute__((ext_vector_type(4)));
typedef float f32x4 __attribute__((ext_vector_type(4)));
typedef float f32x2 __attribute__((ext_vector_type(2)));
typedef float f32x16 __attribute__((ext_vector_type(16)));
typedef unsigned u32x4 __attribute__((ext_vector_type(4)));
typedef unsigned u32x2 __attribute__((ext_vector_type(2)));

constexpr int T = 16384, D = 2048, GW = 1024, QKW = 1024, INW = 12288, NE = 32, DFF = 2048;
constexpr int NCHUNK = 128, NH = 8;
constexpr float EPS = 1e-6f;
constexpr int NWAVES = 8, NTHREADS = 512;
constexpr int ACT_ROWS = 73728;
constexpr float W8_SCALE = 1024.0f, H8_SCALE = 16.0f, A8_SCALE = 4.0f, Y8_SCALE = 32.0f;

constexpr size_t MiB = 1u << 20;
constexpr size_t WS_CTL = 0, CTL_ZERO_BYTES = 1 * MiB;
constexpr size_t WS_WIN = 2 * MiB;
constexpr size_t WS_WPA = WS_WIN + 48 * MiB;
constexpr size_t WS_WPR = WS_WPA + 4 * MiB;
constexpr size_t WS_WOUT = WS_WPR + 8 * MiB;
constexpr size_t WS_WGU = WS_WOUT + 8 * MiB;
constexpr size_t WS_WDN = WS_WGU + 512 * MiB;
constexpr size_t WS_H = WS_WDN + 256 * MiB;
constexpr size_t WS_U = WS_H + 64 * MiB;
constexpr size_t WS_V = WS_U + 32 * MiB;
constexpr size_t WS_Q = WS_V + 32 * MiB;
constexpr size_t WS_K = WS_Q + 32 * MiB;
constexpr size_t WS_RV = WS_K + 32 * MiB;
constexpr size_t WS_RG = WS_RV + 64 * MiB;
constexpr size_t WS_GA = WS_RG + 64 * MiB;
constexpr size_t WS_GR = WS_GA + 64 * MiB;
constexpr size_t WS_VSTAT = WS_GR + 64 * MiB;
constexpr size_t WS_ROPEC = WS_VSTAT + 2 * MiB;
constexpr size_t WS_ROPES = WS_ROPEC + 4 * MiB;
constexpr size_t WS_SG = WS_ROPES + 4 * MiB;
constexpr size_t WS_KV = WS_SG + 32 * MiB;
constexpr size_t WS_ST = WS_KV + 128 * MiB;
constexpr size_t WS_RO = WS_ST + 64 * MiB;
constexpr size_t WS_MRG = WS_RO + 64 * MiB;
constexpr size_t WS_X1 = WS_MRG + 64 * MiB;
constexpr size_t WS_SS = WS_X1 + 128 * MiB;
constexpr size_t WS_TOKE = WS_SS + 2 * MiB;
constexpr size_t WS_TOKR = WS_TOKE + 1 * MiB;
constexpr size_t WS_TOKW = WS_TOKR + 1 * MiB;
constexpr size_t WS_ROWTOK = WS_TOKW + 1 * MiB;
constexpr size_t WS_ACT = WS_ROWTOK + 2 * MiB;
constexpr size_t WS_Y = WS_ACT + 288 * MiB;
constexpr size_t WS_END = WS_Y + 288 * MiB;
constexpr int CW_TMO = 0;
constexpr int CW_BAR = 4096;
constexpr int CW_CNT = 8192;
constexpr int CW_DBG = 12288;

constexpr int RING_BYTES = 131072;
constexpr int AUX_OFF = RING_BYTES;
constexpr int MISC_OFF = AUX_OFF + 12288;
constexpr int LDS_BYTES = 147456;

typedef __bf16 bf16x2_t __attribute__((ext_vector_type(2)));
__device__ __forceinline__ unsigned cvt_pk_bf16(float lo, float hi) { f32x2 v = {lo, hi}; bf16x2_t b = __builtin_convertvector(v, bf16x2_t); return __builtin_bit_cast(unsigned, b); }
__device__ __forceinline__ unsigned pk4_fp8(float a, float b, float c, float d) { int w = 0; w = __builtin_amdgcn_cvt_pk_fp8_f32(a, b, w, false); w = __builtin_amdgcn_cvt_pk_fp8_f32(c, d, w, true); return (unsigned)w; }
__device__ __forceinline__ float bf_lo(unsigned w) { return __uint_as_float(w << 16); }
__device__ __forceinline__ float bf_hi(unsigned w) { return __uint_as_float(w & 0xffff0000u); }
__device__ __forceinline__ float bf2f(bf16_t b) { return __uint_as_float(((unsigned)b) << 16); }
__device__ __forceinline__ float wave_sum(float v) {
#pragma unroll
    for (int o = 1; o < 64; o <<= 1) v += __shfl_xor(v, o);
    return v;
}
__device__ __forceinline__ float sigmoid_f(float x) { return __builtin_amdgcn_rcpf(1.0f + __expf(-x)); }
__device__ __forceinline__ f32x2 gelu_pk(f32x2 v) {
    const f32x2 av = __builtin_elementwise_abs(v), d = av * 0.2316418882f + 1.0f;
    f32x2 t; t.x = __builtin_amdgcn_rcpf(d.x); t.y = __builtin_amdgcn_rcpf(d.y);
    f32x2 q = t * 0.5307027145f + (-0.7265760135f); q = q * t + 0.7107068705f; q = q * t + (-0.142248368f); q = q * t + 0.127414796f; q = q * t;
    const f32x2 s = (v * v) * (-0.72134752044f);
    f32x2 e; e.x = __builtin_amdgcn_exp2f(s.x); e.y = __builtin_amdgcn_exp2f(s.y);
    const f32x2 m = v * (q * e), r = v - m;
    f32x2 o; o.x = v.x < 0.f ? m.x : r.x; o.y = v.y < 0.f ? m.y : r.y; return o;
}
__device__ __forceinline__ f32x4 gelu4(f32x4 v) { f32x2 a = gelu_pk((f32x2){v[0], v[1]}), b = gelu_pk((f32x2){v[2], v[3]}); return (f32x4){a.x, a.y, b.x, b.y}; }

#define XB_TMO      128
#define XB_XCNT(j)  (256  + 64 * (j))
#define XB_XSUB(j)  (1280 + 64 * (j))
#define XB_XGEN(j)  (2304 + 64 * (j))
#define XB_TOP      3328
#define XB_TOPGEN   3392
#define XCD_BAR_WORDS 3456
#define XB_SPIN_CAP (1u << 18)
__device__ __forceinline__ unsigned xb_ld(unsigned* p)              { return __hip_atomic_load(p, __ATOMIC_RELAXED, __HIP_MEMORY_SCOPE_AGENT); }
__device__ __forceinline__ unsigned xb_add(unsigned* p, unsigned v) { return __hip_atomic_fetch_add(p, v, __ATOMIC_RELAXED, __HIP_MEMORY_SCOPE_AGENT); }
__device__ __forceinline__ unsigned xb_xcc_id() { return (unsigned)__builtin_amdgcn_s_getreg((3 << 11) | 20) & 0xFu; }
#define XB_SPIN(cond, bar) do { unsigned _sp = 0; while (cond) { __builtin_amdgcn_s_sleep(1); \
    if ((++_sp & 255u) == 0u) { if (xb_ld(&(bar)[XB_TMO])) break; if (_sp > XB_SPIN_CAP) { atomicAdd(&(bar)[XB_TMO], 1u); break; } } } } while (0)
struct XcdBarrier { unsigned* bar; unsigned x; volatile LAS unsigned* st; };
__device__ __forceinline__ XcdBarrier xcd_barrier_post(unsigned* bar, volatile LAS unsigned* st) {
    XcdBarrier b; b.bar = bar; b.x = xb_xcc_id(); b.st = st;
    if (threadIdx.x == 0) (void)xb_add(&bar[XB_XCNT(b.x)], 1u);
    return b;
}
__device__ __forceinline__ void xcd_barrier_complete(unsigned* bar, unsigned x, unsigned& nloc, unsigned& nx) {
    const unsigned G = gridDim.x * gridDim.y * gridDim.z;
    unsigned sum, cnt, mine, sp = 0u;
    for (;;) {
        sum = 0u; cnt = 0u; mine = 0u;
#pragma unroll
        for (unsigned j = 0; j < 16; ++j) { const unsigned c = xb_ld(&bar[XB_XCNT(j)]); sum += c; cnt += (c > 0u) ? 1u : 0u; mine = (j == x) ? c : mine; }
        if (sum == G) break;
        __builtin_amdgcn_s_sleep(1);
        if ((++sp & 255u) == 0u) { if (xb_ld(&bar[XB_TMO])) break; if (sp > XB_SPIN_CAP) { atomicAdd(&bar[XB_TMO], 1u); break; } }
    }
    nloc = mine > 0u ? mine : 1u; nx = cnt > 0u ? cnt : 1u;
}
__device__ __forceinline__ void xcd_barrier(const XcdBarrier& b) {
    asm volatile("s_waitcnt vmcnt(0)" ::: "memory");
    __syncthreads();
    if (threadIdx.x == 0) {
        unsigned* bar = b.bar;
        __builtin_amdgcn_s_waitcnt(0);
        unsigned nloc = b.st[0], nx = b.st[1];
        if (nloc == 0u) { xcd_barrier_complete(bar, b.x, nloc, nx); b.st[0] = nloc; b.st[1] = nx; }
        const unsigned old = xb_add(&bar[XB_XSUB(b.x)], 1u);
        const unsigned gen = old / nloc;
        if (old + 1u == (gen + 1u) * nloc) {
            __builtin_amdgcn_fence(__ATOMIC_RELEASE, "agent");
            asm volatile("s_waitcnt vmcnt(0)" ::: "memory");
            const unsigned og = xb_add(&bar[XB_TOP], 1u);
            const unsigned tg = og / nx;
            if (og + 1u == (tg + 1u) * nx) xb_add(&bar[XB_TOPGEN], 1u);
            else XB_SPIN(xb_ld(&bar[XB_TOPGEN]) == tg, bar);
            __builtin_amdgcn_fence(__ATOMIC_ACQUIRE, "agent");
            xb_add(&bar[XB_XGEN(b.x)], 1u);
            asm volatile("s_waitcnt vmcnt(0)" ::: "memory");
        } else {
            XB_SPIN(xb_ld(&bar[XB_XGEN(b.x)]) == gen, bar);
            __builtin_amdgcn_fence(__ATOMIC_ACQUIRE, "agent");
            asm volatile("s_waitcnt vmcnt(0)" ::: "memory");
        }
    }
    __syncthreads();
}

namespace pg8 {
constexpr int BM = 256, BK = 64, HALF = 128, HTB = HALF * BK * 2, STAGE_BYTES = 8 * HTB, NXCD = 8, WGM = 4;
__host__ __device__ __forceinline__ int lds_byte(int r, int c) { const int st = (r >> 4) * 2 + (c >> 5), rr = r & 15, cc = c & 31, ob = rr * 64 + cc * 2; return st * 1024 + (ob ^ (((ob >> 9) & 1) << 5)); }
__host__ __device__ __forceinline__ void stage_rc(int b, int& R, int& C) { const int st = b / 1024, sb = b % 1024, swz = sb ^ (((sb >> 9) & 1) << 5); R = (st >> 1) * 16 + swz / 64; C = (st & 1) * 32 + (swz % 64) / 2; }
__host__ __device__ __forceinline__ int perm32(int rho) { const int n = rho >> 4, i = rho & 15; return 8 * (i >> 2) + 4 * n + (i & 3); }

struct Unit { int pm, pn, e, mt, hx; };

struct DenseSched {
    const bf16_t* A; int lda; const bf16_t* Bt; int K; int nM, nN, nwg, G, c;
    static constexpr bool kGather = false;
    __device__ __forceinline__ void init(const bf16_t* A_, int lda_, const bf16_t* Bt_, int K_, int M, int N, int G_, int c_) { A = A_; lda = lda_; Bt = Bt_; K = K_; nM = M / BM; nN = N / BM; nwg = nM * nN; G = G_; c = c_; }
    __device__ __forceinline__ bool next(int i, Unit& u) const {
        const long L = (long)i * G + c; if (L >= nwg) return false;
        int wgid = (int)L; { const int q = nwg / NXCD, r = nwg % NXCD, xcd = wgid % NXCD, off = wgid / NXCD; wgid = (xcd < r ? xcd * (q + 1) : r * (q + 1) + (xcd - r) * q) + off; }
        const int nig = WGM * nN, gid = wgid / nig, fm = gid * WGM, gsz = (nM - fm) < WGM ? (nM - fm) : WGM;
        u.pm = fm + ((wgid % nig) % gsz); u.pn = (wgid % nig) / gsz; u.e = 0; u.mt = u.pm; u.hx = 0; return true;
    }
    __device__ __forceinline__ const char* a_base(const Unit& u) const { return (const char*)A + (size_t)u.pm * BM * lda * 2; }
    __device__ __forceinline__ const char* b_base(const Unit& u) const { return (const char*)Bt + (size_t)u.pn * BM * K * 2; }
    __device__ __forceinline__ void a_offs(const Unit&, const int (&R)[2], const int (&C)[2], unsigned (&off)[2][2]) const {
#pragma unroll
        for (int h = 0; h < 2; ++h)
#pragma unroll
            for (int i = 0; i < 2; ++i) off[h][i] = (unsigned)((h * HALF + R[i]) * lda + C[i]) * 2u;
    }
};
template <bool GATHER, int MODE = 0> struct MoeSched {
    const bf16_t* A; int lda; const bf16_t* Bt; int K; int NB  ; int nN; const LAS int* tstart  ; const LAS int* tall  ; const LAS int* cnt  ; const int* rowtok; LAS unsigned char* aux  ;
    int nwg, G, c; mutable int ecur;
    static constexpr bool kGather = GATHER;
    __device__ __forceinline__ bool next(int i, Unit& u) const {
        const long L = (long)i * G + c; if (L >= nwg) return false;
        int wgid = (int)L; { const int q = nwg / NXCD, r = nwg % NXCD, xcd = wgid % NXCD, off = wgid / NXCD; wgid = (xcd < r ? xcd * (q + 1) : r * (q + 1) + (xcd - r) * q) + off; }
        int e = ecur;
#pragma unroll 1
        while (e < NE - 1 && wgid >= __builtin_amdgcn_readfirstlane(tstart[e + 1]) * nN) ++e;
        ecur = e;
        const int t0 = __builtin_amdgcn_readfirstlane(tstart[e]), t1 = __builtin_amdgcn_readfirstlane(tstart[e + 1]);
        const int local = wgid - t0 * nN, tiles = t1 - t0, idx = local % tiles;
        const int a0 = __builtin_amdgcn_readfirstlane(tall[e]), a1 = __builtin_amdgcn_readfirstlane(tall[e + 1]);
        u.pn = local / tiles; u.e = e;
        if (MODE == 0) { u.mt = idx; u.hx = 0; } else if (MODE == 1) { u.mt = a1 - a0 - 1; u.hx = 0; } else { u.mt = idx >> 1; u.hx = idx & 1; }
        u.pm = a0 + u.mt; return true;
    }
    __device__ __forceinline__ const char* a_base(const Unit& u) const { return GATHER ? (const char*)A : (const char*)A + ((size_t)u.pm * BM + (size_t)u.hx * HALF) * lda * 2; }
    __device__ __forceinline__ const char* b_base(const Unit& u) const { return (const char*)Bt + ((size_t)u.e * NB + (size_t)u.pn * BM) * K * 2; }
    __device__ __forceinline__ void a_tokptrs(const Unit& u, const int (&R)[2], const int* (&gp)[4]) const {
        const int ce = __builtin_amdgcn_readfirstlane(cnt[u.e]);
#pragma unroll
        for (int h = 0; h < 2; ++h)
#pragma unroll
            for (int i = 0; i < 2; ++i) { const int g = u.mt * BM + u.hx * HALF + h * HALF + R[i]; gp[2 * h + i] = rowtok + (size_t)u.e * T + (g < ce ? g : 0); }
    }
    __device__ __forceinline__ void a_offs(const Unit& u, const int (&R)[2], const int (&C)[2], unsigned (&off)[2][2]) const {
        if constexpr (GATHER) {
            const int ce = __builtin_amdgcn_readfirstlane(cnt[u.e]);
#pragma unroll
            for (int h = 0; h < 2; ++h)
#pragma unroll
                for (int i = 0; i < 2; ++i) { const int g = u.mt * BM + u.hx * HALF + h * HALF + R[i]; const int tok = rowtok[u.e * T + (g < ce ? g : 0)] >> 2; off[h][i] = (unsigned)(tok * lda + C[i]) * 2u; }
        } else {
#pragma unroll
            for (int h = 0; h < 2; ++h)
#pragma unroll
                for (int i = 0; i < 2; ++i) off[h][i] = (unsigned)((h * HALF + R[i]) * lda + C[i]) * 2u;
        }
    }
};

__device__ __forceinline__ void glds16(const char* sbase, unsigned voff, unsigned lds_dst) {
    unsigned keep;
    asm volatile("s_mov_b32 %0, m0\n\ts_mov_b32 m0, %3\n\ts_nop 0\n\tglobal_load_lds_dwordx4 %1, %2\n\ts_mov_b32 m0, %0" : "=&s"(keep) : "v"(voff), "s"(sbase), "s"(lds_dst) : "memory");
}
typedef int v8i32 __attribute__((ext_vector_type(8)));
typedef int v4i32 __attribute__((ext_vector_type(4)));
__device__ __forceinline__ v8i32 cat8(bf16x8 a, bf16x8 b) { return __builtin_shufflevector(__builtin_bit_cast(v4i32, a), __builtin_bit_cast(v4i32, b), 0, 1, 2, 3, 4, 5, 6, 7); }
template <int FP8, class Epi, class Sched, int SCW = 127, int SCA = 127, bool RSYNC = false, bool HM = false>
__device__ __forceinline__ void gemm_phase(LAS unsigned char* lds, const Sched& S, const Epi& E, const XcdBarrier* rbar = nullptr) {
    int sclw = SCW * 0x01010101, scla = SCA * 0x01010101; asm volatile("" : "+v"(sclw), "+v"(scla));
    int tid_ = threadIdx.x; asm volatile("" : "+v"(tid_));
    const int tid = tid_, wid = __builtin_amdgcn_readfirstlane(tid >> 6), lane = tid & 63, wr = wid >> 2, wc = wid & 3, fr = lane & 15, fq = lane >> 4;
    const int K = S.K, nt = K / BK;
    unsigned voffB[2];
    { int R[2], C[2];
#pragma unroll
      for (int i = 0; i < 2; ++i) { stage_rc(tid * 16 + i * 8192, R[i], C[i]); voffB[i] = (unsigned)(R[i] * K + C[i]) * 2u; } }
#define PG8_RC() int R[2], C[2]; { int t_ = threadIdx.x; asm volatile("" : "+v"(t_)); _Pragma("unroll") for (int i = 0; i < 2; ++i) stage_rc(t_ * 16 + i * 8192, R[i], C[i]); }
    const size_t kstep = (size_t)(BK * 2);
    const size_t hstepB = (size_t)HALF * K * 2;
    const unsigned ldsbase = (unsigned)__builtin_amdgcn_readfirstlane((int)((unsigned)(size_t)lds + (unsigned)wid * 1024u));
    const int aoff = lds_byte(wr * 64 + fr, fq * 8), boff = lds_byte(wc * 32 + fr, fq * 8);
#define PG8_SA(b, h) (((b) * 2 + (h)) * HTB)
#define PG8_SB(b, h) ((4 + (b) * 2 + (h)) * HTB)
#define PG8_STAGE2(bufoff, gbase, o0, o1) do { glds16((const char*)(gbase), (o0), ldsbase + (unsigned)(bufoff)); glds16((const char*)(gbase), (o1), ldsbase + (unsigned)(bufoff) + 8192u); } while (0)
#define PG8_STAGEB(bufoff, gbase) PG8_STAGE2(bufoff, gbase, voffB[0], voffB[1])
#define PG8_STAGEA(bufoff, gbase, h) PG8_STAGE2(bufoff, gbase, voffA[h][0], voffA[h][1])
#define PG8_STAGEAS(bufoff, gbase, h) PG8_STAGE2(bufoff, gbase, voffA[h][0], voffA[h][1])
#define PG8_LDA(dst, b, h) do { _Pragma("unroll") for (int m = 0; m < 4; ++m) _Pragma("unroll") for (int k = 0; k < 2; ++k) dst[m][k] = *(const LAS bf16x8*)(lds + PG8_SA(b, h) + aoff + m * 2048 + k * 1024); } while (0)
#define PG8_LDB(dst, b, h) do { _Pragma("unroll") for (int n = 0; n < 2; ++n) _Pragma("unroll") for (int k = 0; k < 2; ++k) dst[n][k] = *(const LAS bf16x8*)(lds + PG8_SB(b, h) + boff + n * 2048 + k * 1024); } while (0)
#define PG8_MMA(ai, bj, At, Bt) do { __builtin_amdgcn_s_setprio(1); if constexpr (FP8 == 2) { _Pragma("unroll") for (int m = 0; m < 4; ++m) _Pragma("unroll") for (int n = 0; n < 2; ++n) { \
        const v8i32 wa_ = cat8(Bt[n][0], Bt[n][1]), xa_ = cat8(At[m][0], At[m][1]); \
        asm volatile("s_nop 1\n\tv_mfma_scale_f32_16x16x128_f8f6f4 %0, %1, %2, %0, %3, %4 op_sel_hi:[0,0,0] cbsz:2 blgp:2" : "+v"(acc[ai][bj][m][n]) \
                     : "v"(__builtin_shufflevector(wa_, wa_, 0, 1, 2, 3, 4, 5)), "v"(__builtin_shufflevector(xa_, xa_, 0, 1, 2, 3, 4, 5)), "v"(wa_[6]), "v"(xa_[6])); } } else if constexpr (FP8 == 1) { _Pragma("unroll") for (int m = 0; m < 4; ++m) _Pragma("unroll") for (int n = 0; n < 2; ++n) \
        asm volatile("v_mfma_scale_f32_16x16x128_f8f6f4 %0, %1, %2, %0, %3, %4 op_sel_hi:[0,0,0]" : "+v"(acc[ai][bj][m][n]) : "v"(cat8(Bt[n][0], Bt[n][1])), "v"(cat8(At[m][0], At[m][1])), "v"(sclw), "v"(scla)); } else { \
        _Pragma("unroll") for (int m = 0; m < 4; ++m) _Pragma("unroll") for (int n = 0; n < 2; ++n) _Pragma("unroll") for (int k = 0; k < 2; ++k) \
        acc[ai][bj][m][n] = __builtin_amdgcn_mfma_f32_16x16x32_bf16(Bt[n][k], At[m][k], acc[ai][bj][m][n], 0, 0, 0); } __builtin_amdgcn_s_setprio(0); } while (0)
#define PG8_WAIT_V(n) asm volatile("s_waitcnt vmcnt(" #n ")" ::: "memory")
#define PG8_WAIT_K() do { if constexpr (HM) PG8_WAIT_V(6); else PG8_WAIT_V(8); } while (0)
    constexpr int EST = HM ? Epi::kStoresHM : Epi::kStores;
#define PG8_WAIT_K0() do { if (EST > 0 && t == 0 && ui > 0) asm volatile("s_waitcnt vmcnt(%0)" :: "n"((HM ? 6 : 8) + EST) : "memory"); else PG8_WAIT_K(); } while (0)
#define PG8_WAIT_L(n) asm volatile("s_waitcnt lgkmcnt(" #n ")" ::: "memory")
#define PG8_BAR __builtin_amdgcn_s_barrier()
#define PG8_SCHED __builtin_amdgcn_sched_barrier(0)
    Unit cur, nxt; int ui = 0;
    if (!S.next(0, cur)) return;
    unsigned voffA[2][2];
    { PG8_RC(); S.a_offs(cur, R, C, voffA); }
    f32x4 acc[2][2][4][2];
#pragma unroll
    for (int a = 0; a < 2; ++a)
#pragma unroll
        for (int b = 0; b < 2; ++b)
#pragma unroll
            for (int m = 0; m < 4; ++m)
#pragma unroll
                for (int n = 0; n < 2; ++n) acc[a][b][m][n] = (f32x4){0.f, 0.f, 0.f, 0.f};
    bf16x8 At[4][2], B0[2][2], B1[2][2];
    const char* cA = S.a_base(cur); const char* cB = S.b_base(cur);
    const unsigned bias_lds = (unsigned)__builtin_amdgcn_readfirstlane((int)((unsigned)(size_t)lds + (unsigned)(AUX_OFF + 8192) + (unsigned)wid * 256u));
    if constexpr (Epi::kBiasDMA) { if (lane < 16) glds16(E.bias_base(cur), E.bias_off(cur, wc, lane), bias_lds); }
    const unsigned rowid_lds = (unsigned)__builtin_amdgcn_readfirstlane((int)((unsigned)(size_t)lds + (unsigned)AUX_OFF + (unsigned)wid * 512u));
    if constexpr (Epi::kRowDMA) { if (lane < 32) glds16(E.row_base(cur), E.row_off(cur, wr, lane), rowid_lds); }
    PG8_STAGEB(PG8_SB(0, 0), cB); PG8_STAGEB(PG8_SB(0, 1), cB + hstepB); PG8_STAGEA(PG8_SA(0, 0), cA, 0); if constexpr (!HM) PG8_STAGEA(PG8_SA(0, 1), cA, 1);
    if (wr == 1) PG8_BAR;
    if constexpr (HM) PG8_WAIT_V(0); else PG8_WAIT_V(2);
    PG8_BAR;
    PG8_STAGEB(PG8_SB(1, 0), cB + kstep); PG8_STAGEA(PG8_SA(1, 0), cA + kstep, 0); PG8_STAGEB(PG8_SB(1, 1), cB + hstepB + kstep);
    PG8_WAIT_V(6); PG8_BAR;
    for (;;) {
        const bool has_next = S.next(ui + 1, nxt);
        const char* nA = cA; const char* nB = cB;
        if (has_next) { nA = S.a_base(nxt); nB = S.b_base(nxt); }
        unsigned gtok0 = 0, gtok1 = 0, gtok2 = 0, gtok3 = 0;
        if constexpr (Sched::kGather) {
            if (has_next) { PG8_RC(); const int* gp[4]; S.a_tokptrs(nxt, R, gp);
                asm volatile("global_load_dword %0, %4, off\n\tglobal_load_dword %1, %5, off\n\tglobal_load_dword %2, %6, off\n\tglobal_load_dword %3, %7, off"
                             : "=&v"(gtok0), "=&v"(gtok1), "=&v"(gtok2), "=&v"(gtok3) : "v"(gp[0]), "v"(gp[1]), "v"(gp[2]), "v"(gp[3]) : "memory"); }
        }
        for (int t = 0; t < nt; t += 2) {
            const bool last = (t == nt - 2);
            if constexpr (Sched::kGather) {
                if (t == 2 && has_next) {
                    if constexpr (HM) asm volatile("s_waitcnt vmcnt(12)" : "+v"(gtok0), "+v"(gtok1), "+v"(gtok2), "+v"(gtok3) :: "memory");
                    else asm volatile("s_waitcnt vmcnt(16)" : "+v"(gtok0), "+v"(gtok1), "+v"(gtok2), "+v"(gtok3) :: "memory");
                    PG8_RC(); *(LAS u32x4*)(S.aux + tid * 16) = (u32x4){(unsigned)(((int)gtok0 >> 2) * S.lda + C[0]) * 2u, (unsigned)(((int)gtok1 >> 2) * S.lda + C[1]) * 2u, (unsigned)(((int)gtok2 >> 2) * S.lda + C[0]) * 2u, (unsigned)(((int)gtok3 >> 2) * S.lda + C[1]) * 2u};
                }
            }
            const char* a1 = cA + (size_t)(t + 1) * kstep;
            const char* a2 = last ? nA : cA + (size_t)(t + 2) * kstep; const char* b2 = last ? nB : cB + (size_t)(t + 2) * kstep;
            const char* a3 = a2 + kstep; const char* b3 = b2 + kstep;
            PG8_LDB(B0, 0, 0); PG8_LDB(B1, 0, 1); PG8_SCHED; PG8_LDA(At, 0, 0); if constexpr (!HM) PG8_STAGEA(PG8_SA(1, 1), a1, 1);
            if constexpr (Sched::kGather) { if (last && has_next) { const u32x4 tn = *(const LAS u32x4*)(S.aux + tid * 16); voffA[0][0] = tn.x; voffA[0][1] = tn.y; voffA[1][0] = tn.z; voffA[1][1] = tn.w; } }
            PG8_WAIT_K0(); PG8_WAIT_L(0); PG8_BAR; PG8_MMA(0, 0, At, B0); PG8_MMA(0, 1, At, B1); PG8_BAR; PG8_SCHED;
            if constexpr (!HM) PG8_LDA(At, 0, 1);
            PG8_STAGEB(PG8_SB(0, 0), b2); PG8_STAGEB(PG8_SB(0, 1), b2 + hstepB); PG8_STAGEAS(PG8_SA(0, 0), a2, 0);
            PG8_WAIT_K0(); PG8_WAIT_L(0); PG8_BAR; if constexpr (!HM) { PG8_MMA(1, 0, At, B0); PG8_MMA(1, 1, At, B1); } PG8_BAR; PG8_SCHED;
            PG8_LDB(B0, 1, 0); PG8_LDB(B1, 1, 1); PG8_SCHED; PG8_LDA(At, 1, 0); if constexpr (!HM) PG8_STAGEAS(PG8_SA(0, 1), a2, 1);
            PG8_WAIT_K(); PG8_WAIT_L(0); PG8_BAR; PG8_MMA(0, 0, At, B0); PG8_MMA(0, 1, At, B1); PG8_BAR; PG8_SCHED;
            if constexpr (!HM) PG8_LDA(At, 1, 1);
            PG8_STAGEB(PG8_SB(1, 0), b3); PG8_STAGEB(PG8_SB(1, 1), b3 + hstepB); PG8_STAGEAS(PG8_SA(1, 0), a3, 0);
            PG8_WAIT_K(); PG8_WAIT_L(0); PG8_BAR; if constexpr (!HM) { PG8_MMA(1, 0, At, B0); PG8_MMA(1, 1, At, B1); } PG8_BAR; PG8_SCHED;
        }
        if (wr == 0) PG8_BAR;
        if constexpr (FP8 >= 1) asm volatile("s_nop 15\n\ts_nop 15" ::: "memory");
        if constexpr (Epi::kRowDMA) E(acc, cur, wr, wc, fr, fq, (const LAS float*)(lds + AUX_OFF + 8192 + wid * 256), (const LAS int*)(lds + AUX_OFF + wid * 512), HM ? 1 : 2);
        else if constexpr (Epi::kBiasDMA) E(acc, cur, wr, wc, fr, fq, (const LAS float*)(lds + AUX_OFF + 8192 + wid * 256), HM ? 1 : 2); else E(acc, cur, wr, wc, fr, fq);
        if (!has_next) break;
        if constexpr (RSYNC) xcd_barrier(*rbar);
#pragma unroll
        for (int a = 0; a < 2; ++a)
#pragma unroll
            for (int b = 0; b < 2; ++b)
#pragma unroll
                for (int m = 0; m < 4; ++m)
#pragma unroll
                    for (int n = 0; n < 2; ++n) acc[a][b][m][n] = (f32x4){0.f, 0.f, 0.f, 0.f};
        cur = nxt; cA = nA; cB = nB; ++ui;
        if constexpr (Epi::kBiasDMA) { if (lane < 16) glds16(E.bias_base(cur), E.bias_off(cur, wc, lane), bias_lds); }
        if constexpr (Epi::kRowDMA) { if (lane < 32) glds16(E.row_base(cur), E.row_off(cur, wr, lane), rowid_lds); }
        if (wr == 1) PG8_BAR;
    }
    PG8_WAIT_V(0);
    PG8_BAR;
#undef PG8_SA
#undef PG8_RC
#undef PG8_SB
#undef PG8_STAGE2
#undef PG8_STAGEB
#undef PG8_STAGEA
#undef PG8_STAGEAS
#undef PG8_LDA
#undef PG8_LDB
#undef PG8_MMA
#undef PG8_WAIT_V
#undef PG8_WAIT_K
#undef PG8_WAIT_K0
#undef PG8_WAIT_L
#undef PG8_BAR
#undef PG8_SCHED
}
}

struct Args {
    const float* in[18]; float* out; unsigned char* ws;
    float l2g[8];
    int ph_lo, ph_hi;
};
struct Frame {
    LAS unsigned char* lds;
    int tid, lane, wave, G, vcu;
    unsigned char* ws;
};

enum { CM_NAT = 0, CM_STD = 1, CM_ROPE = 2, CM_SWIGLU = 3, CM_WIN = 4, CM_DN = 5 };
__device__ __forceinline__ int src_col(int mode, int n) {
    if (mode == CM_WIN) mode = (n >= 2048 && n < 4096) ? CM_ROPE : CM_STD;
    if (mode == CM_NAT) return n;
    if (mode == CM_DN) return n;
    if (mode == CM_STD) return (n & ~31) + pg8::perm32(n & 31);
    if (mode == CM_ROPE) { const int p = n & 127, wc = p >> 5, nn = (p >> 4) & 1, i = p & 15; return (n & ~127) + 16 * wc + i + 64 * nn; }
    { const int pn = n >> 8, p = n & 255, bj = p >> 7, g = (p >> 5) & 3, rho = p & 31; return bj * 2048 + 128 * pn + 32 * g + pg8::perm32(rho); }
}
__device__ __forceinline__ int dst_row(int mode, int c) {
    if (mode != CM_DN) return c;
    const int q = c & 255, wc = q >> 6, fq = (q >> 4) & 3, bj = (q >> 3) & 1, nn = (q >> 2) & 1, j = q & 3;
    return (c & ~255) + 128 * bj + 32 * wc + 16 * nn + 4 * fq + j;
}
__device__ __forceinline__ void transpose_item(const float* W, int K, int N, bf16_t* WT, int mode, int item, LAS unsigned* scr, int lane) {
    const int nblk = N / 32, kb = item / nblk, nb = item % nblk, k0 = 64 * kb, n0 = 32 * nb;
    const int g = lane & 7, r = lane >> 3;
    const int sc = src_col(mode, n0 + 4 * g);
    const float* p = W + (size_t)(k0 + 2 * r) * N + sc;
    f32x4 a[4], b[4];
#pragma unroll
    for (int i = 0; i < 4; ++i) { a[i] = *(const f32x4*)(p + (size_t)(16 * i) * N); b[i] = *(const f32x4*)(p + (size_t)(16 * i + 1) * N); }
#pragma unroll
    for (int i = 0; i < 4; ++i)
#pragma unroll
        for (int j = 0; j < 4; ++j) scr[(4 * g + j) * 33 + r + 8 * i] = cvt_pk_bf16(a[i][j], b[i][j]);
    asm volatile("s_waitcnt lgkmcnt(0)" ::: "memory");
    const int c = lane & 7;
#pragma unroll
    for (int ii = 0; ii < 4; ++ii) { const int n = 8 * ii + (lane >> 3); const LAS unsigned* s = scr + n * 33 + 4 * c;
        u32x4 o; o.x = s[0]; o.y = s[1]; o.z = s[2]; o.w = s[3];
        *(u32x4*)(WT + (size_t)(n0 + n) * K + k0 + 8 * c) = o; }
    asm volatile("s_waitcnt lgkmcnt(0)" ::: "memory");
}

typedef float f32x16v __attribute__((ext_vector_type(16)));
typedef unsigned u32x6 __attribute__((ext_vector_type(6)));
#ifndef MK_F6_SCALE_INV
#define MK_F6_SCALE_INV 0
#endif
__device__ __forceinline__ void q6_block(const float (&v)[32], u32x4& lo, u32x4& hi) {
    float amax = 0.f;
#pragma unroll
    for (int t = 0; t < 32; ++t) amax = fmaxf(amax, fabsf(v[t]));
    const unsigned eb = ((__float_as_uint(amax * 0.13333334f) >> 23) & 255u) + 1u;
    const float sc = __uint_as_float(eb << 23);
    f32x16v a, b;
#pragma unroll
    for (int t = 0; t < 16; ++t) { a[t] = v[t]; b[t] = v[16 + t]; }
    const u32x6 q = __builtin_amdgcn_cvt_scalef32_2xpk16_fp6_f32(a, b, MK_F6_SCALE_INV ? __uint_as_float((254u - eb) << 23) : sc);
    lo = (u32x4){q[0], q[1], q[2], q[3]};
    hi = (u32x4){q[4], q[5], eb * 0x01010101u, 0u};
}
__device__ __forceinline__ void t8_load(const float* W, int N, int mode, int item, int lane, f32x4 (&a)[4][4]) {
    const int nblk = N / 32, kb = item / nblk, nb = item % nblk, k0 = 128 * kb, n0 = 32 * nb;
    const int g = lane & 7, r = lane >> 3;
    const float* p = W + (size_t)(k0 + 4 * r) * N + src_col(mode, n0 + 4 * g);
#pragma unroll
    for (int i = 0; i < 4; ++i)
#pragma unroll
        for (int q = 0; q < 4; ++q) a[i][q] = __builtin_nontemporal_load((const f32x4*)(p + (size_t)(32 * i + q) * N));
}
__device__ __forceinline__ void t8_store(const f32x4 (&a)[4][4], int K, int N, unsigned char* WT, int mode, int item, float scale, LAS unsigned* scr, int lane) {
    const int nblk = N / 32, kb = item / nblk, nb = item % nblk, k0 = 128 * kb, n0 = 32 * nb;
    const int g = lane & 7, r = lane >> 3;
#pragma unroll
    for (int i = 0; i < 4; ++i)
#pragma unroll
        for (int j = 0; j < 4; ++j) scr[(4 * g + j) * 33 + r + 8 * i] = pk4_fp8(a[i][0][j] * scale, a[i][1][j] * scale, a[i][2][j] * scale, a[i][3][j] * scale);
    asm volatile("s_waitcnt lgkmcnt(0)" ::: "memory");
    const int c = lane & 7;
#pragma unroll
    for (int ii = 0; ii < 4; ++ii) { const int n = 8 * ii + (lane >> 3); const LAS unsigned* s = scr + n * 33 + 4 * c;
        u32x4 o; o.x = s[0]; o.y = s[1]; o.z = s[2]; o.w = s[3];
        *(u32x4*)(WT + (size_t)dst_row(mode, n0 + n) * K + k0 + 16 * c) = o; }
    asm volatile("s_waitcnt lgkmcnt(0)" ::: "memory");
}
__device__ __forceinline__ void t6_store(const f32x4 (&a)[4][4], int K, int N, unsigned char* WT, int item, LAS float* scr, int lane) {
    const int nblk = N / 32, kbi = item / nblk, nb = item % nblk, k0 = 128 * kbi, n0 = 32 * nb;
    const int g = lane & 7, r = lane >> 3, n = lane & 31, kb = lane >> 5;
    LAS unsigned char* outl = (LAS unsigned char*)(scr + 64 * 36);
#pragma unroll
    for (int h = 0; h < 2; ++h) {
#pragma unroll
        for (int i = 0; i < 2; ++i)
#pragma unroll
            for (int q = 0; q < 4; ++q) *(LAS f32x4*)(scr + (4 * r + 32 * i + q) * 36 + 4 * g) = a[2 * h + i][q];
        asm volatile("s_waitcnt lgkmcnt(0)" ::: "memory");
        float v[32];
#pragma unroll
        for (int t = 0; t < 32; ++t) v[t] = scr[(32 * kb + t) * 36 + n];
        u32x4 lo, hi; q6_block(v, lo, hi);
        *(LAS u32x4*)(outl + n * 144 + 16 * (2 * h + kb)) = lo; *(LAS u32x4*)(outl + n * 144 + 64 + 16 * (2 * h + kb)) = hi;
        asm volatile("s_waitcnt lgkmcnt(0)" ::: "memory");
    }
    const int c = lane & 7;
#pragma unroll
    for (int ii = 0; ii < 4; ++ii) { const int rr = 8 * ii + (lane >> 3);
        const u32x4 o = *(const LAS u32x4*)(outl + rr * 144 + 16 * c);
        *(u32x4*)(WT + (size_t)(n0 + rr) * K + k0 + 16 * c) = o; }
    asm volatile("s_waitcnt lgkmcnt(0)" ::: "memory");
}
template <bool FP6> __device__ __forceinline__ void t8_stream(const float* W, int K, int N, unsigned char* WT, int mode, int items_per_e, int gw, int NGW, LAS unsigned* scr, int lane) {
    const int NIT = NE * items_per_e; const size_t estride = (size_t)K * N;
    f32x4 A[4][4], B[4][4];
#define T8_LD(buf, idx) do { const int i_ = (idx) < NIT ? (idx) : NIT - 1; t8_load(W + (size_t)(i_ / items_per_e) * estride, N, mode, i_ % items_per_e, lane, buf); } while (0)
#define T8_ST(buf, idx) do { if constexpr (FP6) t6_store(buf, K, N, WT + (size_t)((idx) / items_per_e) * estride, (idx) % items_per_e, (LAS float*)scr, lane); else t8_store(buf, K, N, WT + (size_t)((idx) / items_per_e) * estride, mode, (idx) % items_per_e, W8_SCALE, scr, lane); } while (0)
    T8_LD(A, gw);
    for (int it = gw; it < NIT; it += 2 * NGW) {
        T8_LD(B, it + NGW);
        T8_ST(A, it);
        T8_LD(A, it + 2 * NGW);
        if (it + NGW < NIT) T8_ST(B, it + NGW);
    }
#undef T8_LD
#undef T8_ST
}

__device__ __forceinline__ void conv_rest(Frame& F, const Args& a, int gw, int NGW) {
    LAS unsigned* scr = (LAS unsigned*)(F.lds + F.wave * 13824);
    bf16_t* Wpa = (bf16_t*)(F.ws + WS_WPA); bf16_t* Wpr = (bf16_t*)(F.ws + WS_WPR); bf16_t* Wout = (bf16_t*)(F.ws + WS_WOUT);
    unsigned char* Wgu = (unsigned char*)(F.ws + WS_WGU); unsigned char* Wdn = (unsigned char*)(F.ws + WS_WDN);
    constexpr int I_PA = (GW / 64) * (D / 32), I_PR = (D / 64) * (D / 32), I_OUT = I_PR, I_GU1 = (D / 128) * (4096 / 32), I_DN1 = (DFF / 128) * (D / 32);
    constexpr int NITEMS = I_PA + I_PR + I_OUT;
    for (int it = gw; it < NITEMS; it += NGW) {
        int r = it;
        if (r < I_PA) { transpose_item(a.in[7], GW, D, Wpa, CM_STD, r, scr, F.lane); continue; } r -= I_PA;
        if (r < I_PR) { transpose_item(a.in[8], D, D, Wpr, CM_STD, r, scr, F.lane); continue; } r -= I_PR;
        transpose_item(a.in[9], D, D, Wout, CM_NAT, r, scr, F.lane);
    }
    t8_stream<true>(a.in[13], D, 4096, Wgu, CM_SWIGLU, I_GU1, gw, NGW, scr, F.lane);
    t8_stream<false>(a.in[15], DFF, D, Wdn, CM_DN, I_DN1, gw, NGW, scr, F.lane);
}
__device__ __forceinline__ void t16_load(const float* W, int N, int mode, int item, int lane, f32x4 (&a)[4], f32x4 (&b)[4]) {
    const int nblk = N / 32, kb = item / nblk, nb = item % nblk, k0 = 64 * kb, n0 = 32 * nb;
    const int g = lane & 7, r = lane >> 3;
    const float* p = W + (size_t)(k0 + 2 * r) * N + src_col(mode, n0 + 4 * g);
#pragma unroll
    for (int i = 0; i < 4; ++i) { a[i] = __builtin_nontemporal_load((const f32x4*)(p + (size_t)(16 * i) * N)); b[i] = __builtin_nontemporal_load((const f32x4*)(p + (size_t)(16 * i + 1) * N)); }
}
__device__ __forceinline__ void t16_store(const f32x4 (&a)[4], const f32x4 (&b)[4], int K, int N, bf16_t* WT, int item, LAS unsigned* scr, int lane) {
    const int nblk = N / 32, kb = item / nblk, nb = item % nblk, k0 = 64 * kb, n0 = 32 * nb;
    const int g = lane & 7, r = lane >> 3;
#pragma unroll
    for (int i = 0; i < 4; ++i)
#pragma unroll
        for (int j = 0; j < 4; ++j) scr[(4 * g + j) * 33 + r + 8 * i] = cvt_pk_bf16(a[i][j], b[i][j]);
    asm volatile("s_waitcnt lgkmcnt(0)" ::: "memory");
    const int c = lane & 7;
#pragma unroll
    for (int ii = 0; ii < 4; ++ii) { const int n = 8 * ii + (lane >> 3); const LAS unsigned* s = scr + n * 33 + 4 * c;
        u32x4 o; o.x = s[0]; o.y = s[1]; o.z = s[2]; o.w = s[3];
        *(u32x4*)(WT + (size_t)(n0 + n) * K + k0 + 8 * c) = o; }
    asm volatile("s_waitcnt lgkmcnt(0)" ::: "memory");
}
__device__ __forceinline__ void p0_prologue(Frame& F, const Args& a) {
    LAS unsigned* scr = (LAS unsigned*)(F.lds + F.wave * 4352);
    const int gw = F.vcu * NWAVES + F.wave, NGW = F.G * NWAVES;
    bf16_t* Win = (bf16_t*)(F.ws + WS_WIN);
    constexpr int I_IN = (D / 64) * (INW / 32);
    {
        f32x4 A0[4], A1[4], B0[4], B1[4];
        t16_load(a.in[2], INW, CM_WIN, gw < I_IN ? gw : I_IN - 1, F.lane, A0, A1);
        for (int it = gw; it < I_IN; it += 2 * NGW) {
            { const int n1 = it + NGW; t16_load(a.in[2], INW, CM_WIN, n1 < I_IN ? n1 : I_IN - 1, F.lane, B0, B1); }
            t16_store(A0, A1, D, INW, Win, it, scr, F.lane);
            { const int n2 = it + 2 * NGW; t16_load(a.in[2], INW, CM_WIN, n2 < I_IN ? n2 : I_IN - 1, F.lane, A0, A1); }
            if (it + NGW < I_IN) t16_store(B0, B1, D, INW, Win, it + NGW, scr, F.lane);
        }
    }
    const float* x = a.in[0]; const float* g1 = a.in[1]; bf16_t* H = (bf16_t*)(F.ws + WS_H);
    float* rc = (float*)(F.ws + WS_ROPEC); float* rs = (float*)(F.ws + WS_ROPES);
    LAS double* invf = (LAS double*)(F.lds + 40960);
    __syncthreads();
    if (F.tid < 64) invf[F.tid] = exp2(-(double)(2 * F.tid) / 128.0 * 13.287712379549449);
    __syncthreads();
    int ridx = blockIdx.x * NTHREADS + F.tid;
#define ROPE_ENTRY() do { if (ridx < T * 64) { const int pos = ridx >> 6, i_ = ridx & 63; double ang = (double)pos * invf[i_]; const double k_ = rint(ang * 0.15915494309189535); ang = ang - k_ * 6.283185307179586; \
        const float af = (float)ang; rc[ridx] = cosf(af); rs[ridx] = sinf(af); } ridx += F.G * NTHREADS; } while (0)
    {
        f32x4 g1v[8];
#pragma unroll
        for (int j = 0; j < 8; ++j) g1v[j] = ((const f32x4*)g1)[F.lane + 64 * j];
        f32x4 vc[8];
        { const f32x4* xr = (const f32x4*)(x + (size_t)(gw < T ? gw : T - 1) * D) + F.lane;
#pragma unroll
          for (int j = 0; j < 8; ++j) vc[j] = __builtin_nontemporal_load(xr + 64 * j); }
        for (int m = gw; m < T; m += NGW) {
            f32x4 vn[8];
            { const int mn = (m + NGW) < T ? (m + NGW) : T - 1; const f32x4* xr = (const f32x4*)(x + (size_t)mn * D) + F.lane;
#pragma unroll
              for (int j = 0; j < 8; ++j) vn[j] = __builtin_nontemporal_load(xr + 64 * j); }
            float s = 0.f;
#pragma unroll
            for (int j = 0; j < 8; ++j) s += (vc[j].x * vc[j].x + vc[j].y * vc[j].y) + (vc[j].z * vc[j].z + vc[j].w * vc[j].w);
            const float rstd = 1.0f / sqrtf(wave_sum(s) * (1.f / D) + EPS);
            u32x2* o8 = (u32x2*)(H + (size_t)m * D) + F.lane;
#pragma unroll
            for (int j = 0; j < 8; ++j) { const f32x4 g = g1v[j]; u32x2 w; w.x = cvt_pk_bf16(vc[j].x * rstd * g.x, vc[j].y * rstd * g.y); w.y = cvt_pk_bf16(vc[j].z * rstd * g.z, vc[j].w * rstd * g.w); o8[64 * j] = w; }
#pragma unroll
            for (int j = 0; j < 8; ++j) vc[j] = vn[j];
            ROPE_ENTRY();
        }
    }
    while (ridx < T * 64) ROPE_ENTRY();
#undef ROPE_ENTRY
}

typedef f32x4 AccT[2][2][4][2];
struct EpiInProj {
    static constexpr bool kBiasDMA = false; static constexpr bool kRowDMA = false; static constexpr int kStores = 0, kStoresHM = 0;
    unsigned char* ws;
    __device__ __forceinline__ void operator()(const AccT& acc, const pg8::Unit& u, int wr, int wc, int fr, int fq) const {
        const int row0 = u.pm * 256 + wr * 64 + fr; const int pn = u.pn;
        if (pn < 8) {
            bf16_t* dst = (bf16_t*)(ws + (pn < 4 ? WS_U : WS_V)); const int col0 = (pn & 3) * 256 + wc * 32 + 8 * fq;
            float* vstat = (float*)(ws + WS_VSTAT);
#pragma unroll
            for (int ai = 0; ai < 2; ++ai)
#pragma unroll
                for (int m = 0; m < 4; ++m) { const int row = row0 + ai * 128 + m * 16; float s = 0.f, q = 0.f;
#pragma unroll
                    for (int bj = 0; bj < 2; ++bj) { const f32x4 v0 = gelu4(acc[ai][bj][m][0]), v1 = gelu4(acc[ai][bj][m][1]);
                        s += (v0[0] + v0[1]) + (v0[2] + v0[3]) + (v1[0] + v1[1]) + (v1[2] + v1[3]);
                        q += (v0[0] * v0[0] + v0[1] * v0[1]) + (v0[2] * v0[2] + v0[3] * v0[3]) + (v1[0] * v1[0] + v1[1] * v1[1]) + (v1[2] * v1[2] + v1[3] * v1[3]);
                        u32x4 w; w.x = cvt_pk_bf16(v0[0], v0[1]); w.y = cvt_pk_bf16(v0[2], v0[3]); w.z = cvt_pk_bf16(v1[0], v1[1]); w.w = cvt_pk_bf16(v1[2], v1[3]);
                        *(u32x4*)(dst + (size_t)row * GW + col0 + bj * 128) = w; }
                    if (pn >= 4) { s += __shfl_xor(s, 16); s += __shfl_xor(s, 32); q += __shfl_xor(q, 16); q += __shfl_xor(q, 32);
                        if (fq == 0) *(f32x2*)(vstat + (size_t)row * 32 + ((pn - 4) * 4 + wc) * 2) = (f32x2){s, q}; } }
        } else if (pn < 16) {
            bf16_t* dst = (bf16_t*)(ws + (pn < 12 ? WS_Q : WS_K)); const float sc = pn < 12 ? 1.0f : 0.08838834764831845f;
            const float* rc = (const float*)(ws + WS_ROPEC); const float* rs = (const float*)(ws + WS_ROPES);
            const int dd = 16 * wc + 4 * fq;
#pragma unroll
            for (int ai = 0; ai < 2; ++ai) {
                f32x4 cc[4], ss[4];
#pragma unroll
                for (int m = 0; m < 4; ++m) { const int row = row0 + ai * 128 + m * 16; cc[m] = *(const f32x4*)(rc + (size_t)row * 64 + dd); ss[m] = *(const f32x4*)(rs + (size_t)row * 64 + dd); }
#pragma unroll
                for (int m = 0; m < 4; ++m) { const int row = row0 + ai * 128 + m * 16;
                    const f32x4 c = cc[m] * sc, s = ss[m] * sc;
#pragma unroll
                    for (int bj = 0; bj < 2; ++bj) { const f32x4 t1 = acc[ai][bj][m][0], t2 = acc[ai][bj][m][1];
                        const f32x4 o1 = t1 * c - t2 * s, o2 = t2 * c + t1 * s;
                        bf16_t* p = dst + (size_t)row * QKW + (pn & 3) * 256 + bj * 128 + dd;
                        u32x2 w1, w2; w1.x = cvt_pk_bf16(o1[0], o1[1]); w1.y = cvt_pk_bf16(o1[2], o1[3]); w2.x = cvt_pk_bf16(o2[0], o2[1]); w2.y = cvt_pk_bf16(o2[2], o2[3]);
                        *(u32x2*)p = w1; *(u32x2*)(p + 64) = w2; } } }
        } else {
            const int kind = (pn - 16) >> 3;
            bf16_t* dst = (bf16_t*)(ws + (kind == 0 ? WS_RV : kind == 1 ? WS_RG : kind == 2 ? WS_GA : WS_GR)); const int col0 = ((pn - 16) & 7) * 256 + wc * 32 + 8 * fq;
#pragma unroll
            for (int ai = 0; ai < 2; ++ai)
#pragma unroll
                for (int m = 0; m < 4; ++m) { const int row = row0 + ai * 128 + m * 16;
#pragma unroll
                    for (int bj = 0; bj < 2; ++bj) { f32x4 v0 = acc[ai][bj][m][0], v1 = acc[ai][bj][m][1];
                        if (kind == 1) {
#pragma unroll
                            for (int j = 0; j < 4; ++j) { v0[j] = v0[j] * sigmoid_f(v0[j]); v1[j] = v1[j] * sigmoid_f(v1[j]); } }
                        else if (kind >= 2) {
#pragma unroll
                            for (int j = 0; j < 4; ++j) { v0[j] = sigmoid_f(v0[j]); v1[j] = sigmoid_f(v1[j]); } }
                        u32x4 w; w.x = cvt_pk_bf16(v0[0], v0[1]); w.y = cvt_pk_bf16(v0[2], v0[3]); w.z = cvt_pk_bf16(v1[0], v1[1]); w.w = cvt_pk_bf16(v1[2], v1[3]);
                        *(u32x4*)(dst + (size_t)row * D + col0 + bj * 128) = w; } }
        }
    }
};
template <int MODE> struct EpiMerge {
    static constexpr bool kBiasDMA = false; static constexpr bool kRowDMA = false; static constexpr int kStores = 16, kStoresHM = 0;
    unsigned char* ws;
    __device__ __forceinline__ void operator()(const AccT& acc, const pg8::Unit& u, int wr, int wc, int fr, int fq) const {
        const int row0 = u.pm * 256 + wr * 64 + fr, col0 = u.pn * 256 + wc * 32 + 8 * fq;
        const bf16_t* gate = (const bf16_t*)(ws + (MODE == 0 ? WS_GA : WS_GR)); bf16_t* mrg = (bf16_t*)(ws + WS_MRG);
#pragma unroll
        for (int ai = 0; ai < 2; ++ai) {
            u32x4 gg[4][2], pp[4][2];
#pragma unroll
            for (int m = 0; m < 4; ++m)
#pragma unroll
                for (int bj = 0; bj < 2; ++bj) { const size_t ro = (size_t)(row0 + ai * 128 + m * 16) * D + col0 + bj * 128; gg[m][bj] = *(const u32x4*)(gate + ro); if (MODE == 1) pp[m][bj] = *(const u32x4*)(mrg + ro); }
#pragma unroll
            for (int m = 0; m < 4; ++m)
#pragma unroll
                for (int bj = 0; bj < 2; ++bj) { const size_t ro = (size_t)(row0 + ai * 128 + m * 16) * D + col0 + bj * 128; const u32x4 g = gg[m][bj]; const f32x4 v0 = acc[ai][bj][m][0], v1 = acc[ai][bj][m][1];
                    float o[8] = {v0[0] * bf_lo(g.x), v0[1] * bf_hi(g.x), v0[2] * bf_lo(g.y), v0[3] * bf_hi(g.y), v1[0] * bf_lo(g.z), v1[1] * bf_hi(g.z), v1[2] * bf_lo(g.w), v1[3] * bf_hi(g.w)};
                    if (MODE == 1) { const u32x4 p = pp[m][bj];
                        o[0] += bf_lo(p.x); o[1] += bf_hi(p.x); o[2] += bf_lo(p.y); o[3] += bf_hi(p.y); o[4] += bf_lo(p.z); o[5] += bf_hi(p.z); o[6] += bf_lo(p.w); o[7] += bf_hi(p.w); }
                    u32x4 w; w.x = cvt_pk_bf16(o[0], o[1]); w.y = cvt_pk_bf16(o[2], o[3]); w.z = cvt_pk_bf16(o[4], o[5]); w.w = cvt_pk_bf16(o[6], o[7]);
                    *(u32x4*)(mrg + ro) = w; } }
    }
};
struct EpiOut {
    static constexpr bool kBiasDMA = false; static constexpr bool kRowDMA = false; static constexpr int kStores = 32, kStoresHM = 0;
    const float* x; unsigned char* ws;
    __device__ __forceinline__ void operator()(const AccT& acc, const pg8::Unit& u, int wr, int wc, int fr, int fq) const {
        const int row0 = u.pm * 256 + wr * 64 + fr, col0 = u.pn * 256 + wc * 32 + 4 * fq;
        float* x1 = (float*)(ws + WS_X1); float* ss = (float*)(ws + WS_SS);
#pragma unroll
        for (int ai = 0; ai < 2; ++ai) {
            f32x4 xx[4][2][2];
#pragma unroll
            for (int m = 0; m < 4; ++m)
#pragma unroll
                for (int bj = 0; bj < 2; ++bj)
#pragma unroll
                    for (int n = 0; n < 2; ++n) xx[m][bj][n] = *(const f32x4*)(x + (size_t)(row0 + ai * 128 + m * 16) * D + col0 + bj * 128 + n * 16);
#pragma unroll
            for (int m = 0; m < 4; ++m) { const int row = row0 + ai * 128 + m * 16; const size_t ro = (size_t)row * D + col0; float q = 0.f;
#pragma unroll
                for (int bj = 0; bj < 2; ++bj)
#pragma unroll
                    for (int n = 0; n < 2; ++n) { const f32x4 o = xx[m][bj][n] + acc[ai][bj][m][n];
                        q += (o[0] * o[0] + o[1] * o[1]) + (o[2] * o[2] + o[3] * o[3]);
                        *(f32x4*)(x1 + ro + bj * 128 + n * 16) = o; }
                q += __shfl_xor(q, 16); q += __shfl_xor(q, 32);
                if (fq == 0) ss[(size_t)row * 32 + u.pn * 4 + wc] = q; } }
    }
};
struct EpiGateUp {
    static constexpr bool kBiasDMA = true; static constexpr bool kRowDMA = false; static constexpr int kStores = 8, kStoresHM = 4;
    const float* bgu; unsigned char* ws;
    __device__ __forceinline__ const char* bias_base(const pg8::Unit& u) const { return (const char*)(bgu + (size_t)u.e * 4096 + u.pn * 128); }
    __device__ __forceinline__ unsigned bias_off(const pg8::Unit&, int wc, int lane) const { return (unsigned)(((lane >> 3) & 1) * 2048 + wc * 32 + (lane & 7) * 4) * 4u; }
    __device__ __forceinline__ void operator()(const AccT& acc, const pg8::Unit& u, int wr, int wc, int fr, int fq, const LAS float* bl, int nai) const {
        const int row0 = u.pm * 256 + u.hx * 128 + wr * 64 + fr, a0 = u.pn * 128 + wc * 32 + 8 * fq;
        unsigned char* act = (unsigned char*)(ws + WS_ACT);
        const f32x4 bg0 = *(const LAS f32x4*)(bl + 8 * fq), bg1 = *(const LAS f32x4*)(bl + 8 * fq + 4), bu0 = *(const LAS f32x4*)(bl + 32 + 8 * fq), bu1 = *(const LAS f32x4*)(bl + 32 + 8 * fq + 4);
#pragma unroll
        for (int ai = 0; ai < 2; ++ai) if (ai < nai)
#pragma unroll
            for (int m = 0; m < 4; ++m) { const size_t ro = (size_t)(row0 + ai * 128 + m * 16) * DFF + a0; float o[8];
#pragma unroll
                for (int n = 0; n < 2; ++n) {
                    f32x4 g4 = acc[ai][0][m][n] + (n ? bg1 : bg0), u4 = acc[ai][1][m][n] + (n ? bu1 : bu0);
#pragma unroll
                    for (int j = 0; j < 4; ++j) { g4[j] = fminf(g4[j], 7.0f); u4[j] = __builtin_amdgcn_fmed3f(u4[j], -7.0f, 7.0f); }
                    const f32x4 t4 = g4 * (-1.702f * 1.4426950408889634f);
                    f32x4 e4;
#pragma unroll
                    for (int j = 0; j < 4; ++j) e4[j] = __builtin_amdgcn_exp2f(t4[j]);
                    e4 = e4 + 1.0f;
                    f32x4 r4;
#pragma unroll
                    for (int j = 0; j < 4; ++j) r4[j] = __builtin_amdgcn_rcpf(e4[j]);
                    const f32x4 o4 = (u4 * A8_SCALE + A8_SCALE) * (g4 * r4);
#pragma unroll
                    for (int j = 0; j < 4; ++j) o[4 * n + j] = o4[j]; }
                u32x2 w; w.x = pk4_fp8(o[0], o[1], o[2], o[3]); w.y = pk4_fp8(o[4], o[5], o[6], o[7]);
                *(u32x2*)(act + ro) = w; }
    }
};
struct EpiDown {
    static constexpr bool kBiasDMA = true; static constexpr bool kRowDMA = true; static constexpr int kStores = 0, kStoresHM = 0;
    const float* bdn; unsigned char* ws; const LAS int* cnt;
    __device__ __forceinline__ const char* bias_base(const pg8::Unit& u) const { return (const char*)(bdn + (size_t)u.e * D + u.pn * 256); }
    __device__ __forceinline__ unsigned bias_off(const pg8::Unit&, int wc, int lane) const { return (unsigned)(wc * 64 + lane * 4) * 4u; }
    __device__ __forceinline__ const char* row_base(const pg8::Unit& u) const { return (const char*)((const int*)(ws + WS_ROWTOK) + (size_t)u.e * T + u.mt * 256 + u.hx * 128); }
    __device__ __forceinline__ unsigned row_off(const pg8::Unit&, int wr, int lane) const { return (unsigned)(((lane >> 4) & 1) * 128 + wr * 64 + (lane & 15) * 4) * 4u; }
    __device__ __forceinline__ void operator()(const AccT& acc, const pg8::Unit& u, int wr, int wc, int fr, int fq, const LAS float* bl, const LAS int* rid, int nai) const {
        const int col0 = u.pn * 256 + wc * 64 + 16 * fq;
        unsigned char* y = (unsigned char*)(ws + WS_Y);
        const int nvalid = __builtin_amdgcn_readfirstlane(cnt[u.e]) - u.mt * 256;
        f32x4 bv[2][2];
#pragma unroll
        for (int bj = 0; bj < 2; ++bj) { bv[bj][0] = *(const LAS f32x4*)(bl + 16 * fq + 8 * bj) * Y8_SCALE; bv[bj][1] = *(const LAS f32x4*)(bl + 16 * fq + 8 * bj + 4) * Y8_SCALE; }
#pragma unroll
        for (int ai = 0; ai < 2; ++ai) if (ai < nai)
#pragma unroll
            for (int m = 0; m < 4; ++m) { const int rl = u.hx * 128 + ai * 128 + wr * 64 + m * 16 + fr; const int dst = rid[ai * 64 + m * 16 + fr];
                if (rl < nvalid) { const size_t ro = (size_t)dst * D + col0; unsigned wv[4];
#pragma unroll
                    for (int bj = 0; bj < 2; ++bj) { const f32x4 v0 = acc[ai][bj][m][0] * Y8_SCALE + bv[bj][0], v1 = acc[ai][bj][m][1] * Y8_SCALE + bv[bj][1];
                        wv[2 * bj] = pk4_fp8(v0[0], v0[1], v0[2], v0[3]); wv[2 * bj + 1] = pk4_fp8(v1[0], v1[1], v1[2], v1[3]); }
                    *(u32x4*)(y + ro) = (u32x4){wv[0], wv[1], wv[2], wv[3]}; } }
    }
};

__device__ __forceinline__ unsigned off_b(unsigned row, unsigned ch) { return 256u * row + 16u * (ch ^ (((row & 3) << 2) | ((row >> 2) & 3))); }
__device__ __forceinline__ unsigned row_addr16(unsigned lane, unsigned rb, unsigned s) { return off_b((lane & 15) + 16 * rb, 4 * s + (lane >> 4)); }
__device__ __forceinline__ unsigned tr_addr16(unsigned lane, unsigned c, unsigned ks, unsigned t) {
    const unsigned g = lane >> 4, q = (lane & 15) >> 2, p = lane & 3;
    return off_b(32 * ks + 8 * g + 4 * t + q, 2 * c + (p >> 1)) + 8 * (p & 1);
}
__device__ __forceinline__ bf16x8 tr_frag(LAS unsigned char* img, unsigned lane, unsigned c, unsigned ks) {
    const s16x4 a = __builtin_amdgcn_ds_read_tr16_b64_v4i16((LAS s16x4*)(img + tr_addr16(lane, c, ks, 0)));
    const s16x4 b = __builtin_amdgcn_ds_read_tr16_b64_v4i16((LAS s16x4*)(img + tr_addr16(lane, c, ks, 1)));
    return __builtin_shufflevector(a, b, 0, 1, 2, 3, 4, 5, 6, 7);
}
__device__ __forceinline__ bf16x8 row_frag(LAS unsigned char* img, unsigned lane, unsigned rb, unsigned s) { return *(const LAS bf16x8*)(img + row_addr16(lane, rb, s)); }
#define MFMA16(a, b, c) __builtin_amdgcn_mfma_f32_16x16x32_bf16(a, b, c, 0, 0, 0)
__device__ __forceinline__ unsigned row_base(unsigned lane, unsigned s) { return row_addr16(lane, 0, s); }
__device__ __forceinline__ unsigned tr_base(unsigned lane, unsigned c, unsigned t) { return tr_addr16(lane, c, 0, t); }
#define ROWF(img, base, off) (*(const LAS bf16x8*)((img) + (base) + (off)))
__device__ __forceinline__ bf16x8 trf(LAS unsigned char* img, unsigned b0, unsigned b1, unsigned off) {
    const s16x4 a = __builtin_amdgcn_ds_read_tr16_b64_v4i16((LAS s16x4*)(img + b0 + off));
    const s16x4 b = __builtin_amdgcn_ds_read_tr16_b64_v4i16((LAS s16x4*)(img + b1 + off));
    return __builtin_shufflevector(a, b, 0, 1, 2, 3, 4, 5, 6, 7);
}

__device__ __forceinline__ void spatial_unit(Frame& F, const Args& a, int n, int g) {
    LAS unsigned char* Wimg = F.lds; LAS unsigned char* Vimg = F.lds + 32768; LAS float* stats = (LAS float*)(F.lds + 65536);
    const int t0 = n * 128, ch0 = g * 128, tid = F.tid, lane = F.lane, w = F.wave;
    const bf16_t* V = (const bf16_t*)(F.ws + WS_V); const bf16_t* U = (const bf16_t*)(F.ws + WS_U); bf16_t* SG = (bf16_t*)(F.ws + WS_SG);
    const float* vstat = (const float*)(F.ws + WS_VSTAT);
    if (tid < 128) { const f32x4* p = (const f32x4*)(vstat + (size_t)(t0 + tid) * 32); float s = 0.f, q = 0.f;
#pragma unroll
        for (int j = 0; j < 8; ++j) { const f32x4 v = p[j]; s += v[0] + v[2]; q += v[1] + v[3]; }
        const float mean = s * (1.f / GW), var = q * (1.f / GW) - mean * mean;
        stats[2 * tid] = mean; stats[2 * tid + 1] = 1.0f / sqrtf(fmaxf(var, 0.f) + EPS); }
    const float* ws_g = a.in[5] + (size_t)g * 128 * 128;
#pragma unroll
    for (int i = 0; i < 4; ++i) { const int id = tid + 512 * i, t = id >> 4, ch = id & 15;
        const f32x4 x0 = *(const f32x4*)(ws_g + t * 128 + 8 * ch), x1 = *(const f32x4*)(ws_g + t * 128 + 8 * ch + 4);
        float v[8] = {x0[0], x0[1], x0[2], x0[3], x1[0], x1[1], x1[2], x1[3]};
#pragma unroll
        for (int j = 0; j < 8; ++j) v[j] = (8 * ch + j <= t) ? v[j] : 0.f;
        u32x4 o; o.x = cvt_pk_bf16(v[0], v[1]); o.y = cvt_pk_bf16(v[2], v[3]); o.z = cvt_pk_bf16(v[4], v[5]); o.w = cvt_pk_bf16(v[6], v[7]);
        *(LAS u32x4*)(Wimg + off_b(t, ch)) = o; }
    __syncthreads();
    const float* lng = a.in[3]; const float* lnb = a.in[4];
    {
        u32x4 xv[4]; const int ch = tid & 15;
#pragma unroll
        for (int i = 0; i < 4; ++i) xv[i] = __builtin_nontemporal_load((const u32x4*)(V + (size_t)(t0 + (tid >> 4) + 32 * i) * GW + ch0 + 8 * ch));
        const f32x4 g0 = *(const f32x4*)(lng + ch0 + 8 * ch), g1 = *(const f32x4*)(lng + ch0 + 8 * ch + 4), b0 = *(const f32x4*)(lnb + ch0 + 8 * ch), b1 = *(const f32x4*)(lnb + ch0 + 8 * ch + 4);
#pragma unroll
        for (int i = 0; i < 4; ++i) { const int s = (tid >> 4) + 32 * i; const u32x4 x = xv[i];
            const float mean = stats[2 * s], rstd = stats[2 * s + 1];
            float v[8] = {bf_lo(x.x), bf_hi(x.x), bf_lo(x.y), bf_hi(x.y), bf_lo(x.z), bf_hi(x.z), bf_lo(x.w), bf_hi(x.w)};
#pragma unroll
            for (int j = 0; j < 4; ++j) { v[j] = (v[j] - mean) * rstd * g0[j] + b0[j]; v[4 + j] = (v[4 + j] - mean) * rstd * g1[j] + b1[j]; }
            u32x4 o; o.x = cvt_pk_bf16(v[0], v[1]); o.y = cvt_pk_bf16(v[2], v[3]); o.z = cvt_pk_bf16(v[4], v[5]); o.w = cvt_pk_bf16(v[6], v[7]);
            *(LAS u32x4*)(Vimg + off_b(s, ch)) = o; }
    }
    __syncthreads();
    f32x4 acc[8];
#pragma unroll
    for (int c = 0; c < 8; ++c) acc[c] = (f32x4){0.f, 0.f, 0.f, 0.f};
    const int ksmax = w >> 1;
    {
        unsigned vb[8][2];
#pragma unroll
        for (int c = 0; c < 8; ++c) { vb[c][0] = tr_base(lane, c, 0); vb[c][1] = tr_base(lane, c, 1); }
        LAS unsigned char* Wrow = Wimg + 4096 * w;
#pragma unroll
        for (int ks = 0; ks < 4; ++ks) if (ks <= ksmax) {
            const bf16x8 y = ROWF(Wrow, row_base(lane, ks), 0);
            bf16x8 xf[8];
#pragma unroll
            for (int c = 0; c < 8; ++c) xf[c] = trf(Vimg, vb[c][0], vb[c][1], 8192 * ks);
            __builtin_amdgcn_sched_barrier(0);
#pragma unroll
            for (int c = 0; c < 8; ++c) acc[c] = MFMA16(xf[c], y, acc[c]);
            __builtin_amdgcn_sched_barrier(0);
        }
    }
    {
        LAS unsigned char* MT = F.lds + 66560;
        const int t = 16 * w + (lane & 15); const float bias = a.in[6][g * 128 + t];
#pragma unroll
        for (int c = 0; c < 8; ++c) *(LAS f32x4*)(MT + t * 528 + (16 * c + 4 * (lane >> 4)) * 4) = acc[c] + bias;
        __syncthreads();
        u32x4 uu[4];
#pragma unroll
        for (int i = 0; i < 4; ++i) uu[i] = __builtin_nontemporal_load((const u32x4*)(U + (size_t)(t0 + (tid >> 4) + 32 * i) * GW + ch0 + 8 * (tid & 15)));
#pragma unroll
        for (int i = 0; i < 4; ++i) { const int tt = (tid >> 4) + 32 * i, ch = tid & 15;
            const f32x4 m0 = *(const LAS f32x4*)(MT + tt * 528 + ch * 32), m1 = *(const LAS f32x4*)(MT + tt * 528 + ch * 32 + 16);
            const u32x4 u4 = uu[i];
            u32x4 r; r.x = cvt_pk_bf16(bf_lo(u4.x) * m0[0], bf_hi(u4.x) * m0[1]); r.y = cvt_pk_bf16(bf_lo(u4.y) * m0[2], bf_hi(u4.y) * m0[3]);
            r.z = cvt_pk_bf16(bf_lo(u4.z) * m1[0], bf_hi(u4.z) * m1[1]); r.w = cvt_pk_bf16(bf_lo(u4.w) * m1[2], bf_hi(u4.w) * m1[3]);
            *(u32x4*)(SG + (size_t)(t0 + tt) * GW + ch0 + 8 * ch) = r; }
    }
    __syncthreads();
}

__device__ __forceinline__ void kv_unit(Frame& F, const Args& a, int c, int h) {
    LAS unsigned char* Kimg = F.lds; LAS unsigned char* Vimg = F.lds + 32768;
    const int t0 = c * 128, tid = F.tid, lane = F.lane, w = F.wave;
    const bf16_t* Kb = (const bf16_t*)(F.ws + WS_K); const bf16_t* RV = (const bf16_t*)(F.ws + WS_RV); float* KV = (float*)(F.ws + WS_KV);
    const float l2g = a.l2g[h];
    {
        u32x4 kx[4], vx[8];
#pragma unroll
        for (int i = 0; i < 4; ++i) kx[i] = *(const u32x4*)(Kb + (size_t)(t0 + (tid >> 4) + 32 * i) * QKW + h * 128 + 8 * (tid & 15));
#pragma unroll
        for (int i = 0; i < 8; ++i) vx[i] = *(const u32x4*)(RV + (size_t)(t0 + (tid >> 5) + 16 * i) * D + h * 256 + 8 * (tid & 31));
#pragma unroll
        for (int i = 0; i < 4; ++i) *(LAS u32x4*)(Kimg + off_b((tid >> 4) + 32 * i, tid & 15)) = kx[i];
#pragma unroll
        for (int i = 0; i < 8; ++i) { const int s = (tid >> 5) + 16 * i, ch = tid & 31; const u32x4 x = vx[i]; const float z = exp2f((float)(127 - s) * l2g);
            u32x4 o; o.x = cvt_pk_bf16(bf_lo(x.x) * z, bf_hi(x.x) * z); o.y = cvt_pk_bf16(bf_lo(x.y) * z, bf_hi(x.y) * z); o.z = cvt_pk_bf16(bf_lo(x.z) * z, bf_hi(x.z) * z); o.w = cvt_pk_bf16(bf_lo(x.w) * z, bf_hi(x.w) * z);
            *(LAS u32x4*)(Vimg + (ch >> 4) * 32768 + off_b(s, ch & 15)) = o; }
    }
    __syncthreads();
    f32x4 acc[2][8];
#pragma unroll
    for (int j = 0; j < 2; ++j)
#pragma unroll
        for (int cd = 0; cd < 8; ++cd) acc[j][cd] = (f32x4){0.f, 0.f, 0.f, 0.f};
    LAS unsigned char* vi = Vimg + (w >> 2) * 32768; const int cimg = (2 * w) & 7;
    {
        unsigned kb[8][2], vb[2][2];
#pragma unroll
        for (int cd = 0; cd < 8; ++cd) { kb[cd][0] = tr_base(lane, cd, 0); kb[cd][1] = tr_base(lane, cd, 1); }
#pragma unroll
        for (int j = 0; j < 2; ++j) { vb[j][0] = tr_base(lane, cimg + j, 0); vb[j][1] = tr_base(lane, cimg + j, 1); }
#pragma unroll
        for (int ks = 0; ks < 4; ++ks) {
            const bf16x8 y0 = trf(vi, vb[0][0], vb[0][1], 8192 * ks), y1 = trf(vi, vb[1][0], vb[1][1], 8192 * ks);
            bf16x8 xf[8];
#pragma unroll
            for (int cd = 0; cd < 8; ++cd) xf[cd] = trf(Kimg, kb[cd][0], kb[cd][1], 8192 * ks);
            __builtin_amdgcn_sched_barrier(0);
#pragma unroll
            for (int cd = 0; cd < 8; ++cd) { acc[0][cd] = MFMA16(xf[cd], y0, acc[0][cd]); acc[1][cd] = MFMA16(xf[cd], y1, acc[1][cd]); }
            __builtin_amdgcn_sched_barrier(0);
        }
    }
    bf16_t* out = (bf16_t*)KV + (size_t)(c * 8 + h) * 32768;
    __syncthreads();
    LAS unsigned char* KT = F.lds;
#pragma unroll
    for (int j = 0; j < 2; ++j)
#pragma unroll
        for (int cd = 0; cd < 8; ++cd) { const int e = 16 * (2 * w + j) + (lane & 15), d = 16 * cd + 4 * (lane >> 4);
            u32x2 o; o.x = cvt_pk_bf16(acc[j][cd][0], acc[j][cd][1]); o.y = cvt_pk_bf16(acc[j][cd][2], acc[j][cd][3]); *(LAS u32x2*)(KT + e * 272 + d * 2) = o; }
    __syncthreads();
#pragma unroll
    for (int i = 0; i < 8; ++i) { const int id = tid + 512 * i, e = id >> 4, ch = id & 15;
        *(u32x4*)(out + e * 128 + 8 * ch) = *(const LAS u32x4*)(KT + e * 272 + 16 * ch); }
    __syncthreads();
}

__device__ __forceinline__ void scan_phase(Frame& F, const Args& a, int bi, int nb) {
    const unsigned* KV = (const unsigned*)(F.ws + WS_KV); unsigned* ST = (unsigned*)(F.ws + WS_ST);
    for (int pb = bi * NTHREADS; pb < 131072; pb += nb * NTHREADS) {
        const int h = __builtin_amdgcn_readfirstlane(pb >> 14); const unsigned qo = (unsigned)(pb & 16383) + (unsigned)F.tid; const float dh = exp2f(128.0f * a.l2g[h]);
        const unsigned* kvb = KV + (size_t)h * 16384; unsigned* stb = ST + (size_t)h * 16384;
        float s0 = 0.f, s1 = 0.f;
        {
            unsigned kv[NCHUNK];
#pragma unroll
            for (int j = 0; j < NCHUNK; ++j) kv[j] = __builtin_nontemporal_load(kvb + (size_t)j * 131072 + qo);
#pragma unroll
            for (int j = 0; j < NCHUNK; ++j) { (stb + (size_t)j * 131072)[qo] = cvt_pk_bf16(s0, s1); s0 = s0 * dh + bf_lo(kv[j]); s1 = s1 * dh + bf_hi(kv[j]); }
        }
    }
}

__device__ __forceinline__ void ret_unit(Frame& F, const Args& a, int c, int h) {
    LAS unsigned char* Qimg = F.lds; LAS unsigned char* Kimg = F.lds + 32768; LAS unsigned char* Vimg = F.lds + 65536;
    LAS float* part = (LAS float*)(F.lds + AUX_OFF); LAS float* stats = (LAS float*)(F.lds + AUX_OFF + 8192);
    const int t0 = c * 128, tid = F.tid, lane = F.lane, w = F.wave;
    const bf16_t* Qb = (const bf16_t*)(F.ws + WS_Q); const bf16_t* Kb = (const bf16_t*)(F.ws + WS_K); const bf16_t* RV = (const bf16_t*)(F.ws + WS_RV);
    const bf16_t* RG = (const bf16_t*)(F.ws + WS_RG); const bf16_t* ST = (const bf16_t*)(F.ws + WS_ST); bf16_t* RO = (bf16_t*)(F.ws + WS_RO);
    const float l2g = a.l2g[h];
    bf16x8 stf[2][4];
#pragma unroll
    for (int j = 0; j < 2; ++j)
#pragma unroll
        for (int ks = 0; ks < 4; ++ks) stf[j][ks] = __builtin_nontemporal_load((const bf16x8*)(ST + (size_t)(c * 8 + h) * 32768 + (16 * (2 * w + j) + (lane & 15)) * 128 + 32 * ks + 8 * (lane >> 4)));
    {
        u32x4 qx[4], kx[4], vx[8];
#pragma unroll
        for (int i = 0; i < 4; ++i) { const size_t o = (size_t)(t0 + (tid >> 4) + 32 * i) * QKW + h * 128 + 8 * (tid & 15); qx[i] = __builtin_nontemporal_load((const u32x4*)(Qb + o)); kx[i] = __builtin_nontemporal_load((const u32x4*)(Kb + o)); }
#pragma unroll
        for (int i = 0; i < 8; ++i) vx[i] = __builtin_nontemporal_load((const u32x4*)(RV + (size_t)(t0 + (tid >> 5) + 16 * i) * D + h * 256 + 8 * (tid & 31)));
#pragma unroll
        for (int i = 0; i < 4; ++i) { const unsigned o = off_b((tid >> 4) + 32 * i, tid & 15); *(LAS u32x4*)(Qimg + o) = qx[i]; *(LAS u32x4*)(Kimg + o) = kx[i]; }
#pragma unroll
        for (int i = 0; i < 8; ++i) *(LAS u32x4*)(Vimg + ((tid & 31) >> 4) * 32768 + off_b((tid >> 5) + 16 * i, tid & 15)) = vx[i];
    }
    __syncthreads();
    u32x2 pk[8];
    const int csmax = (w | 1);
    unsigned rb4[4];
#pragma unroll
    for (int ks = 0; ks < 4; ++ks) rb4[ks] = row_base(lane, ks);
    {
        bf16x8 yq[4];
#pragma unroll
        for (int ks = 0; ks < 4; ++ks) yq[ks] = ROWF(Qimg + 4096 * w, rb4[ks], 0);
        const int tt = 16 * w + (lane & 15);
#pragma unroll
        for (int cs = 0; cs < 8; ++cs) {
            pk[cs] = (u32x2){0u, 0u};
            if (cs <= csmax) {
                f32x4 sacc = (f32x4){0.f, 0.f, 0.f, 0.f};
                bf16x8 kf[4];
#pragma unroll
                for (int ks = 0; ks < 4; ++ks) kf[ks] = ROWF(Kimg, rb4[ks], 4096 * cs);
                __builtin_amdgcn_sched_barrier(0);
#pragma unroll
                for (int ks = 0; ks < 4; ++ks) sacc = MFMA16(kf[ks], yq[ks], sacc);
                float v[4];
#pragma unroll
                for (int r = 0; r < 4; ++r) { const int ss = 16 * cs + 4 * (lane >> 4) + r; v[r] = (tt >= ss) ? sacc[r] * exp2f((float)(tt - ss) * l2g) : 0.f; }
                pk[cs].x = cvt_pk_bf16(v[0], v[1]); pk[cs].y = cvt_pk_bf16(v[2], v[3]);
            }
        }
    }
    f32x4 acc[2][8];
#pragma unroll
    for (int j = 0; j < 2; ++j)
#pragma unroll
        for (int ct = 0; ct < 8; ++ct) acc[j][ct] = (f32x4){0.f, 0.f, 0.f, 0.f};
#pragma unroll
    for (int ct = 0; ct < 8; ++ct) {
        bf16x8 yy[4];
#pragma unroll
        for (int ks = 0; ks < 4; ++ks) yy[ks] = ROWF(Qimg, rb4[ks], 4096 * ct);
        __builtin_amdgcn_sched_barrier(0);
#pragma unroll
        for (int ks = 0; ks < 4; ++ks) { acc[0][ct] = MFMA16(stf[0][ks], yy[ks], acc[0][ct]); acc[1][ct] = MFMA16(stf[1][ks], yy[ks], acc[1][ct]); }
        const float xi = exp2f((float)(16 * ct + (lane & 15) + 1) * l2g);
        acc[0][ct] *= xi; acc[1][ct] *= xi;
        __builtin_amdgcn_sched_barrier(0);
    }
    __syncthreads();
    LAS unsigned char* Pimg = Kimg;
    {
        const int tt = 16 * w + (lane & 15);
#pragma unroll
        for (int cs = 0; cs < 8; ++cs) if (cs <= csmax) *(LAS u32x2*)(Pimg + off_b(tt, 2 * cs + (lane >> 5)) + 8 * ((lane >> 4) & 1)) = pk[cs];
    }
    __syncthreads();
    {
        LAS unsigned char* vi = Vimg + (w >> 2) * 32768; const int cimg = (2 * w) & 7;
        unsigned vb[2][2];
#pragma unroll
        for (int j = 0; j < 2; ++j) { vb[j][0] = tr_base(lane, cimg + j, 0); vb[j][1] = tr_base(lane, cimg + j, 1); }
        bf16x8 xv[2][4];
#pragma unroll
        for (int ks = 0; ks < 4; ++ks) { xv[0][ks] = trf(vi, vb[0][0], vb[0][1], 8192 * ks); xv[1][ks] = trf(vi, vb[1][0], vb[1][1], 8192 * ks); }
#pragma unroll
        for (int ct = 0; ct < 8; ++ct) {
            bf16x8 yy[4];
#pragma unroll
            for (int ks = 0; ks < 4; ++ks) if (ks <= (ct >> 1)) yy[ks] = ROWF(Pimg, rb4[ks], 4096 * ct);
            __builtin_amdgcn_sched_barrier(0);
#pragma unroll
            for (int ks = 0; ks < 4; ++ks) if (ks <= (ct >> 1)) { acc[0][ct] = MFMA16(xv[0][ks], yy[ks], acc[0][ct]); acc[1][ct] = MFMA16(xv[1][ks], yy[ks], acc[1][ct]); }
            __builtin_amdgcn_sched_barrier(0);
        }
    }
    {
        float s8[8], q8[8];
#pragma unroll
        for (int ct = 0; ct < 8; ++ct) { float s = 0.f, q = 0.f;
#pragma unroll
            for (int j = 0; j < 2; ++j)
#pragma unroll
                for (int r = 0; r < 4; ++r) { const float v = acc[j][ct][r]; s += v; q += v * v; }
            s8[ct] = s; q8[ct] = q; }
        float s16[8], q16[8];
#pragma unroll
        for (int ct = 0; ct < 8; ++ct) { s16[ct] = __shfl_xor(s8[ct], 16); q16[ct] = __shfl_xor(q8[ct], 16); }
        __builtin_amdgcn_sched_barrier(0);
#pragma unroll
        for (int ct = 0; ct < 8; ++ct) { s8[ct] += s16[ct]; q8[ct] += q16[ct]; }
#pragma unroll
        for (int ct = 0; ct < 8; ++ct) { s16[ct] = __shfl_xor(s8[ct], 32); q16[ct] = __shfl_xor(q8[ct], 32); }
        __builtin_amdgcn_sched_barrier(0);
#pragma unroll
        for (int ct = 0; ct < 8; ++ct) { const float s = s8[ct] + s16[ct], q = q8[ct] + q16[ct];
            if ((lane >> 4) == 0) { part[((16 * ct + lane) * 8 + w) * 2] = s; part[((16 * ct + lane) * 8 + w) * 2 + 1] = q; } }
    }
    __syncthreads();
    if (tid < 128) { float s = 0.f, q = 0.f;
#pragma unroll
        for (int j = 0; j < 8; ++j) { s += part[(tid * 8 + j) * 2]; q += part[(tid * 8 + j) * 2 + 1]; }
        const float mean = s * (1.f / 256.f), var = q * (1.f / 256.f) - mean * mean;
        stats[2 * tid] = mean; stats[2 * tid + 1] = 1.0f / sqrtf(fmaxf(var, 0.f) + EPS); }
    __syncthreads();
    {
        LAS unsigned char* OT = F.lds;
#pragma unroll
        for (int ct = 0; ct < 8; ++ct) { const int tt = 16 * ct + (lane & 15); const float mean = stats[2 * tt], rstd = stats[2 * tt + 1];
#pragma unroll
            for (int j = 0; j < 2; ++j) { const f32x4 v = (acc[j][ct] - mean) * rstd; u32x2 r; r.x = cvt_pk_bf16(v[0], v[1]); r.y = cvt_pk_bf16(v[2], v[3]);
                *(LAS u32x2*)(OT + tt * 528 + (16 * (2 * w + j) + 4 * (lane >> 4)) * 2) = r; } }
        __syncthreads();
        u32x4 gx[8];
#pragma unroll
        for (int i = 0; i < 8; ++i) gx[i] = __builtin_nontemporal_load((const u32x4*)(RG + (size_t)(t0 + (tid >> 5) + 16 * i) * D + h * 256 + 8 * (tid & 31)));
#pragma unroll
        for (int i = 0; i < 8; ++i) { const int tt = (tid >> 5) + 16 * i, ch = tid & 31;
            const u32x4 v = *(const LAS u32x4*)(OT + tt * 528 + ch * 16); const u32x4 g = gx[i];
            u32x4 r; r.x = cvt_pk_bf16(bf_lo(v.x) * bf_lo(g.x), bf_hi(v.x) * bf_hi(g.x)); r.y = cvt_pk_bf16(bf_lo(v.y) * bf_lo(g.y), bf_hi(v.y) * bf_hi(g.y));
            r.z = cvt_pk_bf16(bf_lo(v.z) * bf_lo(g.z), bf_hi(v.z) * bf_hi(g.z)); r.w = cvt_pk_bf16(bf_lo(v.w) * bf_lo(g.w), bf_hi(v.w) * bf_hi(g.w));
            *(u32x4*)(RO + (size_t)(t0 + tt) * D + h * 256 + 8 * ch) = r; }
    }
    __syncthreads();
}

__device__ __forceinline__ void router_tile(Frame& F, const Args& a, int tile) {
    LAS float* part = (LAS float*)F.lds;
    LAS int* cntl = (LAS int*)(F.lds + 40960); LAS int* basel = cntl + 32;
    const int tid = F.tid, lane = F.lane, w = F.wave, ts = w & 1, kq = w >> 1, i = lane & 31, kh = lane >> 5;
    const int tok = tile * 64 + 32 * ts + i;
    const float* X1 = (const float*)(F.ws + WS_X1); const float* SS = (const float*)(F.ws + WS_SS); unsigned char* H2 = (unsigned char*)(F.ws + WS_H);
    const float* g2 = a.in[10]; const float* rw = a.in[11]; const float* rb = a.in[12];
    if (tid < 32) cntl[tid] = 0;
    float ssum = 0.f;
#pragma unroll
    for (int j = 0; j < 8; ++j) { const f32x4 v = *(const f32x4*)(SS + (size_t)tok * 32 + 4 * j); ssum += (v[0] + v[1]) + (v[2] + v[3]); }
    const float rstd = 1.0f / sqrtf(ssum * (1.f / D) + EPS);
    f32x16 acc;
#pragma unroll
    for (int r = 0; r < 16; ++r) acc[r] = 0.f;
    LAS float* rwl = (LAS float*)(F.lds + 49152); LAS float* g2l = (LAS float*)(F.lds + 114688);
    { const f32x4 gv = *(const f32x4*)(g2 + 4 * tid); *(LAS f32x4*)(g2l + 4 * tid) = gv; }
    const unsigned rwl_u = (unsigned)__builtin_amdgcn_readfirstlane((int)((unsigned)(size_t)rwl + (unsigned)(kq * 8192 + ts * 4096)));
#define RW_STAGE(p_) do { const char* src_ = (const char*)(rw + (size_t)(512 * kq + 64 * (p_) + 32 * ts) * NE); const unsigned dst_ = rwl_u + (unsigned)(((p_) & 1) * 32768); \
        _Pragma("unroll") for (int j = 0; j < 4; ++j) pg8::glds16(src_, (unsigned)(lane * 16 + j * 1024), dst_ + (unsigned)(j * 1024)); } while (0)
    RW_STAGE(0);
    asm volatile("s_waitcnt vmcnt(0)" ::: "memory");
    {
        f32x4 xc[4]; float avp[16];
#pragma unroll
        for (int q = 0; q < 16; ++q) avp[q] = 0.f;
#define RT_LOAD(sc_, X) do { const int kb_ = 512 * kq + 64 * ((sc_) >> 1) + 32 * kh + 16 * ((sc_) & 1); \
            _Pragma("unroll") for (int q = 0; q < 4; ++q) X[q] = __builtin_nontemporal_load((const f32x4*)(X1 + (size_t)tok * D + kb_ + 4 * q)); } while (0)
        RT_LOAD(0, xc);
#pragma unroll 1
        for (int sc = 0; sc < 16; ++sc) {
            if ((sc & 1) == 0) {
                asm volatile("s_waitcnt lgkmcnt(0)" ::: "memory"); __builtin_amdgcn_s_barrier(); asm volatile("" ::: "memory");
                if (sc < 14) RW_STAGE((sc >> 1) + 1); }
            const int kb = 512 * kq + 64 * (sc >> 1) + 32 * kh + 16 * (sc & 1);
            f32x4 xn[4];
            { const int sn = sc < 15 ? sc + 1 : 15; RT_LOAD(sn, xn); }
            f32x4 gc[4]; float bc[16];
#pragma unroll
            for (int q = 0; q < 4; ++q) gc[q] = *(const LAS f32x4*)(g2l + kb + 4 * q);
            { const LAS float* rwb = rwl + ((sc >> 1) & 1) * 8192 + kq * 2048 + (32 * kh + 16 * (sc & 1)) * 32 + i;
#pragma unroll
              for (int q = 0; q < 16; ++q) bc[q] = rwb[q * 32]; }
            float av[16];
#pragma unroll
            for (int q = 0; q < 4; ++q) { av[4 * q] = xc[q][0] * rstd * gc[q][0]; av[4 * q + 1] = xc[q][1] * rstd * gc[q][1]; av[4 * q + 2] = xc[q][2] * rstd * gc[q][2]; av[4 * q + 3] = xc[q][3] * rstd * gc[q][3]; }
            if (sc & 1) {
                float v32[32];
#pragma unroll
                for (int q = 0; q < 16; ++q) { v32[q] = avp[q]; v32[16 + q] = av[q]; }
                u32x4 lo, hi; q6_block(v32, lo, hi);
                const int k0 = kb - 16, b32 = k0 >> 5;
                unsigned char* base = H2 + (size_t)tok * D + 128 * (b32 >> 2) + 16 * (b32 & 3);
                *(u32x4*)base = lo; *(u32x4*)(base + 64) = hi;
            }
#pragma unroll
            for (int q = 0; q < 16; ++q) avp[q] = av[q];
#pragma unroll
            for (int q = 0; q < 16; ++q) acc = __builtin_amdgcn_mfma_f32_32x32x2f32(av[q], bc[q], acc, 0, 0, 0);
#pragma unroll
            for (int q = 0; q < 4; ++q) xc[q] = xn[q];
        }
#undef RT_LOAD
#undef RW_STAGE
    }
#pragma unroll
    for (int r = 0; r < 16; ++r) { const int row = (r & 3) + 8 * (r >> 2) + 4 * kh; part[((kq * 2 + ts) * 32 + row) * 33 + i] = acc[r]; }
    __syncthreads();
    int te[4] = {0, 0, 0, 0}; float tv[4] = {-3.0e38f, -3.0e38f, -3.0e38f, -3.0e38f}; int lr[4] = {0, 0, 0, 0};
    if (tid < 64) {
        const int tsl = tid >> 5, rowl = tid & 31;
        for (int e = 0; e < NE; ++e) {
            float lg = rb[e];
#pragma unroll
            for (int q = 0; q < 4; ++q) lg += part[((q * 2 + tsl) * 32 + rowl) * 33 + e];
            if (lg > tv[3]) { tv[3] = lg; te[3] = e;
#pragma unroll
                for (int j = 3; j > 0; --j) if (tv[j] > tv[j - 1]) { const float fv = tv[j]; tv[j] = tv[j - 1]; tv[j - 1] = fv; const int iv = te[j]; te[j] = te[j - 1]; te[j - 1] = iv; } }
        }
#pragma unroll
        for (int k = 0; k < 4; ++k) lr[k] = __hip_atomic_fetch_add(&cntl[te[k]], 1, __ATOMIC_RELAXED, __HIP_MEMORY_SCOPE_WORKGROUP);
    }
    __syncthreads();
    if (tid < 32) { const int cn = cntl[tid]; int base = 0; if (cn > 0) base = (int)__hip_atomic_fetch_add((unsigned*)(F.ws + WS_CTL) + CW_CNT + 16 * tid, (unsigned)cn, __ATOMIC_RELAXED, __HIP_MEMORY_SCOPE_AGENT); basel[tid] = base; }
    __syncthreads();
    if (tid < 64) {
        const int t = tile * 64 + tid;
        int* TOKE = (int*)(F.ws + WS_TOKE); int* TOKR = (int*)(F.ws + WS_TOKR); float* TOKW = (float*)(F.ws + WS_TOKW); int* ROWTOK = (int*)(F.ws + WS_ROWTOK);
        float ex[4], sum = 0.f;
#pragma unroll
        for (int k = 0; k < 4; ++k) { ex[k] = __expf(tv[k] - tv[0]); sum += ex[k]; }
        const float inv = 1.0f / sum;
#pragma unroll
        for (int k = 0; k < 4; ++k) { const int rank = basel[te[k]] + lr[k]; TOKE[t * 4 + k] = te[k]; TOKR[t * 4 + k] = rank; TOKW[t * 4 + k] = ex[k] * inv; ROWTOK[te[k] * T + rank] = t * 4 + k; }
    }
    __syncthreads();
}

__device__ __forceinline__ void moe_table(Frame& F, LAS int* cnt, LAS int* tall, LAS int* tfull, LAS int* tsmall, LAS int* thalf) {
    if (F.tid < 64) {
        const int e = F.lane; int c = 0;
        if (e < NE) c = (int)__hip_atomic_load((unsigned*)(F.ws + WS_CTL) + CW_CNT + 16 * e, __ATOMIC_RELAXED, __HIP_MEMORY_SCOPE_AGENT);
        const int tl = (c + 255) >> 8; const int rem = c - 256 * (tl - 1); const int sm = (MK_HM && tl > 0 && rem <= 128) ? 1 : 0;
        int ia = tl, is = sm;
#pragma unroll
        for (int o = 1; o < 32; o <<= 1) { const int va = __shfl_up(ia, o), vs = __shfl_up(is, o); if ((F.lane & 31) >= o) { ia += va; is += vs; } }
        if (e < NE) { cnt[e] = c; tall[e + 1] = ia; tsmall[e + 1] = is; tfull[e + 1] = ia - is; thalf[e + 1] = 2 * ia; }
        if (e == 0) { tall[0] = 0; tsmall[0] = 0; tfull[0] = 0; thalf[0] = 0; }
    }
    __syncthreads();
}

__device__ __forceinline__ void combine_phase(Frame& F, const Args& a) {
    const int gw = F.vcu * NWAVES + F.wave, NGW = F.G * NWAVES, lane = F.lane;
    const float* X1 = (const float*)(F.ws + WS_X1); const unsigned char* Y = (const unsigned char*)(F.ws + WS_Y);
    const int* TOKE = (const int*)(F.ws + WS_TOKE); const int* TOKR = (const int*)(F.ws + WS_TOKR); const float* TOKW = (const float*)(F.ws + WS_TOKW);
    const float* gf = a.in[17];
    f32x4 gfv[8];
#pragma unroll
    for (int j = 0; j < 8; ++j) gfv[j] = ((const f32x4*)gf)[lane + 64 * j];
    for (int t = gw; t < T; t += NGW) {
        f32x4 v[8]; unsigned yy[4][8];
#pragma unroll
        for (int j = 0; j < 8; ++j) v[j] = __builtin_nontemporal_load((const f32x4*)(X1 + (size_t)t * D) + lane + 64 * j);
        const f32x4 w4 = *(const f32x4*)(TOKW + (size_t)t * 4);
#pragma unroll
        for (int k = 0; k < 4; ++k) { const unsigned* yr = (const unsigned*)(Y + ((size_t)t * 4 + k) * D) + lane;
#pragma unroll
            for (int j = 0; j < 8; ++j) yy[k][j] = __builtin_nontemporal_load(yr + 64 * j); }
#pragma unroll
        for (int k = 0; k < 4; ++k) { const float wq = w4[k] * (1.0f / Y8_SCALE);
#pragma unroll
            for (int j = 0; j < 8; ++j) { const unsigned y = yy[k][j]; const f32x2 lo = __builtin_amdgcn_cvt_pk_f32_fp8((int)y, false), hi = __builtin_amdgcn_cvt_pk_f32_fp8((int)y, true);
                v[j][0] += wq * lo.x; v[j][1] += wq * lo.y; v[j][2] += wq * hi.x; v[j][3] += wq * hi.y; } }
        float s = 0.f;
#pragma unroll
        for (int j = 0; j < 8; ++j) s += (v[j][0] * v[j][0] + v[j][1] * v[j][1]) + (v[j][2] * v[j][2] + v[j][3] * v[j][3]);
        const float rstd = 1.0f / sqrtf(wave_sum(s) * (1.f / D) + EPS);
#pragma unroll
        for (int j = 0; j < 8; ++j) __builtin_nontemporal_store(v[j] * rstd * gfv[j], (f32x4*)(a.out + (size_t)t * D) + lane + 64 * j);
    }
}

__device__ __forceinline__ int reframe(Frame& F) { int t_ = threadIdx.x; asm volatile("" : "+v"(t_)); F.tid = t_; F.lane = t_ & 63; F.wave = __builtin_amdgcn_readfirstlane(t_ >> 6); return 0; }
constexpr int N_PHASES = 12;
__global__ void __launch_bounds__(NTHREADS, 2) mk_fwd(Args args) {
    extern __shared__ __attribute__((aligned(16))) unsigned char lds[];
    Frame F;
    F.lds = (LAS unsigned char*)lds;
    F.tid = threadIdx.x; F.lane = F.tid & 63; F.wave = __builtin_amdgcn_readfirstlane(F.tid >> 6);
    F.G = gridDim.x; { const int bx = blockIdx.x; F.vcu = (F.G % 8 == 0) ? (bx % 8) * (F.G / 8) + bx / 8 : bx; }
    F.ws = args.ws;
    volatile LAS unsigned* MISC = (volatile LAS unsigned*)(F.lds + MISC_OFF);
    for (int u = F.tid; u < (LDS_BYTES - MISC_OFF) / 4; u += NTHREADS) MISC[u] = 0u;
    __syncthreads();
    unsigned* ctl = (unsigned*)(F.ws + WS_CTL);
    XcdBarrier bar; bar.bar = ctl + CW_BAR; bar.x = 0; bar.st = nullptr;
    if (MK_N_LAUNCHES == 1) bar = xcd_barrier_post(ctl + CW_BAR, MISC + 8);
    const int lo = args.ph_lo, hi = args.ph_hi;
#define IN(k) ((((MK_PHASES) >> (k)) & 1) && lo <= (k) && (k) < hi)
#define SEAM(k) do { if (IN(k) && IN((k) + 1)) xcd_barrier(bar); } while (0)
    LAS int* mcnt = (LAS int*)(F.lds + MISC_OFF + 256); LAS int* mtstart = mcnt + 32; LAS int* mtfull = mcnt + 96; LAS int* mtsmall = mcnt + 160; LAS int* mthalf = mcnt + 224;

#define REFRAME() do { int t_ = threadIdx.x; asm volatile("" : "+v"(t_)); F.tid = t_; F.lane = t_ & 63; F.wave = __builtin_amdgcn_readfirstlane(t_ >> 6); } while (0)
#define REP(k) for (int rep_ = reframe(F); rep_ < (((MK_DUP) >> (k)) & 1) + 1; ++rep_)
#define REPBAR(k) do { if ((((MK_DUP) >> (k)) & 1) && rep_ == 0) xcd_barrier(bar); } while (0)
    if (IN(0)) REP(0) { p0_prologue(F, args); if (MK_CONV_IN_P0) conv_rest(F, args, F.vcu * NWAVES + F.wave, F.G * NWAVES); REPBAR(0); } SEAM(0);
    if (IN(1)) REP(1) {
        const int nconv = (MK_NCONV * F.G) / 256, ngemm = F.G - nconv;
        if ((int)blockIdx.x < ngemm) {
            pg8::DenseSched S; S.init((const bf16_t*)(F.ws + WS_H), D, (const bf16_t*)(F.ws + WS_WIN), D, T, INW, ngemm, (int)blockIdx.x);
            EpiInProj E{F.ws};
            if (MK_RSYNC) pg8::gemm_phase<0, EpiInProj, pg8::DenseSched, 127, 127, true>(F.lds, S, E, &bar); else pg8::gemm_phase<0>(F.lds, S, E);
        } else if (!MK_CONV_IN_P0) conv_rest(F, args, ((int)blockIdx.x - ngemm) * NWAVES + F.wave, nconv * NWAVES);
        REPBAR(1);
    } SEAM(1);
    if (IN(2)) REP(2) {
        if (MK_NSCAN == 0) for (int u = blockIdx.x; u < 1024; u += F.G) spatial_unit(F, args, u >> 3, u & 7);
        for (int u = blockIdx.x; u < 1024; u += F.G) kv_unit(F, args, u >> 3, u & 7);
        REPBAR(2);
    } SEAM(2);
    if (IN(3)) REP(3) {
        const int nscan = (MK_NSCAN * F.G) / 256, nsp = F.G - nscan;
        if (MK_NSCAN == 0) scan_phase(F, args, (int)blockIdx.x, F.G);
        else if ((int)blockIdx.x < nsp) { for (int u = blockIdx.x; u < 1024; u += nsp) spatial_unit(F, args, u >> 3, u & 7); }
        else scan_phase(F, args, (int)blockIdx.x - nsp, nscan);
        REPBAR(3);
    } SEAM(3);
    if (IN(4)) REP(4) { for (int u = blockIdx.x; u < 1024; u += F.G) ret_unit(F, args, u >> 3, u & 7); REPBAR(4); } SEAM(4);
    if (IN(5)) REP(5) {
        { pg8::DenseSched S; S.init((const bf16_t*)(F.ws + WS_SG), GW, (const bf16_t*)(F.ws + WS_WPA), GW, T, D, F.G, (int)blockIdx.x); EpiMerge<0> E{F.ws}; pg8::gemm_phase<0>(F.lds, S, E); }
        __syncthreads();
        { pg8::DenseSched S; S.init((const bf16_t*)(F.ws + WS_RO), D, (const bf16_t*)(F.ws + WS_WPR), D, T, D, F.G, (int)blockIdx.x); EpiMerge<1> E{F.ws}; pg8::gemm_phase<0>(F.lds, S, E); }
        REPBAR(5);
    } SEAM(5);
    if (IN(6)) REP(6) {
        pg8::DenseSched S; S.init((const bf16_t*)(F.ws + WS_MRG), D, (const bf16_t*)(F.ws + WS_WOUT), D, T, D, F.G, (int)blockIdx.x);
        EpiOut E{args.in[0], F.ws};
        pg8::gemm_phase<0>(F.lds, S, E); REPBAR(6);
    } SEAM(6);
    if (IN(7)) { REFRAME(); for (int tile = blockIdx.x; tile < T / 64; tile += F.G) router_tile(F, args, tile); } SEAM(7);
#define MOE_SCHED(SV, GATHER_, MODE_, A_, LDA_, BT_, K_, NB_, NN_, TS_) pg8::MoeSched<GATHER_, MODE_> SV; SV.A = (const bf16_t*)(A_); SV.lda = (LDA_); SV.Bt = (const bf16_t*)(BT_); SV.K = (K_); SV.NB = (NB_); SV.nN = (NN_); SV.tstart = (TS_); SV.tall = mtstart; \
        SV.cnt = mcnt; SV.rowtok = (GATHER_) ? (const int*)(F.ws + WS_ROWTOK) : nullptr; SV.aux = F.lds + AUX_OFF; SV.nwg = __builtin_amdgcn_readfirstlane((TS_)[NE]) * (NN_); SV.G = F.G; SV.c = (int)blockIdx.x; SV.ecur = 0
    if (IN(8)) REP(8) {
        moe_table(F, mcnt, mtstart, mtfull, mtsmall, mthalf);
        EpiGateUp E{args.in[14], F.ws};
        if (!MK_HM_TEST) { MOE_SCHED(S, true, 0, F.ws + WS_H, D / 2, F.ws + WS_WGU, D / 2, 4096, 16, mtfull); pg8::gemm_phase<2, EpiGateUp, pg8::MoeSched<true, 0>>(F.lds, S, E); }
        __syncthreads();
        if (MK_HM_TEST) { MOE_SCHED(S, true, 2, F.ws + WS_H, D / 2, F.ws + WS_WGU, D / 2, 4096, 16, mthalf); pg8::gemm_phase<2, EpiGateUp, pg8::MoeSched<true, 2>, 127, 127, false, true>(F.lds, S, E); }
        else if (MK_HM) { MOE_SCHED(S, true, 1, F.ws + WS_H, D / 2, F.ws + WS_WGU, D / 2, 4096, 16, mtsmall); pg8::gemm_phase<2, EpiGateUp, pg8::MoeSched<true, 1>, 127, 127, false, true>(F.lds, S, E); }
        REPBAR(8);
    } SEAM(8);
    if (IN(9)) REP(9) {
        moe_table(F, mcnt, mtstart, mtfull, mtsmall, mthalf);
        EpiDown E{args.in[16], F.ws, mcnt};
        if (!MK_HM_TEST) { MOE_SCHED(S, false, 0, F.ws + WS_ACT, DFF / 2, F.ws + WS_WDN, DFF / 2, 2048, 8, mtfull); pg8::gemm_phase<1, EpiDown, pg8::MoeSched<false, 0>, 117, 125>(F.lds, S, E); }
        __syncthreads();
        if (MK_HM_TEST) { MOE_SCHED(S, false, 2, F.ws + WS_ACT, DFF / 2, F.ws + WS_WDN, DFF / 2, 2048, 8, mthalf); pg8::gemm_phase<1, EpiDown, pg8::MoeSched<false, 2>, 117, 125, false, true>(F.lds, S, E); }
        else if (MK_HM) { MOE_SCHED(S, false, 1, F.ws + WS_ACT, DFF / 2, F.ws + WS_WDN, DFF / 2, 2048, 8, mtsmall); pg8::gemm_phase<1, EpiDown, pg8::MoeSched<false, 1>, 117, 125, false, true>(F.lds, S, E); }
        REPBAR(9);
    } SEAM(9);
#undef MOE_SCHED
    if (IN(10)) REP(10) { combine_phase(F, args); REPBAR(10); }
#undef REP
#undef REFRAME
#undef REPBAR
#undef IN
#undef SEAM
}

#include <cmath>
extern "C" void kernel_launch(void* const* d_in, const int* in_sizes, int n_in, void* d_out, int out_size, void* d_ws, size_t ws_size, hipStream_t stream) {
    static int grid = 0;
    if (grid == 0) {
        if (n_in != 18 || out_size != T * D || ws_size < WS_END) { fprintf(stderr, "kernel_launch: unexpected shapes (n_in %d out %d ws %zu need %zu)\n", n_in, out_size, ws_size, (size_t)WS_END); grid = -1; return; }
        int dev = 0, cus = 0, per_cu = 0;
        if (hipGetDevice(&dev) != hipSuccess || hipDeviceGetAttribute(&cus, hipDeviceAttributeMultiprocessorCount, dev) != hipSuccess) { grid = -1; return; }
        if (hipFuncSetAttribute((const void*)mk_fwd, hipFuncAttributeMaxDynamicSharedMemorySize, LDS_BYTES) != hipSuccess) { fprintf(stderr, "kernel_launch: hipFuncSetAttribute failed\n"); grid = -1; return; }
        if (hipOccupancyMaxActiveBlocksPerMultiprocessor(&per_cu, (const void*)mk_fwd, NTHREADS, LDS_BYTES) != hipSuccess || per_cu < 1) fprintf(stderr, "kernel_launch: occupancy query says %d\n", per_cu);
        (void)hipGetLastError();
        grid = cus;
    }
    if (grid < 0) return;
    (void)hipMemsetAsync((char*)d_ws + WS_CTL, 0, CTL_ZERO_BYTES, stream);
    Args a{};
    for (int i = 0; i < 18; ++i) a.in[i] = (const float*)d_in[i];
    a.out = (float*)d_out; a.ws = (unsigned char*)d_ws;
    for (int h = 0; h < 8; ++h) a.l2g[h] = (float)std::log2(1.0 - std::exp2(-5.0 - (double)h));
#if MK_N_LAUNCHES == 1
    a.ph_lo = 0; a.ph_hi = N_PHASES;
    hipLaunchKernelGGL(mk_fwd, dim3(grid), dim3(NTHREADS), LDS_BYTES, stream, a);
#else
    for (int p = 0; p < 11; ++p) { a.ph_lo = p; a.ph_hi = p + 1; hipLaunchKernelGGL(mk_fwd, dim3(grid), dim3(NTHREADS), LDS_BYTES, stream, a); }
#endif
}
```

```cpp
#include <hip/hip_runtime.h>
#include <cstdio>
#include <cstdint>

#ifndef MK_N_LAUNCHES
#define MK_N_LAUNCHES 1
#endif
#ifndef MK_PHASES
#define MK_PHASES 0xFFFF
#endif
#ifndef MK_NCONV
#define MK_NCONV 64
#endif
#ifndef MK_CONV_IN_P0
#define MK_CONV_IN_P0 0
#endif
#ifndef MK_RSYNC
#define MK_RSYNC 0
#endif
#ifndef MK_NSCAN
#define MK_NSCAN 0
#endif
#ifndef MK_HM
#define MK_HM 1
#endif
#ifndef MK_HM_TEST
#define MK_HM_TEST 0
#endif
#ifndef MK_DUP
#define MK_DUP 0
#endif

#define GAS __attribute__((address_space(1)))
#define LAS __attribute__((address_space(3)))
typedef unsigned short bf16_t;
typedef short bf16x8 __attribute__((ext_vector_type(8)));
typedef short s16x4 __attribute__((ext_vector_type(4)));
typedef float f32x4 __attribute__((ext_vector_type(4)));
typedef float f32x2 __attribute__((ext_vector_type(2)));
typedef float f32x16 __attribute__((ext_vector_type(16)));
typedef unsigned u32x4 __attribute__((ext_vector_type(4)));
typedef unsigned u32x2 __attribute__((ext_vector_type(2)));

constexpr int T = 16384, D = 2048, GW = 1024, QKW = 1024, INW = 12288, NE = 32, DFF = 2048;
constexpr int NCHUNK = 128, NH = 8;
constexpr float EPS = 1e-6f;
constexpr int NWAVES = 8, NTHREADS = 512;
constexpr int ACT_ROWS = 73728;
constexpr float W8_SCALE = 1024.0f, H8_SCALE = 16.0f, A8_SCALE = 4.0f, Y8_SCALE = 32.0f;

constexpr size_t MiB = 1u << 20;
constexpr size_t WS_CTL = 0, CTL_ZERO_BYTES = 1 * MiB;
constexpr size_t WS_WIN = 2 * MiB;
constexpr size_t WS_WPA = WS_WIN + 48 * MiB;
constexpr size_t WS_WPR = WS_WPA + 4 * MiB;
constexpr size_t WS_WOUT = WS_WPR + 8 * MiB;
constexpr size_t WS_WGU = WS_WOUT + 8 * MiB;
constexpr size_t WS_WDN = WS_WGU + 512 * MiB;
constexpr size_t WS_H = WS_WDN + 256 * MiB;
constexpr size_t WS_U = WS_H + 64 * MiB;
constexpr size_t WS_V = WS_U + 32 * MiB;
constexpr size_t WS_Q = WS_V + 32 * MiB;
constexpr size_t WS_K = WS_Q + 32 * MiB;
constexpr size_t WS_RV = WS_K + 32 * MiB;
constexpr size_t WS_RG = WS_RV + 64 * MiB;
constexpr size_t WS_GA = WS_RG + 64 * MiB;
constexpr size_t WS_GR = WS_GA + 64 * MiB;
constexpr size_t WS_VSTAT = WS_GR + 64 * MiB;
constexpr size_t WS_ROPEC = WS_VSTAT + 2 * MiB;
constexpr size_t WS_ROPES = WS_ROPEC + 4 * MiB;
constexpr size_t WS_SG = WS_ROPES + 4 * MiB;
constexpr size_t WS_KV = WS_SG + 32 * MiB;
constexpr size_t WS_ST = WS_KV + 128 * MiB;
constexpr size_t WS_RO = WS_ST + 64 * MiB;
constexpr size_t WS_MRG = WS_RO + 64 * MiB;
constexpr size_t WS_X1 = WS_MRG + 64 * MiB;
constexpr size_t WS_SS = WS_X1 + 128 * MiB;
constexpr size_t WS_TOKE = WS_SS + 2 * MiB;
constexpr size_t WS_TOKR = WS_TOKE + 1 * MiB;
constexpr size_t WS_TOKW = WS_TOKR + 1 * MiB;
constexpr size_t WS_ROWTOK = WS_TOKW + 1 * MiB;
constexpr size_t WS_ACT = WS_ROWTOK + 2 * MiB;
constexpr size_t WS_Y = WS_ACT + 288 * MiB;
constexpr size_t WS_END = WS_Y + 288 * MiB;
constexpr int CW_TMO = 0;
constexpr int CW_BAR = 4096;
constexpr int CW_CNT = 8192;
constexpr int CW_DBG = 12288;

constexpr int RING_BYTES = 131072;
constexpr int AUX_OFF = RING_BYTES;
constexpr int MISC_OFF = AUX_OFF + 12288;
constexpr int LDS_BYTES = 147456;

typedef __bf16 bf16x2_t __attribute__((ext_vector_type(2)));
__device__ __forceinline__ unsigned cvt_pk_bf16(float lo, float hi) { f32x2 v = {lo, hi}; bf16x2_t b = __builtin_convertvector(v, bf16x2_t); return __builtin_bit_cast(unsigned, b); }
__device__ __forceinline__ unsigned pk4_fp8(float a, float b, float c, float d) { int w = 0; w = __builtin_amdgcn_cvt_pk_fp8_f32(a, b, w, false); w = __builtin_amdgcn_cvt_pk_fp8_f32(c, d, w, true); return (unsigned)w; }
__device__ __forceinline__ float bf_lo(unsigned w) { return __uint_as_float(w << 16); }
__device__ __forceinline__ float bf_hi(unsigned w) { return __uint_as_float(w & 0xffff0000u); }
__device__ __forceinline__ float bf2f(bf16_t b) { return __uint_as_float(((unsigned)b) << 16); }
__device__ __forceinline__ float wave_sum(float v) {
#pragma unroll
    for (int o = 1; o < 64; o <<= 1) v += __shfl_xor(v, o);
    return v;
}
__device__ __forceinline__ float sigmoid_f(float x) { return __builtin_amdgcn_rcpf(1.0f + __expf(-x)); }
__device__ __forceinline__ f32x2 gelu_pk(f32x2 v) {
    const f32x2 av = __builtin_elementwise_abs(v), d = av * 0.2316418882f + 1.0f;
    f32x2 t; t.x = __builtin_amdgcn_rcpf(d.x); t.y = __builtin_amdgcn_rcpf(d.y);
    f32x2 q = t * 0.5307027145f + (-0.7265760135f); q = q * t + 0.7107068705f; q = q * t + (-0.142248368f); q = q * t + 0.127414796f; q = q * t;
    const f32x2 s = (v * v) * (-0.72134752044f);
    f32x2 e; e.x = __builtin_amdgcn_exp2f(s.x); e.y = __builtin_amdgcn_exp2f(s.y);
    const f32x2 m = v * (q * e), r = v - m;
    f32x2 o; o.x = v.x < 0.f ? m.x : r.x; o.y = v.y < 0.f ? m.y : r.y; return o;
}
__device__ __forceinline__ f32x4 gelu4(f32x4 v) { f32x2 a = gelu_pk((f32x2){v[0], v[1]}), b = gelu_pk((f32x2){v[2], v[3]}); return (f32x4){a.x, a.y, b.x, b.y}; }

#define XB_TMO      128
#define XB_XCNT(j)  (256  + 64 * (j))
#define XB_XSUB(j)  (1280 + 64 * (j))
#define XB_XGEN(j)  (2304 + 64 * (j))
#define XB_TOP      3328
#define XB_TOPGEN   3392
#define XCD_BAR_WORDS 3456
#define XB_SPIN_CAP (1u << 18)
__device__ __forceinline__ unsigned xb_ld(unsigned* p)              { return __hip_atomic_load(p, __ATOMIC_RELAXED, __HIP_MEMORY_SCOPE_AGENT); }
__device__ __forceinline__ unsigned xb_add(unsigned* p, unsigned v) { return __hip_atomic_fetch_add(p, v, __ATOMIC_RELAXED, __HIP_MEMORY_SCOPE_AGENT); }
__device__ __forceinline__ unsigned xb_xcc_id() { return (unsigned)__builtin_amdgcn_s_getreg((3 << 11) | 20) & 0xFu; }
#define XB_SPIN(cond, bar) do { unsigned _sp = 0; while (cond) { __builtin_amdgcn_s_sleep(1); \
    if ((++_sp & 255u) == 0u) { if (xb_ld(&(bar)[XB_TMO])) break; if (_sp > XB_SPIN_CAP) { atomicAdd(&(bar)[XB_TMO], 1u); break; } } } } while (0)
struct XcdBarrier { unsigned* bar; unsigned x; volatile LAS unsigned* st; };
__device__ __forceinline__ XcdBarrier xcd_barrier_post(unsigned* bar, volatile LAS unsigned* st) {
    XcdBarrier b; b.bar = bar; b.x = xb_xcc_id(); b.st = st;
    if (threadIdx.x == 0) (void)xb_add(&bar[XB_XCNT(b.x)], 1u);
    return b;
}
__device__ __forceinline__ void xcd_barrier_complete(unsigned* bar, unsigned x, unsigned& nloc, unsigned& nx) {
    const unsigned G = gridDim.x * gridDim.y * gridDim.z;
    unsigned sum, cnt, mine, sp = 0u;
    for (;;) {
        sum = 0u; cnt = 0u; mine = 0u;
#pragma unroll
        for (unsigned j = 0; j < 16; ++j) { const unsigned c = xb_ld(&bar[XB_XCNT(j)]); sum += c; cnt += (c > 0u) ? 1u : 0u; mine = (j == x) ? c : mine; }
        if (sum == G) break;
        __builtin_amdgcn_s_sleep(1);
        if ((++sp & 255u) == 0u) { if (xb_ld(&bar[XB_TMO])) break; if (sp > XB_SPIN_CAP) { atomicAdd(&bar[XB_TMO], 1u); break; } }
    }
    nloc = mine > 0u ? mine : 1u; nx = cnt > 0u ? cnt : 1u;
}
__device__ __forceinline__ void xcd_barrier(const XcdBarrier& b) {
    asm volatile("s_waitcnt vmcnt(0)" ::: "memory");
    __syncthreads();
    if (threadIdx.x == 0) {
        unsigned* bar = b.bar;
        __builtin_amdgcn_s_waitcnt(0);
        unsigned nloc = b.st[0], nx = b.st[1];
        if (nloc == 0u) { xcd_barrier_complete(bar, b.x, nloc, nx); b.st[0] = nloc; b.st[1] = nx; }
        const unsigned old = xb_add(&bar[XB_XSUB(b.x)], 1u);
        const unsigned gen = old / nloc;
        if (old + 1u == (gen + 1u) * nloc) {
            __builtin_amdgcn_fence(__ATOMIC_RELEASE, "agent");
            asm volatile("s_waitcnt vmcnt(0)" ::: "memory");
            const unsigned og = xb_add(&bar[XB_TOP], 1u);
            const unsigned tg = og / nx;
            if (og + 1u == (tg + 1u) * nx) xb_add(&bar[XB_TOPGEN], 1u);
            else XB_SPIN(xb_ld(&bar[XB_TOPGEN]) == tg, bar);
            __builtin_amdgcn_fence(__ATOMIC_ACQUIRE, "agent");
            xb_add(&bar[XB_XGEN(b.x)], 1u);
            asm volatile("s_waitcnt vmcnt(0)" ::: "memory");
        } else {
            XB_SPIN(xb_ld(&bar[XB_XGEN(b.x)]) == gen, bar);
            __builtin_amdgcn_fence(__ATOMIC_ACQUIRE, "agent");
            asm volatile("s_waitcnt vmcnt(0)" ::: "memory");
        }
    }
    __syncthreads();
}

namespace pg8 {
constexpr int BM = 256, BK = 64, HALF = 128, HTB = HALF * BK * 2, STAGE_BYTES = 8 * HTB, NXCD = 8, WGM = 4;
__host__ __device__ __forceinline__ int lds_byte(int r, int c) { const int st = (r >> 4) * 2 + (c >> 5), rr = r & 15, cc = c & 31, ob = rr * 64 + cc * 2; return st * 1024 + (ob ^ (((ob >> 9) & 1) << 5)); }
__host__ __device__ __forceinline__ void stage_rc(int b, int& R, int& C) { const int st = b / 1024, sb = b % 1024, swz = sb ^ (((sb >> 9) & 1) << 5); R = (st >> 1) * 16 + swz / 64; C = (st & 1) * 32 + (swz % 64) / 2; }
__host__ __device__ __forceinline__ int perm32(int rho) { const int n = rho >> 4, i = rho & 15; return 8 * (i >> 2) + 4 * n + (i & 3); }

struct Unit { int pm, pn, e, mt, hx; };

struct DenseSched {
    const bf16_t* A; int lda; const bf16_t* Bt; int K; int nM, nN, nwg, G, c;
    static constexpr bool kGather = false;
    __device__ __forceinline__ void init(const bf16_t* A_, int lda_, const bf16_t* Bt_, int K_, int M, int N, int G_, int c_) { A = A_; lda = lda_; Bt = Bt_; K = K_; nM = M / BM; nN = N / BM; nwg = nM * nN; G = G_; c = c_; }
    __device__ __forceinline__ bool next(int i, Unit& u) const {
        const long L = (long)i * G + c; if (L >= nwg) return false;
        int wgid = (int)L; { const int q = nwg / NXCD, r = nwg % NXCD, xcd = wgid % NXCD, off = wgid / NXCD; wgid = (xcd < r ? xcd * (q + 1) : r * (q + 1) + (xcd - r) * q) + off; }
        const int nig = WGM * nN, gid = wgid / nig, fm = gid * WGM, gsz = (nM - fm) < WGM ? (nM - fm) : WGM;
        u.pm = fm + ((wgid % nig) % gsz); u.pn = (wgid % nig) / gsz; u.e = 0; u.mt = u.pm; u.hx = 0; return true;
    }
    __device__ __forceinline__ const char* a_base(const Unit& u) const { return (const char*)A + (size_t)u.pm * BM * lda * 2; }
    __device__ __forceinline__ const char* b_base(const Unit& u) const { return (const char*)Bt + (size_t)u.pn * BM * K * 2; }
    __device__ __forceinline__ void a_offs(const Unit&, const int (&R)[2], const int (&C)[2], unsigned (&off)[2][2]) const {
#pragma unroll
        for (int h = 0; h < 2; ++h)
#pragma unroll
            for (int i = 0; i < 2; ++i) off[h][i] = (unsigned)((h * HALF + R[i]) * lda + C[i]) * 2u;
    }
};
template <bool GATHER, int MODE = 0> struct MoeSched {
    const bf16_t* A; int lda; const bf16_t* Bt; int K; int NB  ; int nN; const LAS int* tstart  ; const LAS int* tall  ; const LAS int* cnt  ; const int* rowtok; LAS unsigned char* aux  ;
    int nwg, G, c; mutable int ecur;
    static constexpr bool kGather = GATHER;
    __device__ __forceinline__ bool next(int i, Unit& u) const {
        const long L = (long)i * G + c; if (L >= nwg) return false;
        int wgid = (int)L; { const int q = nwg / NXCD, r = nwg % NXCD, xcd = wgid % NXCD, off = wgid / NXCD; wgid = (xcd < r ? xcd * (q + 1) : r * (q + 1) + (xcd - r) * q) + off; }
        int e = ecur;
#pragma unroll 1
        while (e < NE - 1 && wgid >= __builtin_amdgcn_readfirstlane(tstart[e + 1]) * nN) ++e;
        ecur = e;
        const int t0 = __builtin_amdgcn_readfirstlane(tstart[e]), t1 = __builtin_amdgcn_readfirstlane(tstart[e + 1]);
        const int local = wgid - t0 * nN, tiles = t1 - t0, idx = local % tiles;
        const int a0 = __builtin_amdgcn_readfirstlane(tall[e]), a1 = __builtin_amdgcn_readfirstlane(tall[e + 1]);
        u.pn = local / tiles; u.e = e;
        if (MODE == 0) { u.mt = idx; u.hx = 0; } else if (MODE == 1) { u.mt = a1 - a0 - 1; u.hx = 0; } else { u.mt = idx >> 1; u.hx = idx & 1; }
        u.pm = a0 + u.mt; return true;
    }
    __device__ __forceinline__ const char* a_base(const Unit& u) const { return GATHER ? (const char*)A : (const char*)A + ((size_t)u.pm * BM + (size_t)u.hx * HALF) * lda * 2; }
    __device__ __forceinline__ const char* b_base(const Unit& u) const { return (const char*)Bt + ((size_t)u.e * NB + (size_t)u.pn * BM) * K * 2; }
    __device__ __forceinline__ void a_tokptrs(const Unit& u, const int (&R)[2], const int* (&gp)[4]) const {
        const int ce = __builtin_amdgcn_readfirstlane(cnt[u.e]);
#pragma unroll
        for (int h = 0; h < 2; ++h)
#pragma unroll
            for (int i = 0; i < 2; ++i) { const int g = u.mt * BM + u.hx * HALF + h * HALF + R[i]; gp[2 * h + i] = rowtok + (size_t)u.e * T + (g < ce ? g : 0); }
    }
    __device__ __forceinline__ void a_offs(const Unit& u, const int (&R)[2], const int (&C)[2], unsigned (&off)[2][2]) const {
        if constexpr (GATHER) {
            const int ce = __builtin_amdgcn_readfirstlane(cnt[u.e]);
#pragma unroll
            for (int h = 0; h < 2; ++h)
#pragma unroll
                for (int i = 0; i < 2; ++i) { const int g = u.mt * BM + u.hx * HALF + h * HALF + R[i]; const int tok = rowtok[u.e * T + (g < ce ? g : 0)] >> 2; off[h][i] = (unsigned)(tok * lda + C[i]) * 2u; }
        } else {
#pragma unroll
            for (int h = 0; h < 2; ++h)
#pragma unroll
                for (int i = 0; i < 2; ++i) off[h][i] = (unsigned)((h * HALF + R[i]) * lda + C[i]) * 2u;
        }
    }
};

__device__ __forceinline__ void glds16(const char* sbase, unsigned voff, unsigned lds_dst) {
    unsigned keep;
    asm volatile("s_mov_b32 %0, m0\n\ts_mov_b32 m0, %3\n\ts_nop 0\n\tglobal_load_lds_dwordx4 %1, %2\n\ts_mov_b32 m0, %0" : "=&s"(keep) : "v"(voff), "s"(sbase), "s"(lds_dst) : "memory");
}
typedef int v8i32 __attribute__((ext_vector_type(8)));
typedef int v4i32 __attribute__((ext_vector_type(4)));
__device__ __forceinline__ v8i32 cat8(bf16x8 a, bf16x8 b) { return __builtin_shufflevector(__builtin_bit_cast(v4i32, a), __builtin_bit_cast(v4i32, b), 0, 1, 2, 3, 4, 5, 6, 7); }
template <int FP8, class Epi, class Sched, int SCW = 127, int SCA = 127, bool RSYNC = false, bool HM = false>
__device__ __forceinline__ void gemm_phase(LAS unsigned char* lds, const Sched& S, const Epi& E, const XcdBarrier* rbar = nullptr) {
    int sclw = SCW * 0x01010101, scla = SCA * 0x01010101; asm volatile("" : "+v"(sclw), "+v"(scla));
    int tid_ = threadIdx.x; asm volatile("" : "+v"(tid_));
    const int tid = tid_, wid = __builtin_amdgcn_readfirstlane(tid >> 6), lane = tid & 63, wr = wid >> 2, wc = wid & 3, fr = lane & 15, fq = lane >> 4;
    const int K = S.K, nt = K / BK;
    unsigned voffB[2];
    { int R[2], C[2];
#pragma unroll
      for (int i = 0; i < 2; ++i) { stage_rc(tid * 16 + i * 8192, R[i], C[i]); voffB[i] = (unsigned)(R[i] * K + C[i]) * 2u; } }
#define PG8_RC() int R[2], C[2]; { int t_ = threadIdx.x; asm volatile("" : "+v"(t_)); _Pragma("unroll") for (int i = 0; i < 2; ++i) stage_rc(t_ * 16 + i * 8192, R[i], C[i]); }
    const size_t kstep = (size_t)(BK * 2);
    const size_t hstepB = (size_t)HALF * K * 2;
    const unsigned ldsbase = (unsigned)__builtin_amdgcn_readfirstlane((int)((unsigned)(size_t)lds + (unsigned)wid * 1024u));
    const int aoff = lds_byte(wr * 64 + fr, fq * 8), boff = lds_byte(wc * 32 + fr, fq * 8);
#define PG8_SA(b, h) (((b) * 2 + (h)) * HTB)
#define PG8_SB(b, h) ((4 + (b) * 2 + (h)) * HTB)
#define PG8_STAGE2(bufoff, gbase, o0, o1) do { glds16((const char*)(gbase), (o0), ldsbase + (unsigned)(bufoff)); glds16((const char*)(gbase), (o1), ldsbase + (unsigned)(bufoff) + 8192u); } while (0)
#define PG8_STAGEB(bufoff, gbase) PG8_STAGE2(bufoff, gbase, voffB[0], voffB[1])
#define PG8_STAGEA(bufoff, gbase, h) PG8_STAGE2(bufoff, gbase, voffA[h][0], voffA[h][1])
#define PG8_STAGEAS(bufoff, gbase, h) PG8_STAGE2(bufoff, gbase, voffA[h][0], voffA[h][1])
#define PG8_LDA(dst, b, h) do { _Pragma("unroll") for (int m = 0; m < 4; ++m) _Pragma("unroll") for (int k = 0; k < 2; ++k) dst[m][k] = *(const LAS bf16x8*)(lds + PG8_SA(b, h) + aoff + m * 2048 + k * 1024); } while (0)
#define PG8_LDB(dst, b, h) do { _Pragma("unroll") for (int n = 0; n < 2; ++n) _Pragma("unroll") for (int k = 0; k < 2; ++k) dst[n][k] = *(const LAS bf16x8*)(lds + PG8_SB(b, h) + boff + n * 2048 + k * 1024); } while (0)
#define PG8_MMA(ai, bj, At, Bt) do { __builtin_amdgcn_s_setprio(1); if constexpr (FP8 == 2) { _Pragma("unroll") for (int m = 0; m < 4; ++m) _Pragma("unroll") for (int n = 0; n < 2; ++n) { \
        const v8i32 wa_ = cat8(Bt[n][0], Bt[n][1]), xa_ = cat8(At[m][0], At[m][1]); \
        asm volatile("s_nop 1\n\tv_mfma_scale_f32_16x16x128_f8f6f4 %0, %1, %2, %0, %3, %4 op_sel_hi:[0,0,0] cbsz:2 blgp:2" : "+v"(acc[ai][bj][m][n]) \
                     : "v"(__builtin_shufflevector(wa_, wa_, 0, 1, 2, 3, 4, 5)), "v"(__builtin_shufflevector(xa_, xa_, 0, 1, 2, 3, 4, 5)), "v"(wa_[6]), "v"(xa_[6])); } } else if constexpr (FP8 == 1) { _Pragma("unroll") for (int m = 0; m < 4; ++m) _Pragma("unroll") for (int n = 0; n < 2; ++n) \
        asm volatile("v_mfma_scale_f32_16x16x128_f8f6f4 %0, %1, %2, %0, %3, %4 op_sel_hi:[0,0,0]" : "+v"(acc[ai][bj][m][n]) : "v"(cat8(Bt[n][0], Bt[n][1])), "v"(cat8(At[m][0], At[m][1])), "v"(sclw), "v"(scla)); } else { \
        _Pragma("unroll") for (int m = 0; m < 4; ++m) _Pragma("unroll") for (int n = 0; n < 2; ++n) _Pragma("unroll") for (int k = 0; k < 2; ++k) \
        acc[ai][bj][m][n] = __builtin_amdgcn_mfma_f32_16x16x32_bf16(Bt[n][k], At[m][k], acc[ai][bj][m][n], 0, 0, 0); } __builtin_amdgcn_s_setprio(0); } while (0)
#define PG8_WAIT_V(n) asm volatile("s_waitcnt vmcnt(" #n ")" ::: "memory")
#define PG8_WAIT_K() do { if constexpr (HM) PG8_WAIT_V(6); else PG8_WAIT_V(8); } while (0)
    constexpr int EST = HM ? Epi::kStoresHM : Epi::kStores;
#define PG8_WAIT_K0() do { if (EST > 0 && t == 0 && ui > 0) asm volatile("s_waitcnt vmcnt(%0)" :: "n"((HM ? 6 : 8) + EST) : "memory"); else PG8_WAIT_K(); } while (0)
#define PG8_WAIT_L(n) asm volatile("s_waitcnt lgkmcnt(" #n ")" ::: "memory")
#define PG8_BAR __builtin_amdgcn_s_barrier()
#define PG8_SCHED __builtin_amdgcn_sched_barrier(0)
    Unit cur, nxt; int ui = 0;
    if (!S.next(0, cur)) return;
    unsigned voffA[2][2];
    { PG8_RC(); S.a_offs(cur, R, C, voffA); }
    f32x4 acc[2][2][4][2];
#pragma unroll
    for (int a = 0; a < 2; ++a)
#pragma unroll
        for (int b = 0; b < 2; ++b)
#pragma unroll
            for (int m = 0; m < 4; ++m)
#pragma unroll
                for (int n = 0; n < 2; ++n) acc[a][b][m][n] = (f32x4){0.f, 0.f, 0.f, 0.f};
    bf16x8 At[4][2], B0[2][2], B1[2][2];
    const char* cA = S.a_base(cur); const char* cB = S.b_base(cur);
    const unsigned bias_lds = (unsigned)__builtin_amdgcn_readfirstlane((int)((unsigned)(size_t)lds + (unsigned)(AUX_OFF + 8192) + (unsigned)wid * 256u));
    if constexpr (Epi::kBiasDMA) { if (lane < 16) glds16(E.bias_base(cur), E.bias_off(cur, wc, lane), bias_lds); }
    const unsigned rowid_lds = (unsigned)__builtin_amdgcn_readfirstlane((int)((unsigned)(size_t)lds + (unsigned)AUX_OFF + (unsigned)wid * 512u));
    if constexpr (Epi::kRowDMA) { if (lane < 32) glds16(E.row_base(cur), E.row_off(cur, wr, lane), rowid_lds); }
    PG8_STAGEB(PG8_SB(0, 0), cB); PG8_STAGEB(PG8_SB(0, 1), cB + hstepB); PG8_STAGEA(PG8_SA(0, 0), cA, 0); if constexpr (!HM) PG8_STAGEA(PG8_SA(0, 1), cA, 1);
    if (wr == 1) PG8_BAR;
    if constexpr (HM) PG8_WAIT_V(0); else PG8_WAIT_V(2);
    PG8_BAR;
    PG8_STAGEB(PG8_SB(1, 0), cB + kstep); PG8_STAGEA(PG8_SA(1, 0), cA + kstep, 0); PG8_STAGEB(PG8_SB(1, 1), cB + hstepB + kstep);
    PG8_WAIT_V(6); PG8_BAR;
    for (;;) {
        const bool has_next = S.next(ui + 1, nxt);
        const char* nA = cA; const char* nB = cB;
        if (has_next) { nA = S.a_base(nxt); nB = S.b_base(nxt); }
        unsigned gtok0 = 0, gtok1 = 0, gtok2 = 0, gtok3 = 0;
        if constexpr (Sched::kGather) {
            if (has_next) { PG8_RC(); const int* gp[4]; S.a_tokptrs(nxt, R, gp);
                asm volatile("global_load_dword %0, %4, off\n\tglobal_load_dword %1, %5, off\n\tglobal_load_dword %2, %6, off\n\tglobal_load_dword %3, %7, off"
                             : "=&v"(gtok0), "=&v"(gtok1), "=&v"(gtok2), "=&v"(gtok3) : "v"(gp[0]), "v"(gp[1]), "v"(gp[2]), "v"(gp[3]) : "memory"); }
        }
        for (int t = 0; t < nt; t += 2) {
            const bool last = (t == nt - 2);
            if constexpr (Sched::kGather) {
                if (t == 2 && has_next) {
                    if constexpr (HM) asm volatile("s_waitcnt vmcnt(12)" : "+v"(gtok0), "+v"(gtok1), "+v"(gtok2), "+v"(gtok3) :: "memory");
                    else asm volatile("s_waitcnt vmcnt(16)" : "+v"(gtok0), "+v"(gtok1), "+v"(gtok2), "+v"(gtok3) :: "memory");
                    PG8_RC(); *(LAS u32x4*)(S.aux + tid * 16) = (u32x4){(unsigned)(((int)gtok0 >> 2) * S.lda + C[0]) * 2u, (unsigned)(((int)gtok1 >> 2) * S.lda + C[1]) * 2u, (unsigned)(((int)gtok2 >> 2) * S.lda + C[0]) * 2u, (unsigned)(((int)gtok3 >> 2) * S.lda + C[1]) * 2u};
                }
            }
            const char* a1 = cA + (size_t)(t + 1) * kstep;
            const char* a2 = last ? nA : cA + (size_t)(t + 2) * kstep; const char* b2 = last ? nB : cB + (size_t)(t + 2) * kstep;
            const char* a3 = a2 + kstep; const char* b3 = b2 + kstep;
            PG8_LDB(B0, 0, 0); PG8_LDB(B1, 0, 1); PG8_SCHED; PG8_LDA(At, 0, 0); if constexpr (!HM) PG8_STAGEA(PG8_SA(1, 1), a1, 1);
            if constexpr (Sched::kGather) { if (last && has_next) { const u32x4 tn = *(const LAS u32x4*)(S.aux + tid * 16); voffA[0][0] = tn.x; voffA[0][1] = tn.y; voffA[1][0] = tn.z; voffA[1][1] = tn.w; } }
            PG8_WAIT_K0(); PG8_WAIT_L(0); PG8_BAR; PG8_MMA(0, 0, At, B0); PG8_MMA(0, 1, At, B1); PG8_BAR; PG8_SCHED;
            if constexpr (!HM) PG8_LDA(At, 0, 1);
            PG8_STAGEB(PG8_SB(0, 0), b2); PG8_STAGEB(PG8_SB(0, 1), b2 + hstepB); PG8_STAGEAS(PG8_SA(0, 0), a2, 0);
            PG8_WAIT_K0(); PG8_WAIT_L(0); PG8_BAR; if constexpr (!HM) { PG8_MMA(1, 0, At, B0); PG8_MMA(1, 1, At, B1); } PG8_BAR; PG8_SCHED;
            PG8_LDB(B0, 1, 0); PG8_LDB(B1, 1, 1); PG8_SCHED; PG8_LDA(At, 1, 0); if constexpr (!HM) PG8_STAGEAS(PG8_SA(0, 1), a2, 1);
            PG8_WAIT_K(); PG8_WAIT_L(0); PG8_BAR; PG8_MMA(0, 0, At, B0); PG8_MMA(0, 1, At, B1); PG8_BAR; PG8_SCHED;
            if constexpr (!HM) PG8_LDA(At, 1, 1);
            PG8_STAGEB(PG8_SB(1, 0), b3); PG8_STAGEB(PG8_SB(1, 1), b3 + hstepB); PG8_STAGEAS(PG8_SA(1, 0), a3, 0);
            PG8_WAIT_K(); PG8_WAIT_L(0); PG8_BAR; if constexpr (!HM) { PG8_MMA(1, 0, At, B0); PG8_MMA(1, 1, At, B1); } PG8_BAR; PG8_SCHED;
        }
        if (wr == 0) PG8_BAR;
        if constexpr (FP8 >= 1) asm volatile("s_nop 15\n\ts_nop 15" ::: "memory");
        if constexpr (Epi::kRowDMA) E(acc, cur, wr, wc, fr, fq, (const LAS float*)(lds + AUX_OFF + 8192 + wid * 256), (const LAS int*)(lds + AUX_OFF + wid * 512), HM ? 1 : 2);
        else if constexpr (Epi::kBiasDMA) E(acc, cur, wr, wc, fr, fq, (const LAS float*)(lds + AUX_OFF + 8192 + wid * 256), HM ? 1 : 2); else E(acc, cur, wr, wc, fr, fq);
        if (!has_next) break;
        if constexpr (RSYNC) xcd_barrier(*rbar);
#pragma unroll
        for (int a = 0; a < 2; ++a)
#pragma unroll
            for (int b = 0; b < 2; ++b)
#pragma unroll
                for (int m = 0; m < 4; ++m)
#pragma unroll
                    for (int n = 0; n < 2; ++n) acc[a][b][m][n] = (f32x4){0.f, 0.f, 0.f, 0.f};
        cur = nxt; cA = nA; cB = nB; ++ui;
        if constexpr (Epi::kBiasDMA) { if (lane < 16) glds16(E.bias_base(cur), E.bias_off(cur, wc, lane), bias_lds); }
        if constexpr (Epi::kRowDMA) { if (lane < 32) glds16(E.row_base(cur), E.row_off(cur, wr, lane), rowid_lds); }
        if (wr == 1) PG8_BAR;
    }
    PG8_WAIT_V(0);
    PG8_BAR;
#undef PG8_SA
#undef PG8_RC
#undef PG8_SB
#undef PG8_STAGE2
#undef PG8_STAGEB
#undef PG8_STAGEA
#undef PG8_STAGEAS
#undef PG8_LDA
#undef PG8_LDB
#undef PG8_MMA
#undef PG8_WAIT_V
#undef PG8_WAIT_K
#undef PG8_WAIT_K0
#undef PG8_WAIT_L
#undef PG8_BAR
#undef PG8_SCHED
}
}

struct Args {
    const float* in[18]; float* out; unsigned char* ws;
    float l2g[8];
    int ph_lo, ph_hi;
};
struct Frame {
    LAS unsigned char* lds;
    int tid, lane, wave, G, vcu;
    unsigned char* ws;
};

enum { CM_NAT = 0, CM_STD = 1, CM_ROPE = 2, CM_SWIGLU = 3, CM_WIN = 4, CM_DN = 5 };
__device__ __forceinline__ int src_col(int mode, int n) {
    if (mode == CM_WIN) mode = (n >= 2048 && n < 4096) ? CM_ROPE : CM_STD;
    if (mode == CM_NAT) return n;
    if (mode == CM_DN) return n;
    if (mode == CM_STD) return (n & ~31) + pg8::perm32(n & 31);
    if (mode == CM_ROPE) { const int p = n & 127, wc = p >> 5, nn = (p >> 4) & 1, i = p & 15; return (n & ~127) + 16 * wc + i + 64 * nn; }
    { const int pn = n >> 8, p = n & 255, bj = p >> 7, g = (p >> 5) & 3, rho = p & 31; return bj * 2048 + 128 * pn + 32 * g + pg8::perm32(rho); }
}
__device__ __forceinline__ int dst_row(int mode, int c) {
    if (mode != CM_DN) return c;
    const int q = c & 255, wc = q >> 6, fq = (q >> 4) & 3, bj = (q >> 3) & 1, nn = (q >> 2) & 1, j = q & 3;
    return (c & ~255) + 128 * bj + 32 * wc + 16 * nn + 4 * fq + j;
}
__device__ __forceinline__ void transpose_item(const float* W, int K, int N, bf16_t* WT, int mode, int item, LAS unsigned* scr, int lane) {
    const int nblk = N / 32, kb = item / nblk, nb = item % nblk, k0 = 64 * kb, n0 = 32 * nb;
    const int g = lane & 7, r = lane >> 3;
    const int sc = src_col(mode, n0 + 4 * g);
    const float* p = W + (size_t)(k0 + 2 * r) * N + sc;
    f32x4 a[4], b[4];
#pragma unroll
    for (int i = 0; i < 4; ++i) { a[i] = *(const f32x4*)(p + (size_t)(16 * i) * N); b[i] = *(const f32x4*)(p + (size_t)(16 * i + 1) * N); }
#pragma unroll
    for (int i = 0; i < 4; ++i)
#pragma unroll
        for (int j = 0; j < 4; ++j) scr[(4 * g + j) * 33 + r + 8 * i] = cvt_pk_bf16(a[i][j], b[i][j]);
    asm volatile("s_waitcnt lgkmcnt(0)" ::: "memory");
    const int c = lane & 7;
#pragma unroll
    for (int ii = 0; ii < 4; ++ii) { const int n = 8 * ii + (lane >> 3); const LAS unsigned* s = scr + n * 33 + 4 * c;
        u32x4 o; o.x = s[0]; o.y = s[1]; o.z = s[2]; o.w = s[3];
        *(u32x4*)(WT + (size_t)(n0 + n) * K + k0 + 8 * c) = o; }
    asm volatile("s_waitcnt lgkmcnt(0)" ::: "memory");
}

typedef float f32x16v __attribute__((ext_vector_type(16)));
typedef unsigned u32x6 __attribute__((ext_vector_type(6)));
#ifndef MK_F6_SCALE_INV
#define MK_F6_SCALE_INV 0
#endif
__device__ __forceinline__ void q6_block(const float (&v)[32], u32x4& lo, u32x4& hi) {
    float amax = 0.f;
#pragma unroll
    for (int t = 0; t < 32; ++t) amax = fmaxf(amax, fabsf(v[t]));
    const unsigned eb = ((__float_as_uint(amax * 0.13333334f) >> 23) & 255u) + 1u;
    const float sc = __uint_as_float(eb << 23);
    f32x16v a, b;
#pragma unroll
    for (int t = 0; t < 16; ++t) { a[t] = v[t]; b[t] = v[16 + t]; }
    const u32x6 q = __builtin_amdgcn_cvt_scalef32_2xpk16_fp6_f32(a, b, MK_F6_SCALE_INV ? __uint_as_float((254u - eb) << 23) : sc);
    lo = (u32x4){q[0], q[1], q[2], q[3]};
    hi = (u32x4){q[4], q[5], eb * 0x01010101u, 0u};
}
__device__ __forceinline__ void t8_load(const float* W, int N, int mode, int item, int lane, f32x4 (&a)[4][4]) {
    const int nblk = N / 32, kb = item / nblk, nb = item % nblk, k0 = 128 * kb, n0 = 32 * nb;
    const int g = lane & 7, r = lane >> 3;
    const float* p = W + (size_t)(k0 + 4 * r) * N + src_col(mode, n0 + 4 * g);
#pragma unroll
    for (int i = 0; i < 4; ++i)
#pragma unroll
        for (int q = 0; q < 4; ++q) a[i][q] = __builtin_nontemporal_load((const f32x4*)(p + (size_t)(32 * i + q) * N));
}
__device__ __forceinline__ void t8_store(const f32x4 (&a)[4][4], int K, int N, unsigned char* WT, int mode, int item, float scale, LAS unsigned* scr, int lane) {
    const int nblk = N / 32, kb = item / nblk, nb = item % nblk, k0 = 128 * kb, n0 = 32 * nb;
    const int g = lane & 7, r = lane >> 3;
#pragma unroll
    for (int i = 0; i < 4; ++i)
#pragma unroll
        for (int j = 0; j < 4; ++j) scr[(4 * g + j) * 33 + r + 8 * i] = pk4_fp8(a[i][0][j] * scale, a[i][1][j] * scale, a[i][2][j] * scale, a[i][3][j] * scale);
    asm volatile("s_waitcnt lgkmcnt(0)" ::: "memory");
    const int c = lane & 7;
#pragma unroll
    for (int ii = 0; ii < 4; ++ii) { const int n = 8 * ii + (lane >> 3); const LAS unsigned* s = scr + n * 33 + 4 * c;
        u32x4 o; o.x = s[0]; o.y = s[1]; o.z = s[2]; o.w = s[3];
        *(u32x4*)(WT + (size_t)dst_row(mode, n0 + n) * K + k0 + 16 * c) = o; }
    asm volatile("s_waitcnt lgkmcnt(0)" ::: "memory");
}
__device__ __forceinline__ void t6_store(const f32x4 (&a)[4][4], int K, int N, unsigned char* WT, int item, LAS float* scr, int lane) {
    const int nblk = N / 32, kbi = item / nblk, nb = item % nblk, k0 = 128 * kbi, n0 = 32 * nb;
    const int g = lane & 7, r = lane >> 3, n = lane & 31, kb = lane >> 5;
    LAS unsigned char* outl = (LAS unsigned char*)(scr + 64 * 36);
#pragma unroll
    for (int h = 0; h < 2; ++h) {
#pragma unroll
        for (int i = 0; i < 2; ++i)
#pragma unroll
            for (int q = 0; q < 4; ++q) *(LAS f32x4*)(scr + (4 * r + 32 * i + q) * 36 + 4 * g) = a[2 * h + i][q];
        asm volatile("s_waitcnt lgkmcnt(0)" ::: "memory");
        float v[32];
#pragma unroll
        for (int t = 0; t < 32; ++t) v[t] = scr[(32 * kb + t) * 36 + n];
        u32x4 lo, hi; q6_block(v, lo, hi);
        *(LAS u32x4*)(outl + n * 144 + 16 * (2 * h + kb)) = lo; *(LAS u32x4*)(outl + n * 144 + 64 + 16 * (2 * h + kb)) = hi;
        asm volatile("s_waitcnt lgkmcnt(0)" ::: "memory");
    }
    const int c = lane & 7;
#pragma unroll
    for (int ii = 0; ii < 4; ++ii) { const int rr = 8 * ii + (lane >> 3);
        const u32x4 o = *(const LAS u32x4*)(outl + rr * 144 + 16 * c);
        *(u32x4*)(WT + (size_t)(n0 + rr) * K + k0 + 16 * c) = o; }
    asm volatile("s_waitcnt lgkmcnt(0)" ::: "memory");
}
template <bool FP6> __device__ __forceinline__ void t8_stream(const float* W, int K, int N, unsigned char* WT, int mode, int items_per_e, int gw, int NGW, LAS unsigned* scr, int lane) {
    const int NIT = NE * items_per_e; const size_t estride = (size_t)K * N;
    f32x4 A[4][4], B[4][4];
#define T8_LD(buf, idx) do { const int i_ = (idx) < NIT ? (idx) : NIT - 1; t8_load(W + (size_t)(i_ / items_per_e) * estride, N, mode, i_ % items_per_e, lane, buf); } while (0)
#define T8_ST(buf, idx) do { if constexpr (FP6) t6_store(buf, K, N, WT + (size_t)((idx) / items_per_e) * estride, (idx) % items_per_e, (LAS float*)scr, lane); else t8_store(buf, K, N, WT + (size_t)((idx) / items_per_e) * estride, mode, (idx) % items_per_e, W8_SCALE, scr, lane); } while (0)
    T8_LD(A, gw);
    for (int it = gw; it < NIT; it += 2 * NGW) {
        T8_LD(B, it + NGW);
        T8_ST(A, it);
        T8_LD(A, it + 2 * NGW);
        if (it + NGW < NIT) T8_ST(B, it + NGW);
    }
#undef T8_LD
#undef T8_ST
}

__device__ __forceinline__ void conv_rest(Frame& F, const Args& a, int gw, int NGW) {
    LAS unsigned* scr = (LAS unsigned*)(F.lds + F.wave * 13824);
    bf16_t* Wpa = (bf16_t*)(F.ws + WS_WPA); bf16_t* Wpr = (bf16_t*)(F.ws + WS_WPR); bf16_t* Wout = (bf16_t*)(F.ws + WS_WOUT);
    unsigned char* Wgu = (unsigned char*)(F.ws + WS_WGU); unsigned char* Wdn = (unsigned char*)(F.ws + WS_WDN);
    constexpr int I_PA = (GW / 64) * (D / 32), I_PR = (D / 64) * (D / 32), I_OUT = I_PR, I_GU1 = (D / 128) * (4096 / 32), I_DN1 = (DFF / 128) * (D / 32);
    constexpr int NITEMS = I_PA + I_PR + I_OUT;
    for (int it = gw; it < NITEMS; it += NGW) {
        int r = it;
        if (r < I_PA) { transpose_item(a.in[7], GW, D, Wpa, CM_STD, r, scr, F.lane); continue; } r -= I_PA;
        if (r < I_PR) { transpose_item(a.in[8], D, D, Wpr, CM_STD, r, scr, F.lane); continue; } r -= I_PR;
        transpose_item(a.in[9], D, D, Wout, CM_NAT, r, scr, F.lane);
    }
    t8_stream<true>(a.in[13], D, 4096, Wgu, CM_SWIGLU, I_GU1, gw, NGW, scr, F.lane);
    t8_stream<false>(a.in[15], DFF, D, Wdn, CM_DN, I_DN1, gw, NGW, scr, F.lane);
}
__device__ __forceinline__ void t16_load(const float* W, int N, int mode, int item, int lane, f32x4 (&a)[4], f32x4 (&b)[4]) {
    const int nblk = N / 32, kb = item / nblk, nb = item % nblk, k0 = 64 * kb, n0 = 32 * nb;
    const int g = lane & 7, r = lane >> 3;
    const float* p = W + (size_t)(k0 + 2 * r) * N + src_col(mode, n0 + 4 * g);
#pragma unroll
    for (int i = 0; i < 4; ++i) { a[i] = __builtin_nontemporal_load((const f32x4*)(p + (size_t)(16 * i) * N)); b[i] = __builtin_nontemporal_load((const f32x4*)(p + (size_t)(16 * i + 1) * N)); }
}
__device__ __forceinline__ void t16_store(const f32x4 (&a)[4], const f32x4 (&b)[4], int K, int N, bf16_t* WT, int item, LAS unsigned* scr, int lane) {
    const int nblk = N / 32, kb = item / nblk, nb = item % nblk, k0 = 64 * kb, n0 = 32 * nb;
    const int g = lane & 7, r = lane >> 3;
#pragma unroll
    for (int i = 0; i < 4; ++i)
#pragma unroll
        for (int j = 0; j < 4; ++j) scr[(4 * g + j) * 33 + r + 8 * i] = cvt_pk_bf16(a[i][j], b[i][j]);
    asm volatile("s_waitcnt lgkmcnt(0)" ::: "memory");
    const int c = lane & 7;
#pragma unroll
    for (int ii = 0; ii < 4; ++ii) { const int n = 8 * ii + (lane >> 3); const LAS unsigned* s = scr + n * 33 + 4 * c;
        u32x4 o; o.x = s[0]; o.y = s[1]; o.z = s[2]; o.w = s[3];
        *(u32x4*)(WT + (size_t)(n0 + n) * K + k0 + 8 * c) = o; }
    asm volatile("s_waitcnt lgkmcnt(0)" ::: "memory");
}
__device__ __forceinline__ void p0_prologue(Frame& F, const Args& a) {
    LAS unsigned* scr = (LAS unsigned*)(F.lds + F.wave * 4352);
    const int gw = F.vcu * NWAVES + F.wave, NGW = F.G * NWAVES;
    bf16_t* Win = (bf16_t*)(F.ws + WS_WIN);
    constexpr int I_IN = (D / 64) * (INW / 32);
    {
        f32x4 A0[4], A1[4], B0[4], B1[4];
        t16_load(a.in[2], INW, CM_WIN, gw < I_IN ? gw : I_IN - 1, F.lane, A0, A1);
        for (int it = gw; it < I_IN; it += 2 * NGW) {
            { const int n1 = it + NGW; t16_load(a.in[2], INW, CM_WIN, n1 < I_IN ? n1 : I_IN - 1, F.lane, B0, B1); }
            t16_store(A0, A1, D, INW, Win, it, scr, F.lane);
            { const int n2 = it + 2 * NGW; t16_load(a.in[2], INW, CM_WIN, n2 < I_IN ? n2 : I_IN - 1, F.lane, A0, A1); }
            if (it + NGW < I_IN) t16_store(B0, B1, D, INW, Win, it + NGW, scr, F.lane);
        }
    }
    const float* x = a.in[0]; const float* g1 = a.in[1]; bf16_t* H = (bf16_t*)(F.ws + WS_H);
    float* rc = (float*)(F.ws + WS_ROPEC); float* rs = (float*)(F.ws + WS_ROPES);
    LAS double* invf = (LAS double*)(F.lds + 40960);
    __syncthreads();
    if (F.tid < 64) invf[F.tid] = exp2(-(double)(2 * F.tid) / 128.0 * 13.287712379549449);
    __syncthreads();
    int ridx = blockIdx.x * NTHREADS + F.tid;
#define ROPE_ENTRY() do { if (ridx < T * 64) { const int pos = ridx >> 6, i_ = ridx & 63; double ang = (double)pos * invf[i_]; const double k_ = rint(ang * 0.15915494309189535); ang = ang - k_ * 6.283185307179586; \
        const float af = (float)ang; rc[ridx] = cosf(af); rs[ridx] = sinf(af); } ridx += F.G * NTHREADS; } while (0)
    {
        f32x4 g1v[8];
#pragma unroll
        for (int j = 0; j < 8; ++j) g1v[j] = ((const f32x4*)g1)[F.lane + 64 * j];
        f32x4 vc[8];
        { const f32x4* xr = (const f32x4*)(x + (size_t)(gw < T ? gw : T - 1) * D) + F.lane;
#pragma unroll
          for (int j = 0; j < 8; ++j) vc[j] = __builtin_nontemporal_load(xr + 64 * j); }
        for (int m = gw; m < T; m += NGW) {
            f32x4 vn[8];
            { const int mn = (m + NGW) < T ? (m + NGW) : T - 1; const f32x4* xr = (const f32x4*)(x + (size_t)mn * D) + F.lane;
#pragma unroll
              for (int j = 0; j < 8; ++j) vn[j] = __builtin_nontemporal_load(xr + 64 * j); }
            float s = 0.f;
#pragma unroll
            for (int j = 0; j < 8; ++j) s += (vc[j].x * vc[j].x + vc[j].y * vc[j].y) + (vc[j].z * vc[j].z + vc[j].w * vc[j].w);
            const float rstd = 1.0f / sqrtf(wave_sum(s) * (1.f / D) + EPS);
            u32x2* o8 = (u32x2*)(H + (size_t)m * D) + F.lane;
#pragma unroll
            for (int j = 0; j < 8; ++j) { const f32x4 g = g1v[j]; u32x2 w; w.x = cvt_pk_bf16(vc[j].x * rstd * g.x, vc[j].y * rstd * g.y); w.y = cvt_pk_bf16(vc[j].z * rstd * g.z, vc[j].w * rstd * g.w); o8[64 * j] = w; }
#pragma unroll
            for (int j = 0; j < 8; ++j) vc[j] = vn[j];
            ROPE_ENTRY();
        }
    }
    while (ridx < T * 64) ROPE_ENTRY();
#undef ROPE_ENTRY
}

typedef f32x4 AccT[2][2][4][2];
struct EpiInProj {
    static constexpr bool kBiasDMA = false; static constexpr bool kRowDMA = false; static constexpr int kStores = 0, kStoresHM = 0;
    unsigned char* ws;
    __device__ __forceinline__ void operator()(const AccT& acc, const pg8::Unit& u, int wr, int wc, int fr, int fq) const {
        const int row0 = u.pm * 256 + wr * 64 + fr; const int pn = u.pn;
        if (pn < 8) {
            bf16_t* dst = (bf16_t*)(ws + (pn < 4 ? WS_U : WS_V)); const int col0 = (pn & 3) * 256 + wc * 32 + 8 * fq;
            float* vstat = (float*)(ws + WS_VSTAT);
#pragma unroll
            for (int ai = 0; ai < 2; ++ai)
#pragma unroll
                for (int m = 0; m < 4; ++m) { const int row = row0 + ai * 128 + m * 16; float s = 0.f, q = 0.f;
#pragma unroll
                    for (int bj = 0; bj < 2; ++bj) { const f32x4 v0 = gelu4(acc[ai][bj][m][0]), v1 = gelu4(acc[ai][bj][m][1]);
                        s += (v0[0] + v0[1]) + (v0[2] + v0[3]) + (v1[0] + v1[1]) + (v1[2] + v1[3]);
                        q += (v0[0] * v0[0] + v0[1] * v0[1]) + (v0[2] * v0[2] + v0[3] * v0[3]) + (v1[0] * v1[0] + v1[1] * v1[1]) + (v1[2] * v1[2] + v1[3] * v1[3]);
                        u32x4 w; w.x = cvt_pk_bf16(v0[0], v0[1]); w.y = cvt_pk_bf16(v0[2], v0[3]); w.z = cvt_pk_bf16(v1[0], v1[1]); w.w = cvt_pk_bf16(v1[2], v1[3]);
                        *(u32x4*)(dst + (size_t)row * GW + col0 + bj * 128) = w; }
                    if (pn >= 4) { s += __shfl_xor(s, 16); s += __shfl_xor(s, 32); q += __shfl_xor(q, 16); q += __shfl_xor(q, 32);
                        if (fq == 0) *(f32x2*)(vstat + (size_t)row * 32 + ((pn - 4) * 4 + wc) * 2) = (f32x2){s, q}; } }
        } else if (pn < 16) {
            bf16_t* dst = (bf16_t*)(ws + (pn < 12 ? WS_Q : WS_K)); const float sc = pn < 12 ? 1.0f : 0.08838834764831845f;
            const float* rc = (const float*)(ws + WS_ROPEC); const float* rs = (const float*)(ws + WS_ROPES);
            const int dd = 16 * wc + 4 * fq;
#pragma unroll
            for (int ai = 0; ai < 2; ++ai) {
                f32x4 cc[4], ss[4];
#pragma unroll
                for (int m = 0; m < 4; ++m) { const int row = row0 + ai * 128 + m * 16; cc[m] = *(const f32x4*)(rc + (size_t)row * 64 + dd); ss[m] = *(const f32x4*)(rs + (size_t)row * 64 + dd); }
#pragma unroll
                for (int m = 0; m < 4; ++m) { const int row = row0 + ai * 128 + m * 16;
                    const f32x4 c = cc[m] * sc, s = ss[m] * sc;
#pragma unroll
                    for (int bj = 0; bj < 2; ++bj) { const f32x4 t1 = acc[ai][bj][m][0], t2 = acc[ai][bj][m][1];
                        const f32x4 o1 = t1 * c - t2 * s, o2 = t2 * c + t1 * s;
                        bf16_t* p = dst + (size_t)row * QKW + (pn & 3) * 256 + bj * 128 + dd;
                        u32x2 w1, w2; w1.x = cvt_pk_bf16(o1[0], o1[1]); w1.y = cvt_pk_bf16(o1[2], o1[3]); w2.x = cvt_pk_bf16(o2[0], o2[1]); w2.y = cvt_pk_bf16(o2[2], o2[3]);
                        *(u32x2*)p = w1; *(u32x2*)(p + 64) = w2; } } }
        } else {
            const int kind = (pn - 16) >> 3;
            bf16_t* dst = (bf16_t*)(ws + (kind == 0 ? WS_RV : kind == 1 ? WS_RG : kind == 2 ? WS_GA : WS_GR)); const int col0 = ((pn - 16) & 7) * 256 + wc * 32 + 8 * fq;
#pragma unroll
            for (int ai = 0; ai < 2; ++ai)
#pragma unroll
                for (int m = 0; m < 4; ++m) { const int row = row0 + ai * 128 + m * 16;
#pragma unroll
                    for (int bj = 0; bj < 2; ++bj) { f32x4 v0 = acc[ai][bj][m][0], v1 = acc[ai][bj][m][1];
                        if (kind == 1) {
#pragma unroll
                            for (int j = 0; j < 4; ++j) { v0[j] = v0[j] * sigmoid_f(v0[j]); v1[j] = v1[j] * sigmoid_f(v1[j]); } }
                        else if (kind >= 2) {
#pragma unroll
                            for (int j = 0; j < 4; ++j) { v0[j] = sigmoid_f(v0[j]); v1[j] = sigmoid_f(v1[j]); } }
                        u32x4 w; w.x = cvt_pk_bf16(v0[0], v0[1]); w.y = cvt_pk_bf16(v0[2], v0[3]); w.z = cvt_pk_bf16(v1[0], v1[1]); w.w = cvt_pk_bf16(v1[2], v1[3]);
                        *(u32x4*)(dst + (size_t)row * D + col0 + bj * 128) = w; } }
        }
    }
};
template <int MODE> struct EpiMerge {
    static constexpr bool kBiasDMA = false; static constexpr bool kRowDMA = false; static constexpr int kStores = 16, kStoresHM = 0;
    unsigned char* ws;
    __device__ __forceinline__ void operator()(const AccT& acc, const pg8::Unit& u, int wr, int wc, int fr, int fq) const {
        const int row0 = u.pm * 256 + wr * 64 + fr, col0 = u.pn * 256 + wc * 32 + 8 * fq;
        const bf16_t* gate = (const bf16_t*)(ws + (MODE == 0 ? WS_GA : WS_GR)); bf16_t* mrg = (bf16_t*)(ws + WS_MRG);
#pragma unroll
        for (int ai = 0; ai < 2; ++ai) {
            u32x4 gg[4][2], pp[4][2];
#pragma unroll
            for (int m = 0; m < 4; ++m)
#pragma unroll
                for (int bj = 0; bj < 2; ++bj) { const size_t ro = (size_t)(row0 + ai * 128 + m * 16) * D + col0 + bj * 128; gg[m][bj] = *(const u32x4*)(gate + ro); if (MODE == 1) pp[m][bj] = *(const u32x4*)(mrg + ro); }
#pragma unroll
            for (int m = 0; m < 4; ++m)
#pragma unroll
                for (int bj = 0; bj < 2; ++bj) { const size_t ro = (size_t)(row0 + ai * 128 + m * 16) * D + col0 + bj * 128; const u32x4 g = gg[m][bj]; const f32x4 v0 = acc[ai][bj][m][0], v1 = acc[ai][bj][m][1];
                    float o[8] = {v0[0] * bf_lo(g.x), v0[1] * bf_hi(g.x), v0[2] * bf_lo(g.y), v0[3] * bf_hi(g.y), v1[0] * bf_lo(g.z), v1[1] * bf_hi(g.z), v1[2] * bf_lo(g.w), v1[3] * bf_hi(g.w)};
                    if (MODE == 1) { const u32x4 p = pp[m][bj];
                        o[0] += bf_lo(p.x); o[1] += bf_hi(p.x); o[2] += bf_lo(p.y); o[3] += bf_hi(p.y); o[4] += bf_lo(p.z); o[5] += bf_hi(p.z); o[6] += bf_lo(p.w); o[7] += bf_hi(p.w); }
                    u32x4 w; w.x = cvt_pk_bf16(o[0], o[1]); w.y = cvt_pk_bf16(o[2], o[3]); w.z = cvt_pk_bf16(o[4], o[5]); w.w = cvt_pk_bf16(o[6], o[7]);
                    *(u32x4*)(mrg + ro) = w; } }
    }
};
struct EpiOut {
    static constexpr bool kBiasDMA = false; static constexpr bool kRowDMA = false; static constexpr int kStores = 32, kStoresHM = 0;
    const float* x; unsigned char* ws;
    __device__ __forceinline__ void operator()(const AccT& acc, const pg8::Unit& u, int wr, int wc, int fr, int fq) const {
        const int row0 = u.pm * 256 + wr * 64 + fr, col0 = u.pn * 256 + wc * 32 + 4 * fq;
        float* x1 = (float*)(ws + WS_X1); float* ss = (float*)(ws + WS_SS);
#pragma unroll
        for (int ai = 0; ai < 2; ++ai) {
            f32x4 xx[4][2][2];
#pragma unroll
            for (int m = 0; m < 4; ++m)
#pragma unroll
                for (int bj = 0; bj < 2; ++bj)
#pragma unroll
                    for (int n = 0; n < 2; ++n) xx[m][bj][n] = *(const f32x4*)(x + (size_t)(row0 + ai * 128 + m * 16) * D + col0 + bj * 128 + n * 16);
#pragma unroll
            for (int m = 0; m < 4; ++m) { const int row = row0 + ai * 128 + m * 16; const size_t ro = (size_t)row * D + col0; float q = 0.f;
#pragma unroll
                for (int bj = 0; bj < 2; ++bj)
#pragma unroll
                    for (int n = 0; n < 2; ++n) { const f32x4 o = xx[m][bj][n] + acc[ai][bj][m][n];
                        q += (o[0] * o[0] + o[1] * o[1]) + (o[2] * o[2] + o[3] * o[3]);
                        *(f32x4*)(x1 + ro + bj * 128 + n * 16) = o; }
                q += __shfl_xor(q, 16); q += __shfl_xor(q, 32);
                if (fq == 0) ss[(size_t)row * 32 + u.pn * 4 + wc] = q; } }
    }
};
struct EpiGateUp {
    static constexpr bool kBiasDMA = true; static constexpr bool kRowDMA = false; static constexpr int kStores = 8, kStoresHM = 4;
    const float* bgu; unsigned char* ws;
    __device__ __forceinline__ const char* bias_base(const pg8::Unit& u) const { return (const char*)(bgu + (size_t)u.e * 4096 + u.pn * 128); }
    __device__ __forceinline__ unsigned bias_off(const pg8::Unit&, int wc, int lane) const { return (unsigned)(((lane >> 3) & 1) * 2048 + wc * 32 + (lane & 7) * 4) * 4u; }
    __device__ __forceinline__ void operator()(const AccT& acc, const pg8::Unit& u, int wr, int wc, int fr, int fq, const LAS float* bl, int nai) const {
        const int row0 = u.pm * 256 + u.hx * 128 + wr * 64 + fr, a0 = u.pn * 128 + wc * 32 + 8 * fq;
        unsigned char* act = (unsigned char*)(ws + WS_ACT);
        const f32x4 bg0 = *(const LAS f32x4*)(bl + 8 * fq), bg1 = *(const LAS f32x4*)(bl + 8 * fq + 4), bu0 = *(const LAS f32x4*)(bl + 32 + 8 * fq), bu1 = *(const LAS f32x4*)(bl + 32 + 8 * fq + 4);
#pragma unroll
        for (int ai = 0; ai < 2; ++ai) if (ai < nai)
#pragma unroll
            for (int m = 0; m < 4; ++m) { const size_t ro = (size_t)(row0 + ai * 128 + m * 16) * DFF + a0; float o[8];
#pragma unroll
                for (int n = 0; n < 2; ++n) {
                    f32x4 g4 = acc[ai][0][m][n] + (n ? bg1 : bg0), u4 = acc[ai][1][m][n] + (n ? bu1 : bu0);
#pragma unroll
                    for (int j = 0; j < 4; ++j) { g4[j] = fminf(g4[j], 7.0f); u4[j] = __builtin_amdgcn_fmed3f(u4[j], -7.0f, 7.0f); }
                    const f32x4 t4 = g4 * (-1.702f * 1.4426950408889634f);
                    f32x4 e4;
#pragma unroll
                    for (int j = 0; j < 4; ++j) e4[j] = __builtin_amdgcn_exp2f(t4[j]);
                    e4 = e4 + 1.0f;
                    f32x4 r4;
#pragma unroll
                    for (int j = 0; j < 4; ++j) r4[j] = __builtin_amdgcn_rcpf(e4[j]);
                    const f32x4 o4 = (u4 * A8_SCALE + A8_SCALE) * (g4 * r4);
#pragma unroll
                    for (int j = 0; j < 4; ++j) o[4 * n + j] = o4[j]; }
                u32x2 w; w.x = pk4_fp8(o[0], o[1], o[2], o[3]); w.y = pk4_fp8(o[4], o[5], o[6], o[7]);
                *(u32x2*)(act + ro) = w; }
    }
};
struct EpiDown {
    static constexpr bool kBiasDMA = true; static constexpr bool kRowDMA = true; static constexpr int kStores = 0, kStoresHM = 0;
    const float* bdn; unsigned char* ws; const LAS int* cnt;
    __device__ __forceinline__ const char* bias_base(const pg8::Unit& u) const { return (const char*)(bdn + (size_t)u.e * D + u.pn * 256); }
    __device__ __forceinline__ unsigned bias_off(const pg8::Unit&, int wc, int lane) const { return (unsigned)(wc * 64 + lane * 4) * 4u; }
    __device__ __forceinline__ const char* row_base(const pg8::Unit& u) const { return (const char*)((const int*)(ws + WS_ROWTOK) + (size_t)u.e * T + u.mt * 256 + u.hx * 128); }
    __device__ __forceinline__ unsigned row_off(const pg8::Unit&, int wr, int lane) const { return (unsigned)(((lane >> 4) & 1) * 128 + wr * 64 + (lane & 15) * 4) * 4u; }
    __device__ __forceinline__ void operator()(const AccT& acc, const pg8::Unit& u, int wr, int wc, int fr, int fq, const LAS float* bl, const LAS int* rid, int nai) const {
        const int col0 = u.pn * 256 + wc * 64 + 16 * fq;
        unsigned char* y = (unsigned char*)(ws + WS_Y);
        const int nvalid = __builtin_amdgcn_readfirstlane(cnt[u.e]) - u.mt * 256;
        f32x4 bv[2][2];
#pragma unroll
        for (int bj = 0; bj < 2; ++bj) { bv[bj][0] = *(const LAS f32x4*)(bl + 16 * fq + 8 * bj) * Y8_SCALE; bv[bj][1] = *(const LAS f32x4*)(bl + 16 * fq + 8 * bj + 4) * Y8_SCALE; }
#pragma unroll
        for (int ai = 0; ai < 2; ++ai) if (ai < nai)
#pragma unroll
            for (int m = 0; m < 4; ++m) { const int rl = u.hx * 128 + ai * 128 + wr * 64 + m * 16 + fr; const int dst = rid[ai * 64 + m * 16 + fr];
                if (rl < nvalid) { const size_t ro = (size_t)dst * D + col0; unsigned wv[4];
#pragma unroll
                    for (int bj = 0; bj < 2; ++bj) { const f32x4 v0 = acc[ai][bj][m][0] * Y8_SCALE + bv[bj][0], v1 = acc[ai][bj][m][1] * Y8_SCALE + bv[bj][1];
                        wv[2 * bj] = pk4_fp8(v0[0], v0[1], v0[2], v0[3]); wv[2 * bj + 1] = pk4_fp8(v1[0], v1[1], v1[2], v1[3]); }
                    *(u32x4*)(y + ro) = (u32x4){wv[0], wv[1], wv[2], wv[3]}; } }
    }
};

__device__ __forceinline__ unsigned off_b(unsigned row, unsigned ch) { return 256u * row + 16u * (ch ^ (((row & 3) << 2) | ((row >> 2) & 3))); }
__device__ __forceinline__ unsigned row_addr16(unsigned lane, unsigned rb, unsigned s) { return off_b((lane & 15) + 16 * rb, 4 * s + (lane >> 4)); }
__device__ __forceinline__ unsigned tr_addr16(unsigned lane, unsigned c, unsigned ks, unsigned t) {
    const unsigned g = lane >> 4, q = (lane & 15) >> 2, p = lane & 3;
    return off_b(32 * ks + 8 * g + 4 * t + q, 2 * c + (p >> 1)) + 8 * (p & 1);
}
__device__ __forceinline__ bf16x8 tr_frag(LAS unsigned char* img, unsigned lane, unsigned c, unsigned ks) {
    const s16x4 a = __builtin_amdgcn_ds_read_tr16_b64_v4i16((LAS s16x4*)(img + tr_addr16(lane, c, ks, 0)));
    const s16x4 b = __builtin_amdgcn_ds_read_tr16_b64_v4i16((LAS s16x4*)(img + tr_addr16(lane, c, ks, 1)));
    return __builtin_shufflevector(a, b, 0, 1, 2, 3, 4, 5, 6, 7);
}
__device__ __forceinline__ bf16x8 row_frag(LAS unsigned char* img, unsigned lane, unsigned rb, unsigned s) { return *(const LAS bf16x8*)(img + row_addr16(lane, rb, s)); }
#define MFMA16(a, b, c) __builtin_amdgcn_mfma_f32_16x16x32_bf16(a, b, c, 0, 0, 0)
__device__ __forceinline__ unsigned row_base(unsigned lane, unsigned s) { return row_addr16(lane, 0, s); }
__device__ __forceinline__ unsigned tr_base(unsigned lane, unsigned c, unsigned t) { return tr_addr16(lane, c, 0, t); }
#define ROWF(img, base, off) (*(const LAS bf16x8*)((img) + (base) + (off)))
__device__ __forceinline__ bf16x8 trf(LAS unsigned char* img, unsigned b0, unsigned b1, unsigned off) {
    const s16x4 a = __builtin_amdgcn_ds_read_tr16_b64_v4i16((LAS s16x4*)(img + b0 + off));
    const s16x4 b = __builtin_amdgcn_ds_read_tr16_b64_v4i16((LAS s16x4*)(img + b1 + off));
    return __builtin_shufflevector(a, b, 0, 1, 2, 3, 4, 5, 6, 7);
}

__device__ __forceinline__ void spatial_unit(Frame& F, const Args& a, int n, int g) {
    LAS unsigned char* Wimg = F.lds; LAS unsigned char* Vimg = F.lds + 32768; LAS float* stats = (LAS float*)(F.lds + 65536);
    const int t0 = n * 128, ch0 = g * 128, tid = F.tid, lane = F.lane, w = F.wave;
    const bf16_t* V = (const bf16_t*)(F.ws + WS_V); const bf16_t* U = (const bf16_t*)(F.ws + WS_U); bf16_t* SG = (bf16_t*)(F.ws + WS_SG);
    const float* vstat = (const float*)(F.ws + WS_VSTAT);
    if (tid < 128) { const f32x4* p = (const f32x4*)(vstat + (size_t)(t0 + tid) * 32); float s = 0.f, q = 0.f;
#pragma unroll
        for (int j = 0; j < 8; ++j) { const f32x4 v = p[j]; s += v[0] + v[2]; q += v[1] + v[3]; }
        const float mean = s * (1.f / GW), var = q * (1.f / GW) - mean * mean;
        stats[2 * tid] = mean; stats[2 * tid + 1] = 1.0f / sqrtf(fmaxf(var, 0.f) + EPS); }
    const float* ws_g = a.in[5] + (size_t)g * 128 * 128;
#pragma unroll
    for (int i = 0; i < 4; ++i) { const int id = tid + 512 * i, t = id >> 4, ch = id & 15;
        const f32x4 x0 = *(const f32x4*)(ws_g + t * 128 + 8 * ch), x1 = *(const f32x4*)(ws_g + t * 128 + 8 * ch + 4);
        float v[8] = {x0[0], x0[1], x0[2], x0[3], x1[0], x1[1], x1[2], x1[3]};
#pragma unroll
        for (int j = 0; j < 8; ++j) v[j] = (8 * ch + j <= t) ? v[j] : 0.f;
        u32x4 o; o.x = cvt_pk_bf16(v[0], v[1]); o.y = cvt_pk_bf16(v[2], v[3]); o.z = cvt_pk_bf16(v[4], v[5]); o.w = cvt_pk_bf16(v[6], v[7]);
        *(LAS u32x4*)(Wimg + off_b(t, ch)) = o; }
    __syncthreads();
    const float* lng = a.in[3]; const float* lnb = a.in[4];
    {
        u32x4 xv[4]; const int ch = tid & 15;
#pragma unroll
        for (int i = 0; i < 4; ++i) xv[i] = __builtin_nontemporal_load((const u32x4*)(V + (size_t)(t0 + (tid >> 4) + 32 * i) * GW + ch0 + 8 * ch));
        const f32x4 g0 = *(const f32x4*)(lng + ch0 + 8 * ch), g1 = *(const f32x4*)(lng + ch0 + 8 * ch + 4), b0 = *(const f32x4*)(lnb + ch0 + 8 * ch), b1 = *(const f32x4*)(lnb + ch0 + 8 * ch + 4);
#pragma unroll
        for (int i = 0; i < 4; ++i) { const int s = (tid >> 4) + 32 * i; const u32x4 x = xv[i];
            const float mean = stats[2 * s], rstd = stats[2 * s + 1];
            float v[8] = {bf_lo(x.x), bf_hi(x.x), bf_lo(x.y), bf_hi(x.y), bf_lo(x.z), bf_hi(x.z), bf_lo(x.w), bf_hi(x.w)};
#pragma unroll
            for (int j = 0; j < 4; ++j) { v[j] = (v[j] - mean) * rstd * g0[j] + b0[j]; v[4 + j] = (v[4 + j] - mean) * rstd * g1[j] + b1[j]; }
            u32x4 o; o.x = cvt_pk_bf16(v[0], v[1]); o.y = cvt_pk_bf16(v[2], v[3]); o.z = cvt_pk_bf16(v[4], v[5]); o.w = cvt_pk_bf16(v[6], v[7]);
            *(LAS u32x4*)(Vimg + off_b(s, ch)) = o; }
    }
    __syncthreads();
    f32x4 acc[8];
#pragma unroll
    for (int c = 0; c < 8; ++c) acc[c] = (f32x4){0.f, 0.f, 0.f, 0.f};
    const int ksmax = w >> 1;
    {
        unsigned vb[8][2];
#pragma unroll
        for (int c = 0; c < 8; ++c) { vb[c][0] = tr_base(lane, c, 0); vb[c][1] = tr_base(lane, c, 1); }
        LAS unsigned char* Wrow = Wimg + 4096 * w;
#pragma unroll
        for (int ks = 0; ks < 4; ++ks) if (ks <= ksmax) {
            const bf16x8 y = ROWF(Wrow, row_base(lane, ks), 0);
            bf16x8 xf[8];
#pragma unroll
            for (int c = 0; c < 8; ++c) xf[c] = trf(Vimg, vb[c][0], vb[c][1], 8192 * ks);
            __builtin_amdgcn_sched_barrier(0);
#pragma unroll
            for (int c = 0; c < 8; ++c) acc[c] = MFMA16(xf[c], y, acc[c]);
            __builtin_amdgcn_sched_barrier(0);
        }
    }
    {
        LAS unsigned char* MT = F.lds + 66560;
        const int t = 16 * w + (lane & 15); const float bias = a.in[6][g * 128 + t];
#pragma unroll
        for (int c = 0; c < 8; ++c) *(LAS f32x4*)(MT + t * 528 + (16 * c + 4 * (lane >> 4)) * 4) = acc[c] + bias;
        __syncthreads();
        u32x4 uu[4];
#pragma unroll
        for (int i = 0; i < 4; ++i) uu[i] = __builtin_nontemporal_load((const u32x4*)(U + (size_t)(t0 + (tid >> 4) + 32 * i) * GW + ch0 + 8 * (tid & 15)));
#pragma unroll
        for (int i = 0; i < 4; ++i) { const int tt = (tid >> 4) + 32 * i, ch = tid & 15;
            const f32x4 m0 = *(const LAS f32x4*)(MT + tt * 528 + ch * 32), m1 = *(const LAS f32x4*)(MT + tt * 528 + ch * 32 + 16);
            const u32x4 u4 = uu[i];
            u32x4 r; r.x = cvt_pk_bf16(bf_lo(u4.x) * m0[0], bf_hi(u4.x) * m0[1]); r.y = cvt_pk_bf16(bf_lo(u4.y) * m0[2], bf_hi(u4.y) * m0[3]);
            r.z = cvt_pk_bf16(bf_lo(u4.z) * m1[0], bf_hi(u4.z) * m1[1]); r.w = cvt_pk_bf16(bf_lo(u4.w) * m1[2], bf_hi(u4.w) * m1[3]);
            *(u32x4*)(SG + (size_t)(t0 + tt) * GW + ch0 + 8 * ch) = r; }
    }
    __syncthreads();
}

__device__ __forceinline__ void kv_unit(Frame& F, const Args& a, int c, int h) {
    LAS unsigned char* Kimg = F.lds; LAS unsigned char* Vimg = F.lds + 32768;
    const int t0 = c * 128, tid = F.tid, lane = F.lane, w = F.wave;
    const bf16_t* Kb = (const bf16_t*)(F.ws + WS_K); const bf16_t* RV = (const bf16_t*)(F.ws + WS_RV); float* KV = (float*)(F.ws + WS_KV);
    const float l2g = a.l2g[h];
    {
        u32x4 kx[4], vx[8];
#pragma unroll
        for (int i = 0; i < 4; ++i) kx[i] = *(const u32x4*)(Kb + (size_t)(t0 + (tid >> 4) + 32 * i) * QKW + h * 128 + 8 * (tid & 15));
#pragma unroll
        for (int i = 0; i < 8; ++i) vx[i] = *(const u32x4*)(RV + (size_t)(t0 + (tid >> 5) + 16 * i) * D + h * 256 + 8 * (tid & 31));
#pragma unroll
        for (int i = 0; i < 4; ++i) *(LAS u32x4*)(Kimg + off_b((tid >> 4) + 32 * i, tid & 15)) = kx[i];
#pragma unroll
        for (int i = 0; i < 8; ++i) { const int s = (tid >> 5) + 16 * i, ch = tid & 31; const u32x4 x = vx[i]; const float z = exp2f((float)(127 - s) * l2g);
            u32x4 o; o.x = cvt_pk_bf16(bf_lo(x.x) * z, bf_hi(x.x) * z); o.y = cvt_pk_bf16(bf_lo(x.y) * z, bf_hi(x.y) * z); o.z = cvt_pk_bf16(bf_lo(x.z) * z, bf_hi(x.z) * z); o.w = cvt_pk_bf16(bf_lo(x.w) * z, bf_hi(x.w) * z);
            *(LAS u32x4*)(Vimg + (ch >> 4) * 32768 + off_b(s, ch & 15)) = o; }
    }
    __syncthreads();
    f32x4 acc[2][8];
#pragma unroll
    for (int j = 0; j < 2; ++j)
#pragma unroll
        for (int cd = 0; cd < 8; ++cd) acc[j][cd] = (f32x4){0.f, 0.f, 0.f, 0.f};
    LAS unsigned char* vi = Vimg + (w >> 2) * 32768; const int cimg = (2 * w) & 7;
    {
        unsigned kb[8][2], vb[2][2];
#pragma unroll
        for (int cd = 0; cd < 8; ++cd) { kb[cd][0] = tr_base(lane, cd, 0); kb[cd][1] = tr_base(lane, cd, 1); }
#pragma unroll
        for (int j = 0; j < 2; ++j) { vb[j][0] = tr_base(lane, cimg + j, 0); vb[j][1] = tr_base(lane, cimg + j, 1); }
#pragma unroll
        for (int ks = 0; ks < 4; ++ks) {
            const bf16x8 y0 = trf(vi, vb[0][0], vb[0][1], 8192 * ks), y1 = trf(vi, vb[1][0], vb[1][1], 8192 * ks);
            bf16x8 xf[8];
#pragma unroll
            for (int cd = 0; cd < 8; ++cd) xf[cd] = trf(Kimg, kb[cd][0], kb[cd][1], 8192 * ks);
            __builtin_amdgcn_sched_barrier(0);
#pragma unroll
            for (int cd = 0; cd < 8; ++cd) { acc[0][cd] = MFMA16(xf[cd], y0, acc[0][cd]); acc[1][cd] = MFMA16(xf[cd], y1, acc[1][cd]); }
            __builtin_amdgcn_sched_barrier(0);
        }
    }
    bf16_t* out = (bf16_t*)KV + (size_t)(c * 8 + h) * 32768;
    __syncthreads();
    LAS unsigned char* KT = F.lds;
#pragma unroll
    for (int j = 0; j < 2; ++j)
#pragma unroll
        for (int cd = 0; cd < 8; ++cd) { const int e = 16 * (2 * w + j) + (lane & 15), d = 16 * cd + 4 * (lane >> 4);
            u32x2 o; o.x = cvt_pk_bf16(acc[j][cd][0], acc[j][cd][1]); o.y = cvt_pk_bf16(acc[j][cd][2], acc[j][cd][3]); *(LAS u32x2*)(KT + e * 272 + d * 2) = o; }
    __syncthreads();
#pragma unroll
    for (int i = 0; i < 8; ++i) { const int id = tid + 512 * i, e = id >> 4, ch = id & 15;
        *(u32x4*)(out + e * 128 + 8 * ch) = *(const LAS u32x4*)(KT + e * 272 + 16 * ch); }
    __syncthreads();
}

__device__ __forceinline__ void scan_phase(Frame& F, const Args& a, int bi, int nb) {
    const unsigned* KV = (const unsigned*)(F.ws + WS_KV); unsigned* ST = (unsigned*)(F.ws + WS_ST);
    for (int pb = bi * NTHREADS; pb < 131072; pb += nb * NTHREADS) {
        const int h = __builtin_amdgcn_readfirstlane(pb >> 14); const unsigned qo = (unsigned)(pb & 16383) + (unsigned)F.tid; const float dh = exp2f(128.0f * a.l2g[h]);
        const unsigned* kvb = KV + (size_t)h * 16384; unsigned* stb = ST + (size_t)h * 16384;
        float s0 = 0.f, s1 = 0.f;
        {
            unsigned kv[NCHUNK];
#pragma unroll
            for (int j = 0; j < NCHUNK; ++j) kv[j] = __builtin_nontemporal_load(kvb + (size_t)j * 131072 + qo);
#pragma unroll
            for (int j = 0; j < NCHUNK; ++j) { (stb + (size_t)j * 131072)[qo] = cvt_pk_bf16(s0, s1); s0 = s0 * dh + bf_lo(kv[j]); s1 = s1 * dh + bf_hi(kv[j]); }
        }
    }
}

__device__ __forceinline__ void ret_unit(Frame& F, const Args& a, int c, int h) {
    LAS unsigned char* Qimg = F.lds; LAS unsigned char* Kimg = F.lds + 32768; LAS unsigned char* Vimg = F.lds + 65536;
    LAS float* part = (LAS float*)(F.lds + AUX_OFF); LAS float* stats = (LAS float*)(F.lds + AUX_OFF + 8192);
    const int t0 = c * 128, tid = F.tid, lane = F.lane, w = F.wave;
    const bf16_t* Qb = (const bf16_t*)(F.ws + WS_Q); const bf16_t* Kb = (const bf16_t*)(F.ws + WS_K); const bf16_t* RV = (const bf16_t*)(F.ws + WS_RV);
    const bf16_t* RG = (const bf16_t*)(F.ws + WS_RG); const bf16_t* ST = (const bf16_t*)(F.ws + WS_ST); bf16_t* RO = (bf16_t*)(F.ws + WS_RO);
    const float l2g = a.l2g[h];
    bf16x8 stf[2][4];
#pragma unroll
    for (int j = 0; j < 2; ++j)
#pragma unroll
        for (int ks = 0; ks < 4; ++ks) stf[j][ks] = __builtin_nontemporal_load((const bf16x8*)(ST + (size_t)(c * 8 + h) * 32768 + (16 * (2 * w + j) + (lane & 15)) * 128 + 32 * ks + 8 * (lane >> 4)));
    {
        u32x4 qx[4], kx[4], vx[8];
#pragma unroll
        for (int i = 0; i < 4; ++i) { const size_t o = (size_t)(t0 + (tid >> 4) + 32 * i) * QKW + h * 128 + 8 * (tid & 15); qx[i] = __builtin_nontemporal_load((const u32x4*)(Qb + o)); kx[i] = __builtin_nontemporal_load((const u32x4*)(Kb + o)); }
#pragma unroll
        for (int i = 0; i < 8; ++i) vx[i] = __builtin_nontemporal_load((const u32x4*)(RV + (size_t)(t0 + (tid >> 5) + 16 * i) * D + h * 256 + 8 * (tid & 31)));
#pragma unroll
        for (int i = 0; i < 4; ++i) { const unsigned o = off_b((tid >> 4) + 32 * i, tid & 15); *(LAS u32x4*)(Qimg + o) = qx[i]; *(LAS u32x4*)(Kimg + o) = kx[i]; }
#pragma unroll
        for (int i = 0; i < 8; ++i) *(LAS u32x4*)(Vimg + ((tid & 31) >> 4) * 32768 + off_b((tid >> 5) + 16 * i, tid & 15)) = vx[i];
    }
    __syncthreads();
    u32x2 pk[8];
    const int csmax = (w | 1);
    unsigned rb4[4];
#pragma unroll
    for (int ks = 0; ks < 4; ++ks) rb4[ks] = row_base(lane, ks);
    {
        bf16x8 yq[4];
#pragma unroll
        for (int ks = 0; ks < 4; ++ks) yq[ks] = ROWF(Qimg + 4096 * w, rb4[ks], 0);
        const int tt = 16 * w + (lane & 15);
#pragma unroll
        for (int cs = 0; cs < 8; ++cs) {
            pk[cs] = (u32x2){0u, 0u};
            if (cs <= csmax) {
                f32x4 sacc = (f32x4){0.f, 0.f, 0.f, 0.f};
                bf16x8 kf[4];
#pragma unroll
                for (int ks = 0; ks < 4; ++ks) kf[ks] = ROWF(Kimg, rb4[ks], 4096 * cs);
                __builtin_amdgcn_sched_barrier(0);
#pragma unroll
                for (int ks = 0; ks < 4; ++ks) sacc = MFMA16(kf[ks], yq[ks], sacc);
                float v[4];
#pragma unroll
                for (int r = 0; r < 4; ++r) { const int ss = 16 * cs + 4 * (lane >> 4) + r; v[r] = (tt >= ss) ? sacc[r] * exp2f((float)(tt - ss) * l2g) : 0.f; }
                pk[cs].x = cvt_pk_bf16(v[0], v[1]); pk[cs].y = cvt_pk_bf16(v[2], v[3]);
            }
        }
    }
    f32x4 acc[2][8];
#pragma unroll
    for (int j = 0; j < 2; ++j)
#pragma unroll
        for (int ct = 0; ct < 8; ++ct) acc[j][ct] = (f32x4){0.f, 0.f, 0.f, 0.f};
#pragma unroll
    for (int ct = 0; ct < 8; ++ct) {
        bf16x8 yy[4];
#pragma unroll
        for (int ks = 0; ks < 4; ++ks) yy[ks] = ROWF(Qimg, rb4[ks], 4096 * ct);
        __builtin_amdgcn_sched_barrier(0);
#pragma unroll
        for (int ks = 0; ks < 4; ++ks) { acc[0][ct] = MFMA16(stf[0][ks], yy[ks], acc[0][ct]); acc[1][ct] = MFMA16(stf[1][ks], yy[ks], acc[1][ct]); }
        const float xi = exp2f((float)(16 * ct + (lane & 15) + 1) * l2g);
        acc[0][ct] *= xi; acc[1][ct] *= xi;
        __builtin_amdgcn_sched_barrier(0);
    }
    __syncthreads();
    LAS unsigned char* Pimg = Kimg;
    {
        const int tt = 16 * w + (lane & 15);
#pragma unroll
        for (int cs = 0; cs < 8; ++cs) if (cs <= csmax) *(LAS u32x2*)(Pimg + off_b(tt, 2 * cs + (lane >> 5)) + 8 * ((lane >> 4) & 1)) = pk[cs];
    }
    __syncthreads();
    {
        LAS unsigned char* vi = Vimg + (w >> 2) * 32768; const int cimg = (2 * w) & 7;
        unsigned vb[2][2];
#pragma unroll
        for (int j = 0; j < 2; ++j) { vb[j][0] = tr_base(lane, cimg + j, 0); vb[j][1] = tr_base(lane, cimg + j, 1); }
        bf16x8 xv[2][4];
#pragma unroll
        for (int ks = 0; ks < 4; ++ks) { xv[0][ks] = trf(vi, vb[0][0], vb[0][1], 8192 * ks); xv[1][ks] = trf(vi, vb[1][0], vb[1][1], 8192 * ks); }
#pragma unroll
        for (int ct = 0; ct < 8; ++ct) {
            bf16x8 yy[4];
#pragma unroll
            for (int ks = 0; ks < 4; ++ks) if (ks <= (ct >> 1)) yy[ks] = ROWF(Pimg, rb4[ks], 4096 * ct);
            __builtin_amdgcn_sched_barrier(0);
#pragma unroll
            for (int ks = 0; ks < 4; ++ks) if (ks <= (ct >> 1)) { acc[0][ct] = MFMA16(xv[0][ks], yy[ks], acc[0][ct]); acc[1][ct] = MFMA16(xv[1][ks], yy[ks], acc[1][ct]); }
            __builtin_amdgcn_sched_barrier(0);
        }
    }
    {
        float s8[8], q8[8];
#pragma unroll
        for (int ct = 0; ct < 8; ++ct) { float s = 0.f, q = 0.f;
#pragma unroll
            for (int j = 0; j < 2; ++j)
#pragma unroll
                for (int r = 0; r < 4; ++r) { const float v = acc[j][ct][r]; s += v; q += v * v; }
            s8[ct] = s; q8[ct] = q; }
        float s16[8], q16[8];
#pragma unroll
        for (int ct = 0; ct < 8; ++ct) { s16[ct] = __shfl_xor(s8[ct], 16); q16[ct] = __shfl_xor(q8[ct], 16); }
        __builtin_amdgcn_sched_barrier(0);
#pragma unroll
        for (int ct = 0; ct < 8; ++ct) { s8[ct] += s16[ct]; q8[ct] += q16[ct]; }
#pragma unroll
        for (int ct = 0; ct < 8; ++ct) { s16[ct] = __shfl_xor(s8[ct], 32); q16[ct] = __shfl_xor(q8[ct], 32); }
        __builtin_amdgcn_sched_barrier(0);
#pragma unroll
        for (int ct = 0; ct < 8; ++ct) { const float s = s8[ct] + s16[ct], q = q8[ct] + q16[ct];
            if ((lane >> 4) == 0) { part[((16 * ct + lane) * 8 + w) * 2] = s; part[((16 * ct + lane) * 8 + w) * 2 + 1] = q; } }
    }
    __syncthreads();
    if (tid < 128) { float s = 0.f, q = 0.f;
#pragma unroll
        for (int j = 0; j < 8; ++j) { s += part[(tid * 8 + j) * 2]; q += part[(tid * 8 + j) * 2 + 1]; }
        const float mean = s * (1.f / 256.f), var = q * (1.f / 256.f) - mean * mean;
        stats[2 * tid] = mean; stats[2 * tid + 1] = 1.0f / sqrtf(fmaxf(var, 0.f) + EPS); }
    __syncthreads();
    {
        LAS unsigned char* OT = F.lds;
#pragma unroll
        for (int ct = 0; ct < 8; ++ct) { const int tt = 16 * ct + (lane & 15); const float mean = stats[2 * tt], rstd = stats[2 * tt + 1];
#pragma unroll
            for (int j = 0; j < 2; ++j) { const f32x4 v = (acc[j][ct] - mean) * rstd; u32x2 r; r.x = cvt_pk_bf16(v[0], v[1]); r.y = cvt_pk_bf16(v[2], v[3]);
                *(LAS u32x2*)(OT + tt * 528 + (16 * (2 * w + j) + 4 * (lane >> 4)) * 2) = r; } }
        __syncthreads();
        u32x4 gx[8];
#pragma unroll
        for (int i = 0; i < 8; ++i) gx[i] = __builtin_nontemporal_load((const u32x4*)(RG + (size_t)(t0 + (tid >> 5) + 16 * i) * D + h * 256 + 8 * (tid & 31)));
#pragma unroll
        for (int i = 0; i < 8; ++i) { const int tt = (tid >> 5) + 16 * i, ch = tid & 31;
            const u32x4 v = *(const LAS u32x4*)(OT + tt * 528 + ch * 16); const u32x4 g = gx[i];
            u32x4 r; r.x = cvt_pk_bf16(bf_lo(v.x) * bf_lo(g.x), bf_hi(v.x) * bf_hi(g.x)); r.y = cvt_pk_bf16(bf_lo(v.y) * bf_lo(g.y), bf_hi(v.y) * bf_hi(g.y));
            r.z = cvt_pk_bf16(bf_lo(v.z) * bf_lo(g.z), bf_hi(v.z) * bf_hi(g.z)); r.w = cvt_pk_bf16(bf_lo(v.w) * bf_lo(g.w), bf_hi(v.w) * bf_hi(g.w));
            *(u32x4*)(RO + (size_t)(t0 + tt) * D + h * 256 + 8 * ch) = r; }
    }
    __syncthreads();
}

__device__ __forceinline__ void router_tile(Frame& F, const Args& a, int tile) {
    LAS float* part = (LAS float*)F.lds;
    LAS int* cntl = (LAS int*)(F.lds + 40960); LAS int* basel = cntl + 32;
    const int tid = F.tid, lane = F.lane, w = F.wave, ts = w & 1, kq = w >> 1, i = lane & 31, kh = lane >> 5;
    const int tok = tile * 64 + 32 * ts + i;
    const float* X1 = (const float*)(F.ws + WS_X1); const float* SS = (const float*)(F.ws + WS_SS); unsigned char* H2 = (unsigned char*)(F.ws + WS_H);
    const float* g2 = a.in[10]; const float* rw = a.in[11]; const float* rb = a.in[12];
    if (tid < 32) cntl[tid] = 0;
    float ssum = 0.f;
#pragma unroll
    for (int j = 0; j < 8; ++j) { const f32x4 v = *(const f32x4*)(SS + (size_t)tok * 32 + 4 * j); ssum += (v[0] + v[1]) + (v[2] + v[3]); }
    const float rstd = 1.0f / sqrtf(ssum * (1.f / D) + EPS);
    f32x16 acc;
#pragma unroll
    for (int r = 0; r < 16; ++r) acc[r] = 0.f;
    LAS float* rwl = (LAS float*)(F.lds + 49152); LAS float* g2l = (LAS float*)(F.lds + 114688);
    { const f32x4 gv = *(const f32x4*)(g2 + 4 * tid); *(LAS f32x4*)(g2l + 4 * tid) = gv; }
    const unsigned rwl_u = (unsigned)__builtin_amdgcn_readfirstlane((int)((unsigned)(size_t)rwl + (unsigned)(kq * 8192 + ts * 4096)));
#define RW_STAGE(p_) do { const char* src_ = (const char*)(rw + (size_t)(512 * kq + 64 * (p_) + 32 * ts) * NE); const unsigned dst_ = rwl_u + (unsigned)(((p_) & 1) * 32768); \
        _Pragma("unroll") for (int j = 0; j < 4; ++j) pg8::glds16(src_, (unsigned)(lane * 16 + j * 1024), dst_ + (unsigned)(j * 1024)); } while (0)
    RW_STAGE(0);
    asm volatile("s_waitcnt vmcnt(0)" ::: "memory");
    {
        f32x4 xc[4]; float avp[16];
#pragma unroll
        for (int q = 0; q < 16; ++q) avp[q] = 0.f;
#define RT_LOAD(sc_, X) do { const int kb_ = 512 * kq + 64 * ((sc_) >> 1) + 32 * kh + 16 * ((sc_) & 1); \
            _Pragma("unroll") for (int q = 0; q < 4; ++q) X[q] = *(const f32x4*)(X1 + (size_t)tok * D + kb_ + 4 * q); } while (0)
        RT_LOAD(0, xc);
#pragma unroll 1
        for (int sc = 0; sc < 16; ++sc) {
            if ((sc & 1) == 0) {
                asm volatile("s_waitcnt lgkmcnt(0)" ::: "memory"); __builtin_amdgcn_s_barrier(); asm volatile("" ::: "memory");
                if (sc < 14) RW_STAGE((sc >> 1) + 1); }
            const int kb = 512 * kq + 64 * (sc >> 1) + 32 * kh + 16 * (sc & 1);
            f32x4 xn[4];
            { const int sn = sc < 15 ? sc + 1 : 15; RT_LOAD(sn, xn); }
            f32x4 gc[4]; float bc[16];
#pragma unroll
            for (int q = 0; q < 4; ++q) gc[q] = *(const LAS f32x4*)(g2l + kb + 4 * q);
            { const LAS float* rwb = rwl + ((sc >> 1) & 1) * 8192 + kq * 2048 + (32 * kh + 16 * (sc & 1)) * 32 + i;
#pragma unroll
              for (int q = 0; q < 16; ++q) bc[q] = rwb[q * 32]; }
            float av[16];
#pragma unroll
            for (int q = 0; q < 4; ++q) { av[4 * q] = xc[q][0] * rstd * gc[q][0]; av[4 * q + 1] = xc[q][1] * rstd * gc[q][1]; av[4 * q + 2] = xc[q][2] * rstd * gc[q][2]; av[4 * q + 3] = xc[q][3] * rstd * gc[q][3]; }
            if (sc & 1) {
                float v32[32];
#pragma unroll
                for (int q = 0; q < 16; ++q) { v32[q] = avp[q]; v32[16 + q] = av[q]; }
                u32x4 lo, hi; q6_block(v32, lo, hi);
                const int k0 = kb - 16, b32 = k0 >> 5;
                unsigned char* base = H2 + (size_t)tok * D + 128 * (b32 >> 2) + 16 * (b32 & 3);
                *(u32x4*)base = lo; *(u32x4*)(base + 64) = hi;
            }
#pragma unroll
            for (int q = 0; q < 16; ++q) avp[q] = av[q];
#pragma unroll
            for (int q = 0; q < 16; ++q) acc = __builtin_amdgcn_mfma_f32_32x32x2f32(av[q], bc[q], acc, 0, 0, 0);
#pragma unroll
            for (int q = 0; q < 4; ++q) xc[q] = xn[q];
        }
#undef RT_LOAD
#undef RW_STAGE
    }
#pragma unroll
    for (int r = 0; r < 16; ++r) { const int row = (r & 3) + 8 * (r >> 2) + 4 * kh; part[((kq * 2 + ts) * 32 + row) * 33 + i] = acc[r]; }
    __syncthreads();
    int te[4] = {0, 0, 0, 0}; float tv[4] = {-3.0e38f, -3.0e38f, -3.0e38f, -3.0e38f}; int lr[4] = {0, 0, 0, 0};
    if (tid < 64) {
        const int tsl = tid >> 5, rowl = tid & 31;
        for (int e = 0; e < NE; ++e) {
            float lg = rb[e];
#pragma unroll
            for (int q = 0; q < 4; ++q) lg += part[((q * 2 + tsl) * 32 + rowl) * 33 + e];
            if (lg > tv[3]) { tv[3] = lg; te[3] = e;
#pragma unroll
                for (int j = 3; j > 0; --j) if (tv[j] > tv[j - 1]) { const float fv = tv[j]; tv[j] = tv[j - 1]; tv[j - 1] = fv; const int iv = te[j]; te[j] = te[j - 1]; te[j - 1] = iv; } }
        }
#pragma unroll
        for (int k = 0; k < 4; ++k) lr[k] = __hip_atomic_fetch_add(&cntl[te[k]], 1, __ATOMIC_RELAXED, __HIP_MEMORY_SCOPE_WORKGROUP);
    }
    __syncthreads();
    if (tid < 32) { const int cn = cntl[tid]; int base = 0; if (cn > 0) base = (int)__hip_atomic_fetch_add((unsigned*)(F.ws + WS_CTL) + CW_CNT + 16 * tid, (unsigned)cn, __ATOMIC_RELAXED, __HIP_MEMORY_SCOPE_AGENT); basel[tid] = base; }
    __syncthreads();
    if (tid < 64) {
        const int t = tile * 64 + tid;
        int* TOKE = (int*)(F.ws + WS_TOKE); int* TOKR = (int*)(F.ws + WS_TOKR); float* TOKW = (float*)(F.ws + WS_TOKW); int* ROWTOK = (int*)(F.ws + WS_ROWTOK);
        float ex[4], sum = 0.f;
#pragma unroll
        for (int k = 0; k < 4; ++k) { ex[k] = __expf(tv[k] - tv[0]); sum += ex[k]; }
        const float inv = 1.0f / sum;
#pragma unroll
        for (int k = 0; k < 4; ++k) { const int rank = basel[te[k]] + lr[k]; TOKE[t * 4 + k] = te[k]; TOKR[t * 4 + k] = rank; TOKW[t * 4 + k] = ex[k] * inv; ROWTOK[te[k] * T + rank] = t * 4 + k; }
    }
    __syncthreads();
}

__device__ __forceinline__ void moe_table(Frame& F, LAS int* cnt, LAS int* tall, LAS int* tfull, LAS int* tsmall, LAS int* thalf) {
    if (F.tid < 64) {
        const int e = F.lane; int c = 0;
        if (e < NE) c = (int)__hip_atomic_load((unsigned*)(F.ws + WS_CTL) + CW_CNT + 16 * e, __ATOMIC_RELAXED, __HIP_MEMORY_SCOPE_AGENT);
        const int tl = (c + 255) >> 8; const int rem = c - 256 * (tl - 1); const int sm = (MK_HM && tl > 0 && rem <= 128) ? 1 : 0;
        int ia = tl, is = sm;
#pragma unroll
        for (int o = 1; o < 32; o <<= 1) { const int va = __shfl_up(ia, o), vs = __shfl_up(is, o); if ((F.lane & 31) >= o) { ia += va; is += vs; } }
        if (e < NE) { cnt[e] = c; tall[e + 1] = ia; tsmall[e + 1] = is; tfull[e + 1] = ia - is; thalf[e + 1] = 2 * ia; }
        if (e == 0) { tall[0] = 0; tsmall[0] = 0; tfull[0] = 0; thalf[0] = 0; }
    }
    __syncthreads();
}

__device__ __forceinline__ void combine_phase(Frame& F, const Args& a) {
    const int gw = F.vcu * NWAVES + F.wave, NGW = F.G * NWAVES, lane = F.lane;
    const float* X1 = (const float*)(F.ws + WS_X1); const unsigned char* Y = (const unsigned char*)(F.ws + WS_Y);
    const int* TOKE = (const int*)(F.ws + WS_TOKE); const int* TOKR = (const int*)(F.ws + WS_TOKR); const float* TOKW = (const float*)(F.ws + WS_TOKW);
    const float* gf = a.in[17];
    f32x4 gfv[8];
#pragma unroll
    for (int j = 0; j < 8; ++j) gfv[j] = ((const f32x4*)gf)[lane + 64 * j];
    for (int t = gw; t < T; t += NGW) {
        f32x4 v[8]; unsigned yy[4][8];
#pragma unroll
        for (int j = 0; j < 8; ++j) v[j] = __builtin_nontemporal_load((const f32x4*)(X1 + (size_t)t * D) + lane + 64 * j);
        const f32x4 w4 = *(const f32x4*)(TOKW + (size_t)t * 4);
#pragma unroll
        for (int k = 0; k < 4; ++k) { const unsigned* yr = (const unsigned*)(Y + ((size_t)t * 4 + k) * D) + lane;
#pragma unroll
            for (int j = 0; j < 8; ++j) yy[k][j] = __builtin_nontemporal_load(yr + 64 * j); }
#pragma unroll
        for (int k = 0; k < 4; ++k) { const float wq = w4[k] * (1.0f / Y8_SCALE);
#pragma unroll
            for (int j = 0; j < 8; ++j) { const unsigned y = yy[k][j]; const f32x2 lo = __builtin_amdgcn_cvt_pk_f32_fp8((int)y, false), hi = __builtin_amdgcn_cvt_pk_f32_fp8((int)y, true);
                v[j][0] += wq * lo.x; v[j][1] += wq * lo.y; v[j][2] += wq * hi.x; v[j][3] += wq * hi.y; } }
        float s = 0.f;
#pragma unroll
        for (int j = 0; j < 8; ++j) s += (v[j][0] * v[j][0] + v[j][1] * v[j][1]) + (v[j][2] * v[j][2] + v[j][3] * v[j][3]);
        const float rstd = 1.0f / sqrtf(wave_sum(s) * (1.f / D) + EPS);
#pragma unroll
        for (int j = 0; j < 8; ++j) __builtin_nontemporal_store(v[j] * rstd * gfv[j], (f32x4*)(a.out + (size_t)t * D) + lane + 64 * j);
    }
}

__device__ __forceinline__ int reframe(Frame& F) { int t_ = threadIdx.x; asm volatile("" : "+v"(t_)); F.tid = t_; F.lane = t_ & 63; F.wave = __builtin_amdgcn_readfirstlane(t_ >> 6); return 0; }
constexpr int N_PHASES = 12;
__global__ void __launch_bounds__(NTHREADS, 2) mk_fwd(Args args) {
    extern __shared__ __attribute__((aligned(16))) unsigned char lds[];
    Frame F;
    F.lds = (LAS unsigned char*)lds;
    F.tid = threadIdx.x; F.lane = F.tid & 63; F.wave = __builtin_amdgcn_readfirstlane(F.tid >> 6);
    F.G = gridDim.x; { const int bx = blockIdx.x; F.vcu = (F.G % 8 == 0) ? (bx % 8) * (F.G / 8) + bx / 8 : bx; }
    F.ws = args.ws;
    volatile LAS unsigned* MISC = (volatile LAS unsigned*)(F.lds + MISC_OFF);
    for (int u = F.tid; u < (LDS_BYTES - MISC_OFF) / 4; u += NTHREADS) MISC[u] = 0u;
    __syncthreads();
    unsigned* ctl = (unsigned*)(F.ws + WS_CTL);
    XcdBarrier bar; bar.bar = ctl + CW_BAR; bar.x = 0; bar.st = nullptr;
    if (MK_N_LAUNCHES == 1) bar = xcd_barrier_post(ctl + CW_BAR, MISC + 8);
    const int lo = args.ph_lo, hi = args.ph_hi;
#define IN(k) ((((MK_PHASES) >> (k)) & 1) && lo <= (k) && (k) < hi)
#define SEAM(k) do { if (IN(k) && IN((k) + 1)) xcd_barrier(bar); } while (0)
    LAS int* mcnt = (LAS int*)(F.lds + MISC_OFF + 256); LAS int* mtstart = mcnt + 32; LAS int* mtfull = mcnt + 96; LAS int* mtsmall = mcnt + 160; LAS int* mthalf = mcnt + 224;

#define REFRAME() do { int t_ = threadIdx.x; asm volatile("" : "+v"(t_)); F.tid = t_; F.lane = t_ & 63; F.wave = __builtin_amdgcn_readfirstlane(t_ >> 6); } while (0)
#define REP(k) for (int rep_ = reframe(F); rep_ < (((MK_DUP) >> (k)) & 1) + 1; ++rep_)
#define REPBAR(k) do { if ((((MK_DUP) >> (k)) & 1) && rep_ == 0) xcd_barrier(bar); } while (0)
    if (IN(0)) REP(0) { p0_prologue(F, args); if (MK_CONV_IN_P0) conv_rest(F, args, F.vcu * NWAVES + F.wave, F.G * NWAVES); REPBAR(0); } SEAM(0);
    if (IN(1)) REP(1) {
        const int nconv = (MK_NCONV * F.G) / 256, ngemm = F.G - nconv;
        if ((int)blockIdx.x < ngemm) {
            pg8::DenseSched S; S.init((const bf16_t*)(F.ws + WS_H), D, (const bf16_t*)(F.ws + WS_WIN), D, T, INW, ngemm, (int)blockIdx.x);
            EpiInProj E{F.ws};
            if (MK_RSYNC) pg8::gemm_phase<0, EpiInProj, pg8::DenseSched, 127, 127, true>(F.lds, S, E, &bar); else pg8::gemm_phase<0>(F.lds, S, E);
        } else if (!MK_CONV_IN_P0) conv_rest(F, args, ((int)blockIdx.x - ngemm) * NWAVES + F.wave, nconv * NWAVES);
        REPBAR(1);
    } SEAM(1);
    if (IN(2)) REP(2) {
        if (MK_NSCAN == 0) for (int u = blockIdx.x; u < 1024; u += F.G) spatial_unit(F, args, u >> 3, u & 7);
        for (int u = blockIdx.x; u < 1024; u += F.G) kv_unit(F, args, u >> 3, u & 7);
        REPBAR(2);
    } SEAM(2);
    if (IN(3)) REP(3) {
        const int nscan = (MK_NSCAN * F.G) / 256, nsp = F.G - nscan;
        if (MK_NSCAN == 0) scan_phase(F, args, (int)blockIdx.x, F.G);
        else if ((int)blockIdx.x < nsp) { for (int u = blockIdx.x; u < 1024; u += nsp) spatial_unit(F, args, u >> 3, u & 7); }
        else scan_phase(F, args, (int)blockIdx.x - nsp, nscan);
        REPBAR(3);
    } SEAM(3);
    if (IN(4)) REP(4) { for (int u = blockIdx.x; u < 1024; u += F.G) ret_unit(F, args, u >> 3, u & 7); REPBAR(4); } SEAM(4);
    if (IN(5)) REP(5) {
        { pg8::DenseSched S; S.init((const bf16_t*)(F.ws + WS_SG), GW, (const bf16_t*)(F.ws + WS_WPA), GW, T, D, F.G, (int)blockIdx.x); EpiMerge<0> E{F.ws}; pg8::gemm_phase<0>(F.lds, S, E); }
        __syncthreads();
        { pg8::DenseSched S; S.init((const bf16_t*)(F.ws + WS_RO), D, (const bf16_t*)(F.ws + WS_WPR), D, T, D, F.G, (int)blockIdx.x); EpiMerge<1> E{F.ws}; pg8::gemm_phase<0>(F.lds, S, E); }
        REPBAR(5);
    } SEAM(5);
    if (IN(6)) REP(6) {
        pg8::DenseSched S; S.init((const bf16_t*)(F.ws + WS_MRG), D, (const bf16_t*)(F.ws + WS_WOUT), D, T, D, F.G, (int)blockIdx.x);
        EpiOut E{args.in[0], F.ws};
        pg8::gemm_phase<0>(F.lds, S, E); REPBAR(6);
    } SEAM(6);
    if (IN(7)) { REFRAME(); for (int tile = blockIdx.x; tile < T / 64; tile += F.G) router_tile(F, args, tile); } SEAM(7);
#define MOE_SCHED(SV, GATHER_, MODE_, A_, LDA_, BT_, K_, NB_, NN_, TS_) pg8::MoeSched<GATHER_, MODE_> SV; SV.A = (const bf16_t*)(A_); SV.lda = (LDA_); SV.Bt = (const bf16_t*)(BT_); SV.K = (K_); SV.NB = (NB_); SV.nN = (NN_); SV.tstart = (TS_); SV.tall = mtstart; \
        SV.cnt = mcnt; SV.rowtok = (GATHER_) ? (const int*)(F.ws + WS_ROWTOK) : nullptr; SV.aux = F.lds + AUX_OFF; SV.nwg = __builtin_amdgcn_readfirstlane((TS_)[NE]) * (NN_); SV.G = F.G; SV.c = (int)blockIdx.x; SV.ecur = 0
    if (IN(8)) REP(8) {
        moe_table(F, mcnt, mtstart, mtfull, mtsmall, mthalf);
        EpiGateUp E{args.in[14], F.ws};
        if (!MK_HM_TEST) { MOE_SCHED(S, true, 0, F.ws + WS_H, D / 2, F.ws + WS_WGU, D / 2, 4096, 16, mtfull); pg8::gemm_phase<2, EpiGateUp, pg8::MoeSched<true, 0>>(F.lds, S, E); }
        __syncthreads();
        if (MK_HM_TEST) { MOE_SCHED(S, true, 2, F.ws + WS_H, D / 2, F.ws + WS_WGU, D / 2, 4096, 16, mthalf); pg8::gemm_phase<2, EpiGateUp, pg8::MoeSched<true, 2>, 127, 127, false, true>(F.lds, S, E); }
        else if (MK_HM) { MOE_SCHED(S, true, 1, F.ws + WS_H, D / 2, F.ws + WS_WGU, D / 2, 4096, 16, mtsmall); pg8::gemm_phase<2, EpiGateUp, pg8::MoeSched<true, 1>, 127, 127, false, true>(F.lds, S, E); }
        REPBAR(8);
    } SEAM(8);
    if (IN(9)) REP(9) {
        moe_table(F, mcnt, mtstart, mtfull, mtsmall, mthalf);
        EpiDown E{args.in[16], F.ws, mcnt};
        if (!MK_HM_TEST) { MOE_SCHED(S, false, 0, F.ws + WS_ACT, DFF / 2, F.ws + WS_WDN, DFF / 2, 2048, 8, mtfull); pg8::gemm_phase<1, EpiDown, pg8::MoeSched<false, 0>, 117, 125>(F.lds, S, E); }
        __syncthreads();
        if (MK_HM_TEST) { MOE_SCHED(S, false, 2, F.ws + WS_ACT, DFF / 2, F.ws + WS_WDN, DFF / 2, 2048, 8, mthalf); pg8::gemm_phase<1, EpiDown, pg8::MoeSched<false, 2>, 117, 125, false, true>(F.lds, S, E); }
        else if (MK_HM) { MOE_SCHED(S, false, 1, F.ws + WS_ACT, DFF / 2, F.ws + WS_WDN, DFF / 2, 2048, 8, mtsmall); pg8::gemm_phase<1, EpiDown, pg8::MoeSched<false, 1>, 117, 125, false, true>(F.lds, S, E); }
        REPBAR(9);
    } SEAM(9);
#undef MOE_SCHED
    if (IN(10)) REP(10) { combine_phase(F, args); REPBAR(10); }
#undef REP
#undef REFRAME
#undef REPBAR
#undef IN
#undef SEAM
}

#include <cmath>
extern "C" void kernel_launch(void* const* d_in, const int* in_sizes, int n_in, void* d_out, int out_size, void* d_ws, size_t ws_size, hipStream_t stream) {
    static int grid = 0;
    if (grid == 0) {
        if (n_in != 18 || out_size != T * D || ws_size < WS_END) { fprintf(stderr, "kernel_launch: unexpected shapes (n_in %d out %d ws %zu need %zu)\n", n_in, out_size, ws_size, (size_t)WS_END); grid = -1; return; }
        int dev = 0, cus = 0, per_cu = 0;
        if (hipGetDevice(&dev) != hipSuccess || hipDeviceGetAttribute(&cus, hipDeviceAttributeMultiprocessorCount, dev) != hipSuccess) { grid = -1; return; }
        if (hipFuncSetAttribute((const void*)mk_fwd, hipFuncAttributeMaxDynamicSharedMemorySize, LDS_BYTES) != hipSuccess) { fprintf(stderr, "kernel_launch: hipFuncSetAttribute failed\n"); grid = -1; return; }
        if (hipOccupancyMaxActiveBlocksPerMultiprocessor(&per_cu, (const void*)mk_fwd, NTHREADS, LDS_BYTES) != hipSuccess || per_cu < 1) fprintf(stderr, "kernel_launch: occupancy query says %d\n", per_cu);
        (void)hipGetLastError();
        grid = cus;
    }
    if (grid < 0) return;
    (void)hipMemsetAsync((char*)d_ws + WS_CTL, 0, CTL_ZERO_BYTES, stream);
    Args a{};
    for (int i = 0; i < 18; ++i) a.in[i] = (const float*)d_in[i];
    a.out = (float*)d_out; a.ws = (unsigned char*)d_ws;
    for (int h = 0; h < 8; ++h) a.l2g[h] = (float)std::log2(1.0 - std::exp2(-5.0 - (double)h));
#if MK_N_LAUNCHES == 1
    a.ph_lo = 0; a.ph_hi = N_PHASES;
    hipLaunchKernelGGL(mk_fwd, dim3(grid), dim3(NTHREADS), LDS_BYTES, stream, a);
#else
    for (int p = 0; p < 11; ++p) { a.ph_lo = p; a.ph_hi = p + 1; hipLaunchKernelGGL(mk_fwd, dim3(grid), dim3(NTHREADS), LDS_BYTES, stream, a); }
#endif
}
```

```cpp
#include <hip/hip_runtime.h>
#include <cstdio>
#include <cstdint>

#ifndef MK_N_LAUNCHES
#define MK_N_LAUNCHES 1
#endif
#ifndef MK_PHASES
#define MK_PHASES 0xFFFF
#endif
#ifndef MK_NCONV
#define MK_NCONV 64
#endif
#ifndef MK_CONV_IN_P0
#define MK_CONV_IN_P0 0
#endif
#ifndef MK_RSYNC
#define MK_RSYNC 0
#endif
#ifndef MK_NSCAN
#define MK_NSCAN 0
#endif
#ifndef MK_HM
#define MK_HM 1
#endif
#ifndef MK_HM_TEST
#define MK_HM_TEST 0
#endif
#ifndef MK_DUP
#define MK_DUP 0
#endif

#define GAS __attribute__((address_space(1)))
#define LAS __attribute__((address_space(3)))
typedef unsigned short bf16_t;
typedef short bf16x8 __attribute__((ext_vector_type(8)));
typedef short s16x4 __attribute__((ext_vector_type(4)));
typedef float f32x4 __attribute__((ext_vector_type(4)));
typedef float f32x2 __attribute__((ext_vector_type(2)));
typedef float f32x16 __attribute__((ext_vector_type(16)));
typedef unsigned u32x4 __attribute__((ext_vector_type(4)));
typedef unsigned u32x2 __attribute__((ext_vector_type(2)));

constexpr int T = 16384, D = 2048, GW = 1024, QKW = 1024, INW = 12288, NE = 32, DFF = 2048;
constexpr int NCHUNK = 128, NH = 8;
constexpr float EPS = 1e-6f;
constexpr int NWAVES = 8, NTHREADS = 512;
constexpr int ACT_ROWS = 73728;
constexpr float W8_SCALE = 1024.0f, H8_SCALE = 16.0f, A8_SCALE = 4.0f, Y8_SCALE = 32.0f;

constexpr size_t MiB = 1u << 20;
constexpr size_t WS_CTL = 0, CTL_ZERO_BYTES = 1 * MiB;
constexpr size_t WS_WIN = 2 * MiB;
constexpr size_t WS_WPA = WS_WIN + 48 * MiB;
constexpr size_t WS_WPR = WS_WPA + 4 * MiB;
constexpr size_t WS_WOUT = WS_WPR + 8 * MiB;
constexpr size_t WS_WGU = WS_WOUT + 8 * MiB;
constexpr size_t WS_WDN = WS_WGU + 512 * MiB;
constexpr size_t WS_H = WS_WDN + 256 * MiB;
constexpr size_t WS_U = WS_H + 64 * MiB;
constexpr size_t WS_V = WS_U + 32 * MiB;
constexpr size_t WS_Q = WS_V + 32 * MiB;
constexpr size_t WS_K = WS_Q + 32 * MiB;
constexpr size_t WS_RV = WS_K + 32 * MiB;
constexpr size_t WS_RG = WS_RV + 64 * MiB;
constexpr size_t WS_GA = WS_RG + 64 * MiB;
constexpr size_t WS_GR = WS_GA + 64 * MiB;
constexpr size_t WS_VSTAT = WS_GR + 64 * MiB;
constexpr size_t WS_ROPEC = WS_VSTAT + 2 * MiB;
constexpr size_t WS_ROPES = WS_ROPEC + 4 * MiB;
constexpr size_t WS_SG = WS_ROPES + 4 * MiB;
constexpr size_t WS_KV = WS_SG + 32 * MiB;
constexpr size_t WS_ST = WS_KV + 128 * MiB;
constexpr size_t WS_RO = WS_ST + 64 * MiB;
constexpr size_t WS_MRG = WS_RO + 64 * MiB;
constexpr size_t WS_X1 = WS_MRG + 64 * MiB;
constexpr size_t WS_SS = WS_X1 + 128 * MiB;
constexpr size_t WS_TOKE = WS_SS + 2 * MiB;
constexpr size_t WS_TOKR = WS_TOKE + 1 * MiB;
constexpr size_t WS_TOKW = WS_TOKR + 1 * MiB;
constexpr size_t WS_ROWTOK = WS_TOKW + 1 * MiB;
constexpr size_t WS_ACT = WS_ROWTOK + 2 * MiB;
constexpr size_t WS_Y = WS_ACT + 288 * MiB;
constexpr size_t WS_END = WS_Y + 288 * MiB;
constexpr int CW_TMO = 0;
constexpr int CW_BAR = 4096;
constexpr int CW_CNT = 8192;
constexpr int CW_DBG = 12288;

constexpr int RING_BYTES = 131072;
constexpr int AUX_OFF = RING_BYTES;
constexpr int MISC_OFF = AUX_OFF + 12288;
constexpr int LDS_BYTES = 147456;

typedef __bf16 bf16x2_t __attribute__((ext_vector_type(2)));
__device__ __forceinline__ unsigned cvt_pk_bf16(float lo, float hi) { f32x2 v = {lo, hi}; bf16x2_t b = __builtin_convertvector(v, bf16x2_t); return __builtin_bit_cast(unsigned, b); }
__device__ __forceinline__ unsigned pk4_fp8(float a, float b, float c, float d) { int w = 0; w = __builtin_amdgcn_cvt_pk_fp8_f32(a, b, w, false); w = __builtin_amdgcn_cvt_pk_fp8_f32(c, d, w, true); return (unsigned)w; }
__device__ __forceinline__ float bf_lo(unsigned w) { return __uint_as_float(w << 16); }
__device__ __forceinline__ float bf_hi(unsigned w) { return __uint_as_float(w & 0xffff0000u); }
__device__ __forceinline__ float bf2f(bf16_t b) { return __uint_as_float(((unsigned)b) << 16); }
__device__ __forceinline__ float wave_sum(float v) {
#pragma unroll
    for (int o = 1; o < 64; o <<= 1) v += __shfl_xor(v, o);
    return v;
}
__device__ __forceinline__ float sigmoid_f(float x) { return __builtin_amdgcn_rcpf(1.0f + __expf(-x)); }
__device__ __forceinline__ f32x2 gelu_pk(f32x2 v) {
    const f32x2 av = __builtin_elementwise_abs(v), d = av * 0.2316418882f + 1.0f;
    f32x2 t; t.x = __builtin_amdgcn_rcpf(d.x); t.y = __builtin_amdgcn_rcpf(d.y);
    f32x2 q = t * 0.5307027145f + (-0.7265760135f); q = q * t + 0.7107068705f; q = q * t + (-0.142248368f); q = q * t + 0.127414796f; q = q * t;
    const f32x2 s = (v * v) * (-0.72134752044f);
    f32x2 e; e.x = __builtin_amdgcn_exp2f(s.x); e.y = __builtin_amdgcn_exp2f(s.y);
    const f32x2 m = v * (q * e), r = v - m;
    f32x2 o; o.x = v.x < 0.f ? m.x : r.x; o.y = v.y < 0.f ? m.y : r.y; return o;
}
__device__ __forceinline__ f32x4 gelu4(f32x4 v) { f32x2 a = gelu_pk((f32x2){v[0], v[1]}), b = gelu_pk((f32x2){v[2], v[3]}); return (f32x4){a.x, a.y, b.x, b.y}; }

#define XB_TMO      128
#define XB_XCNT(j)  (256  + 64 * (j))
#define XB_XSUB(j)  (1280 + 64 * (j))
#define XB_XGEN(j)  (2304 + 64 * (j))
#define XB_TOP      3328
#define XB_TOPGEN   3392
#define XCD_BAR_WORDS 3456
#define XB_SPIN_CAP (1u << 18)
__device__ __forceinline__ unsigned xb_ld(unsigned* p)              { return __hip_atomic_load(p, __ATOMIC_RELAXED, __HIP_MEMORY_SCOPE_AGENT); }
__device__ __forceinline__ unsigned xb_add(unsigned* p, unsigned v) { return __hip_atomic_fetch_add(p, v, __ATOMIC_RELAXED, __HIP_MEMORY_SCOPE_AGENT); }
__device__ __forceinline__ unsigned xb_xcc_id() { return (unsigned)__builtin_amdgcn_s_getreg((3 << 11) | 20) & 0xFu; }
#define XB_SPIN(cond, bar) do { unsigned _sp = 0; while (cond) { __builtin_amdgcn_s_sleep(1); \
    if ((++_sp & 255u) == 0u) { if (xb_ld(&(bar)[XB_TMO])) break; if (_sp > XB_SPIN_CAP) { atomicAdd(&(bar)[XB_TMO], 1u); break; } } } } while (0)
struct XcdBarrier { unsigned* bar; unsigned x; volatile LAS unsigned* st; };
__device__ __forceinline__ XcdBarrier xcd_barrier_post(unsigned* bar, volatile LAS unsigned* st) {
    XcdBarrier b; b.bar = bar; b.x = xb_xcc_id(); b.st = st;
    if (threadIdx.x == 0) (void)xb_add(&bar[XB_XCNT(b.x)], 1u);
    return b;
}
__device__ __forceinline__ void xcd_barrier_complete(unsigned* bar, unsigned x, unsigned& nloc, unsigned& nx) {
    const unsigned G = gridDim.x * gridDim.y * gridDim.z;
    unsigned sum, cnt, mine, sp = 0u;
    for (;;) {
        sum = 0u; cnt = 0u; mine = 0u;
#pragma unroll
        for (unsigned j = 0; j < 16; ++j) { const unsigned c = xb_ld(&bar[XB_XCNT(j)]); sum += c; cnt += (c > 0u) ? 1u : 0u; mine = (j == x) ? c : mine; }
        if (sum == G) break;
        __builtin_amdgcn_s_sleep(1);
        if ((++sp & 255u) == 0u) { if (xb_ld(&bar[XB_TMO])) break; if (sp > XB_SPIN_CAP) { atomicAdd(&bar[XB_TMO], 1u); break; } }
    }
    nloc = mine > 0u ? mine : 1u; nx = cnt > 0u ? cnt : 1u;
}
__device__ __forceinline__ void xcd_barrier(const XcdBarrier& b) {
    asm volatile("s_waitcnt vmcnt(0)" ::: "memory");
    __syncthreads();
    if (threadIdx.x == 0) {
        unsigned* bar = b.bar;
        __builtin_amdgcn_s_waitcnt(0);
        unsigned nloc = b.st[0], nx = b.st[1];
        if (nloc == 0u) { xcd_barrier_complete(bar, b.x, nloc, nx); b.st[0] = nloc; b.st[1] = nx; }
        const unsigned old = xb_add(&bar[XB_XSUB(b.x)], 1u);
        const unsigned gen = old / nloc;
        if (old + 1u == (gen + 1u) * nloc) {
            __builtin_amdgcn_fence(__ATOMIC_RELEASE, "agent");
            asm volatile("s_waitcnt vmcnt(0)" ::: "memory");
            const unsigned og = xb_add(&bar[XB_TOP], 1u);
            const unsigned tg = og / nx;
            if (og + 1u == (tg + 1u) * nx) xb_add(&bar[XB_TOPGEN], 1u);
            else XB_SPIN(xb_ld(&bar[XB_TOPGEN]) == tg, bar);
            __builtin_amdgcn_fence(__ATOMIC_ACQUIRE, "agent");
            xb_add(&bar[XB_XGEN(b.x)], 1u);
            asm volatile("s_waitcnt vmcnt(0)" ::: "memory");
        } else {
            XB_SPIN(xb_ld(&bar[XB_XGEN(b.x)]) == gen, bar);
            __builtin_amdgcn_fence(__ATOMIC_ACQUIRE, "agent");
            asm volatile("s_waitcnt vmcnt(0)" ::: "memory");
        }
    }
    __syncthreads();
}

namespace pg8 {
constexpr int BM = 256, BK = 64, HALF = 128, HTB = HALF * BK * 2, STAGE_BYTES = 8 * HTB, NXCD = 8, WGM = 4;
__host__ __device__ __forceinline__ int lds_byte(int r, int c) { const int st = (r >> 4) * 2 + (c >> 5), rr = r & 15, cc = c & 31, ob = rr * 64 + cc * 2; return st * 1024 + (ob ^ (((ob >> 9) & 1) << 5)); }
__host__ __device__ __forceinline__ void stage_rc(int b, int& R, int& C) { const int st = b / 1024, sb = b % 1024, swz = sb ^ (((sb >> 9) & 1) << 5); R = (st >> 1) * 16 + swz / 64; C = (st & 1) * 32 + (swz % 64) / 2; }
__host__ __device__ __forceinline__ int perm32(int rho) { const int n = rho >> 4, i = rho & 15; return 8 * (i >> 2) + 4 * n + (i & 3); }

struct Unit { int pm, pn, e, mt, hx; };

struct DenseSched {
    const bf16_t* A; int lda; const bf16_t* Bt; int K; int nM, nN, nwg, G, c;
    static constexpr bool kGather = false;
    __device__ __forceinline__ void init(const bf16_t* A_, int lda_, const bf16_t* Bt_, int K_, int M, int N, int G_, int c_) { A = A_; lda = lda_; Bt = Bt_; K = K_; nM = M / BM; nN = N / BM; nwg = nM * nN; G = G_; c = c_; }
    __device__ __forceinline__ bool next(int i, Unit& u) const {
        const long L = (long)i * G + c; if (L >= nwg) return false;
        int wgid = (int)L; { const int q = nwg / NXCD, r = nwg % NXCD, xcd = wgid % NXCD, off = wgid / NXCD; wgid = (xcd < r ? xcd * (q + 1) : r * (q + 1) + (xcd - r) * q) + off; }
        const int nig = WGM * nN, gid = wgid / nig, fm = gid * WGM, gsz = (nM - fm) < WGM ? (nM - fm) : WGM;
        u.pm = fm + ((wgid % nig) % gsz); u.pn = (wgid % nig) / gsz; u.e = 0; u.mt = u.pm; u.hx = 0; return true;
    }
    __device__ __forceinline__ const char* a_base(const Unit& u) const { return (const char*)A + (size_t)u.pm * BM * lda * 2; }
    __device__ __forceinline__ const char* b_base(const Unit& u) const { return (const char*)Bt + (size_t)u.pn * BM * K * 2; }
    __device__ __forceinline__ void a_offs(const Unit&, const int (&R)[2], const int (&C)[2], unsigned (&off)[2][2]) const {
#pragma unroll
        for (int h = 0; h < 2; ++h)
#pragma unroll
            for (int i = 0; i < 2; ++i) off[h][i] = (unsigned)((h * HALF + R[i]) * lda + C[i]) * 2u;
    }
};
template <bool GATHER, int MODE = 0> struct MoeSched {
    const bf16_t* A; int lda; const bf16_t* Bt; int K; int NB  ; int nN; const LAS int* tstart  ; const LAS int* tall  ; const LAS int* cnt  ; const int* rowtok; LAS unsigned char* aux  ;
    int nwg, G, c; mutable int ecur;
    static constexpr bool kGather = GATHER;
    __device__ __forceinline__ bool next(int i, Unit& u) const {
        const long L = (long)i * G + c; if (L >= nwg) return false;
        int wgid = (int)L; { const int q = nwg / NXCD, r = nwg % NXCD, xcd = wgid % NXCD, off = wgid / NXCD; wgid = (xcd < r ? xcd * (q + 1) : r * (q + 1) + (xcd - r) * q) + off; }
        int e = ecur;
#pragma unroll 1
        while (e < NE - 1 && wgid >= __builtin_amdgcn_readfirstlane(tstart[e + 1]) * nN) ++e;
        ecur = e;
        const int t0 = __builtin_amdgcn_readfirstlane(tstart[e]), t1 = __builtin_amdgcn_readfirstlane(tstart[e + 1]);
        const int local = wgid - t0 * nN, tiles = t1 - t0, idx = local % tiles;
        const int a0 = __builtin_amdgcn_readfirstlane(tall[e]), a1 = __builtin_amdgcn_readfirstlane(tall[e + 1]);
        u.pn = local / tiles; u.e = e;
        if (MODE == 0) { u.mt = idx; u.hx = 0; } else if (MODE == 1) { u.mt = a1 - a0 - 1; u.hx = 0; } else { u.mt = idx >> 1; u.hx = idx & 1; }
        u.pm = a0 + u.mt; return true;
    }
    __device__ __forceinline__ const char* a_base(const Unit& u) const { return GATHER ? (const char*)A : (const char*)A + ((size_t)u.pm * BM + (size_t)u.hx * HALF) * lda * 2; }
    __device__ __forceinline__ const char* b_base(const Unit& u) const { return (const char*)Bt + ((size_t)u.e * NB + (size_t)u.pn * BM) * K * 2; }
    __device__ __forceinline__ void a_tokptrs(const Unit& u, const int (&R)[2], const int* (&gp)[4]) const {
        const int ce = __builtin_amdgcn_readfirstlane(cnt[u.e]);
#pragma unroll
        for (int h = 0; h < 2; ++h)
#pragma unroll
            for (int i = 0; i < 2; ++i) { const int g = u.mt * BM + u.hx * HALF + h * HALF + R[i]; gp[2 * h + i] = rowtok + (size_t)u.e * T + (g < ce ? g : 0); }
    }
    __device__ __forceinline__ void a_offs(const Unit& u, const int (&R)[2], const int (&C)[2], unsigned (&off)[2][2]) const {
        if constexpr (GATHER) {
            const int ce = __builtin_amdgcn_readfirstlane(cnt[u.e]);
#pragma unroll
            for (int h = 0; h < 2; ++h)
#pragma unroll
                for (int i = 0; i < 2; ++i) { const int g = u.mt * BM + u.hx * HALF + h * HALF + R[i]; const int tok = rowtok[u.e * T + (g < ce ? g : 0)] >> 2; off[h][i] = (unsigned)(tok * lda + C[i]) * 2u; }
        } else {
#pragma unroll
            for (int h = 0; h < 2; ++h)
#pragma unroll
                for (int i = 0; i < 2; ++i) off[h][i] = (unsigned)((h * HALF + R[i]) * lda + C[i]) * 2u;
        }
    }
};

__device__ __forceinline__ void glds16(const char* sbase, unsigned voff, unsigned lds_dst) {
    unsigned keep;
    asm volatile("s_mov_b32 %0, m0\n\ts_mov_b32 m0, %3\n\ts_nop 0\n\tglobal_load_lds_dwordx4 %1, %2\n\ts_mov_b32 m0, %0" : "=&s"(keep) : "v"(voff), "s"(sbase), "s"(lds_dst) : "memory");
}
typedef int v8i32 __attribute__((ext_vector_type(8)));
typedef int v4i32 __attribute__((ext_vector_type(4)));
__device__ __forceinline__ v8i32 cat8(bf16x8 a, bf16x8 b) { return __builtin_shufflevector(__builtin_bit_cast(v4i32, a), __builtin_bit_cast(v4i32, b), 0, 1, 2, 3, 4, 5, 6, 7); }
template <int FP8, class Epi, class Sched, int SCW = 127, int SCA = 127, bool RSYNC = false, bool HM = false>
__device__ __forceinline__ void gemm_phase(LAS unsigned char* lds, const Sched& S, const Epi& E, const XcdBarrier* rbar = nullptr) {
    int sclw = SCW * 0x01010101, scla = SCA * 0x01010101; asm volatile("" : "+v"(sclw), "+v"(scla));
    int tid_ = threadIdx.x; asm volatile("" : "+v"(tid_));
    const int tid = tid_, wid = __builtin_amdgcn_readfirstlane(tid >> 6), lane = tid & 63, wr = wid >> 2, wc = wid & 3, fr = lane & 15, fq = lane >> 4;
    const int K = S.K, nt = K / BK;
    unsigned voffB[2];
    { int R[2], C[2];
#pragma unroll
      for (int i = 0; i < 2; ++i) { stage_rc(tid * 16 + i * 8192, R[i], C[i]); voffB[i] = (unsigned)(R[i] * K + C[i]) * 2u; } }
#define PG8_RC() int R[2], C[2]; { int t_ = threadIdx.x; asm volatile("" : "+v"(t_)); _Pragma("unroll") for (int i = 0; i < 2; ++i) stage_rc(t_ * 16 + i * 8192, R[i], C[i]); }
    const size_t kstep = (size_t)(BK * 2);
    const size_t hstepB = (size_t)HALF * K * 2;
    const unsigned ldsbase = (unsigned)__builtin_amdgcn_readfirstlane((int)((unsigned)(size_t)lds + (unsigned)wid * 1024u));
    const int aoff = lds_byte(wr * 64 + fr, fq * 8), boff = lds_byte(wc * 32 + fr, fq * 8);
#define PG8_SA(b, h) (((b) * 2 + (h)) * HTB)
#define PG8_SB(b, h) ((4 + (b) * 2 + (h)) * HTB)
#define PG8_STAGE2(bufoff, gbase, o0, o1) do { glds16((const char*)(gbase), (o0), ldsbase + (unsigned)(bufoff)); glds16((const char*)(gbase), (o1), ldsbase + (unsigned)(bufoff) + 8192u); } while (0)
#define PG8_STAGEB(bufoff, gbase) PG8_STAGE2(bufoff, gbase, voffB[0], voffB[1])
#define PG8_STAGEA(bufoff, gbase, h) PG8_STAGE2(bufoff, gbase, voffA[h][0], voffA[h][1])
#define PG8_STAGEAS(bufoff, gbase, h) PG8_STAGE2(bufoff, gbase, voffA[h][0], voffA[h][1])
#define PG8_LDA(dst, b, h) do { _Pragma("unroll") for (int m = 0; m < 4; ++m) _Pragma("unroll") for (int k = 0; k < 2; ++k) dst[m][k] = *(const LAS bf16x8*)(lds + PG8_SA(b, h) + aoff + m * 2048 + k * 1024); } while (0)
#define PG8_LDB(dst, b, h) do { _Pragma("unroll") for (int n = 0; n < 2; ++n) _Pragma("unroll") for (int k = 0; k < 2; ++k) dst[n][k] = *(const LAS bf16x8*)(lds + PG8_SB(b, h) + boff + n * 2048 + k * 1024); } while (0)
#define PG8_MMA(ai, bj, At, Bt) do { __builtin_amdgcn_s_setprio(1); if constexpr (FP8 == 2) { _Pragma("unroll") for (int m = 0; m < 4; ++m) _Pragma("unroll") for (int n = 0; n < 2; ++n) { \
        const v8i32 wa_ = cat8(Bt[n][0], Bt[n][1]), xa_ = cat8(At[m][0], At[m][1]); \
        asm volatile("s_nop 1\n\tv_mfma_scale_f32_16x16x128_f8f6f4 %0, %1, %2, %0, %3, %4 op_sel_hi:[0,0,0] cbsz:2 blgp:2" : "+v"(acc[ai][bj][m][n]) \
                     : "v"(__builtin_shufflevector(wa_, wa_, 0, 1, 2, 3, 4, 5)), "v"(__builtin_shufflevector(xa_, xa_, 0, 1, 2, 3, 4, 5)), "v"(wa_[6]), "v"(xa_[6])); } } else if constexpr (FP8 == 1) { _Pragma("unroll") for (int m = 0; m < 4; ++m) _Pragma("unroll") for (int n = 0; n < 2; ++n) \
        asm volatile("v_mfma_scale_f32_16x16x128_f8f6f4 %0, %1, %2, %0, %3, %4 op_sel_hi:[0,0,0]" : "+v"(acc[ai][bj][m][n]) : "v"(cat8(Bt[n][0], Bt[n][1])), "v"(cat8(At[m][0], At[m][1])), "v"(sclw), "v"(scla)); } else { \
        _Pragma("unroll") for (int m = 0; m < 4; ++m) _Pragma("unroll") for (int n = 0; n < 2; ++n) _Pragma("unroll") for (int k = 0; k < 2; ++k) \
        acc[ai][bj][m][n] = __builtin_amdgcn_mfma_f32_16x16x32_bf16(Bt[n][k], At[m][k], acc[ai][bj][m][n], 0, 0, 0); } __builtin_amdgcn_s_setprio(0); } while (0)
#define PG8_WAIT_V(n) asm volatile("s_waitcnt vmcnt(" #n ")" ::: "memory")
#define PG8_WAIT_K() do { if constexpr (HM) PG8_WAIT_V(6); else PG8_WAIT_V(8); } while (0)
    constexpr int EST = HM ? Epi::kStoresHM : Epi::kStores;
#define PG8_WAIT_K0() do { if (EST > 0 && t == 0 && ui > 0) asm volatile("s_waitcnt vmcnt(%0)" :: "n"((HM ? 6 : 8) + EST) : "memory"); else PG8_WAIT_K(); } while (0)
#define PG8_WAIT_L(n) asm volatile("s_waitcnt lgkmcnt(" #n ")" ::: "memory")
#define PG8_BAR __builtin_amdgcn_s_barrier()
#define PG8_SCHED __builtin_amdgcn_sched_barrier(0)
    Unit cur, nxt; int ui = 0;
    if (!S.next(0, cur)) return;
    unsigned voffA[2][2];
    { PG8_RC(); S.a_offs(cur, R, C, voffA); }
    f32x4 acc[2][2][4][2];
#pragma unroll
    for (int a = 0; a < 2; ++a)
#pragma unroll
        for (int b = 0; b < 2; ++b)
#pragma unroll
            for (int m = 0; m < 4; ++m)
#pragma unroll
                for (int n = 0; n < 2; ++n) acc[a][b][m][n] = (f32x4){0.f, 0.f, 0.f, 0.f};
    bf16x8 At[4][2], B0[2][2], B1[2][2];
    const char* cA = S.a_base(cur); const char* cB = S.b_base(cur);
    const unsigned bias_lds = (unsigned)__builtin_amdgcn_readfirstlane((int)((unsigned)(size_t)lds + (unsigned)(AUX_OFF + 8192) + (unsigned)wid * 256u));
    if constexpr (Epi::kBiasDMA) { if (lane < 16) glds16(E.bias_base(cur), E.bias_off(cur, wc, lane), bias_lds); }
    const unsigned rowid_lds = (unsigned)__builtin_amdgcn_readfirstlane((int)((unsigned)(size_t)lds + (unsigned)AUX_OFF + (unsigned)wid * 512u));
    if constexpr (Epi::kRowDMA) { if (lane < 32) glds16(E.row_base(cur), E.row_off(cur, wr, lane), rowid_lds); }
    PG8_STAGEB(PG8_SB(0, 0), cB); PG8_STAGEB(PG8_SB(0, 1), cB + hstepB); PG8_STAGEA(PG8_SA(0, 0), cA, 0); if constexpr (!HM) PG8_STAGEA(PG8_SA(0, 1), cA, 1);
    if (wr == 1) PG8_BAR;
    if constexpr (HM) PG8_WAIT_V(0); else PG8_WAIT_V(2);
    PG8_BAR;
    PG8_STAGEB(PG8_SB(1, 0), cB + kstep); PG8_STAGEA(PG8_SA(1, 0), cA + kstep, 0); PG8_STAGEB(PG8_SB(1, 1), cB + hstepB + kstep);
    PG8_WAIT_V(6); PG8_BAR;
    for (;;) {
        const bool has_next = S.next(ui + 1, nxt);
        const char* nA = cA; const char* nB = cB;
        if (has_next) { nA = S.a_base(nxt); nB = S.b_base(nxt); }
        unsigned gtok0 = 0, gtok1 = 0, gtok2 = 0, gtok3 = 0;
        if constexpr (Sched::kGather) {
            if (has_next) { PG8_RC(); const int* gp[4]; S.a_tokptrs(nxt, R, gp);
                asm volatile("global_load_dword %0, %4, off\n\tglobal_load_dword %1, %5, off\n\tglobal_load_dword %2, %6, off\n\tglobal_load_dword %3, %7, off"
                             : "=&v"(gtok0), "=&v"(gtok1), "=&v"(gtok2), "=&v"(gtok3) : "v"(gp[0]), "v"(gp[1]), "v"(gp[2]), "v"(gp[3]) : "memory"); }
        }
        for (int t = 0; t < nt; t += 2) {
            const bool last = (t == nt - 2);
            if constexpr (Sched::kGather) {
                if (t == 2 && has_next) {
                    if constexpr (HM) asm volatile("s_waitcnt vmcnt(12)" : "+v"(gtok0), "+v"(gtok1), "+v"(gtok2), "+v"(gtok3) :: "memory");
                    else asm volatile("s_waitcnt vmcnt(16)" : "+v"(gtok0), "+v"(gtok1), "+v"(gtok2), "+v"(gtok3) :: "memory");
                    PG8_RC(); *(LAS u32x4*)(S.aux + tid * 16) = (u32x4){(unsigned)(((int)gtok0 >> 2) * S.lda + C[0]) * 2u, (unsigned)(((int)gtok1 >> 2) * S.lda + C[1]) * 2u, (unsigned)(((int)gtok2 >> 2) * S.lda + C[0]) * 2u, (unsigned)(((int)gtok3 >> 2) * S.lda + C[1]) * 2u};
                }
            }
            const char* a1 = cA + (size_t)(t + 1) * kstep;
            const char* a2 = last ? nA : cA + (size_t)(t + 2) * kstep; const char* b2 = last ? nB : cB + (size_t)(t + 2) * kstep;
            const char* a3 = a2 + kstep; const char* b3 = b2 + kstep;
            PG8_LDB(B0, 0, 0); PG8_LDB(B1, 0, 1); PG8_SCHED; PG8_LDA(At, 0, 0); if constexpr (!HM) PG8_STAGEA(PG8_SA(1, 1), a1, 1);
            if constexpr (Sched::kGather) { if (last && has_next) { const u32x4 tn = *(const LAS u32x4*)(S.aux + tid * 16); voffA[0][0] = tn.x; voffA[0][1] = tn.y; voffA[1][0] = tn.z; voffA[1][1] = tn.w; } }
            PG8_WAIT_K0(); PG8_WAIT_L(0); PG8_BAR; PG8_MMA(0, 0, At, B0); PG8_MMA(0, 1, At, B1); PG8_BAR; PG8_SCHED;
            if constexpr (!HM) PG8_LDA(At, 0, 1);
            PG8_STAGEB(PG8_SB(0, 0), b2); PG8_STAGEB(PG8_SB(0, 1), b2 + hstepB); PG8_STAGEAS(PG8_SA(0, 0), a2, 0);
            PG8_WAIT_K0(); PG8_WAIT_L(0); PG8_BAR; if constexpr (!HM) { PG8_MMA(1, 0, At, B0); PG8_MMA(1, 1, At, B1); } PG8_BAR; PG8_SCHED;
            PG8_LDB(B0, 1, 0); PG8_LDB(B1, 1, 1); PG8_SCHED; PG8_LDA(At, 1, 0); if constexpr (!HM) PG8_STAGEAS(PG8_SA(0, 1), a2, 1);
            PG8_WAIT_K(); PG8_WAIT_L(0); PG8_BAR; PG8_MMA(0, 0, At, B0); PG8_MMA(0, 1, At, B1); PG8_BAR; PG8_SCHED;
            if constexpr (!HM) PG8_LDA(At, 1, 1);
            PG8_STAGEB(PG8_SB(1, 0), b3); PG8_STAGEB(PG8_SB(1, 1), b3 + hstepB); PG8_STAGEAS(PG8_SA(1, 0), a3, 0);
            PG8_WAIT_K(); PG8_WAIT_L(0); PG8_BAR; if constexpr (!HM) { PG8_MMA(1, 0, At, B0); PG8_MMA(1, 1, At, B1); } PG8_BAR; PG8_SCHED;
        }
        if (wr == 0) PG8_BAR;
        if constexpr (FP8 >= 1) asm volatile("s_nop 15\n\ts_nop 15" ::: "memory");
        if constexpr (Epi::kRowDMA) E(acc, cur, wr, wc, fr, fq, (const LAS float*)(lds + AUX_OFF + 8192 + wid * 256), (const LAS int*)(lds + AUX_OFF + wid * 512), HM ? 1 : 2);
        else if constexpr (Epi::kBiasDMA) E(acc, cur, wr, wc, fr, fq, (const LAS float*)(lds + AUX_OFF + 8192 + wid * 256), HM ? 1 : 2); else E(acc, cur, wr, wc, fr, fq);
        if (!has_next) break;
        if constexpr (RSYNC) xcd_barrier(*rbar);
#pragma unroll
        for (int a = 0; a < 2; ++a)
#pragma unroll
            for (int b = 0; b < 2; ++b)
#pragma unroll
                for (int m = 0; m < 4; ++m)
#pragma unroll
                    for (int n = 0; n < 2; ++n) acc[a][b][m][n] = (f32x4){0.f, 0.f, 0.f, 0.f};
        cur = nxt; cA = nA; cB = nB; ++ui;
        if constexpr (Epi::kBiasDMA) { if (lane < 16) glds16(E.bias_base(cur), E.bias_off(cur, wc, lane), bias_lds); }
        if constexpr (Epi::kRowDMA) { if (lane < 32) glds16(E.row_base(cur), E.row_off(cur, wr, lane), rowid_lds); }
        if (wr == 1) PG8_BAR;
    }
    PG8_WAIT_V(0);
    PG8_BAR;
#undef PG8_SA
#undef PG8_RC
#undef PG8_SB
#undef PG8_STAGE2
#undef PG8_STAGEB
#undef PG8_STAGEA
#undef PG8_STAGEAS
#undef PG8_LDA
#undef PG8_LDB
#undef PG8_MMA
#undef PG8_WAIT_V
#undef PG8_WAIT_K
#undef PG8_WAIT_K0
#undef PG8_WAIT_L
#undef PG8_BAR
#undef PG8_SCHED
}
}

struct Args {
    const float* in[18]; float* out; unsigned char* ws;
    float l2g[8];
    int ph_lo, ph_hi;
};
struct Frame {
    LAS unsigned char* lds;
    int tid, lane, wave, G, vcu;
    unsigned char* ws;
};

enum { CM_NAT = 0, CM_STD = 1, CM_ROPE = 2, CM_SWIGLU = 3, CM_WIN = 4, CM_DN = 5 };
__device__ __forceinline__ int src_col(int mode, int n) {
    if (mode == CM_WIN) mode = (n >= 2048 && n < 4096) ? CM_ROPE : CM_STD;
    if (mode == CM_NAT) return n;
    if (mode == CM_DN) return n;
    if (mode == CM_STD) return (n & ~31) + pg8::perm32(n & 31);
    if (mode == CM_ROPE) { const int p = n & 127, wc = p >> 5, nn = (p >> 4) & 1, i = p & 15; return (n & ~127) + 16 * wc + i + 64 * nn; }
    { const int pn = n >> 8, p = n & 255, bj = p >> 7, g = (p >> 5) & 3, rho = p & 31; return bj * 2048 + 128 * pn + 32 * g + pg8::perm32(rho); }
}
__device__ __forceinline__ int dst_row(int mode, int c) {
    if (mode != CM_DN) return c;
    const int q = c & 255, wc = q >> 6, fq = (q >> 4) & 3, bj = (q >> 3) & 1, nn = (q >> 2) & 1, j = q & 3;
    return (c & ~255) + 128 * bj + 32 * wc + 16 * nn + 4 * fq + j;
}
__device__ __forceinline__ void transpose_item(const float* W, int K, int N, bf16_t* WT, int mode, int item, LAS unsigned* scr, int lane) {
    const int nblk = N / 32, kb = item / nblk, nb = item % nblk, k0 = 64 * kb, n0 = 32 * nb;
    const int g = lane & 7, r = lane >> 3;
    const int sc = src_col(mode, n0 + 4 * g);
    const float* p = W + (size_t)(k0 + 2 * r) * N + sc;
    f32x4 a[4], b[4];
#pragma unroll
    for (int i = 0; i < 4; ++i) { a[i] = *(const f32x4*)(p + (size_t)(16 * i) * N); b[i] = *(const f32x4*)(p + (size_t)(16 * i + 1) * N); }
#pragma unroll
    for (int i = 0; i < 4; ++i)
#pragma unroll
        for (int j = 0; j < 4; ++j) scr[(4 * g + j) * 33 + r + 8 * i] = cvt_pk_bf16(a[i][j], b[i][j]);
    asm volatile("s_waitcnt lgkmcnt(0)" ::: "memory");
    const int c = lane & 7;
#pragma unroll
    for (int ii = 0; ii < 4; ++ii) { const int n = 8 * ii + (lane >> 3); const LAS unsigned* s = scr + n * 33 + 4 * c;
        u32x4 o; o.x = s[0]; o.y = s[1]; o.z = s[2]; o.w = s[3];
        *(u32x4*)(WT + (size_t)(n0 + n) * K + k0 + 8 * c) = o; }
    asm volatile("s_waitcnt lgkmcnt(0)" ::: "memory");
}

typedef float f32x16v __attribute__((ext_vector_type(16)));
typedef unsigned u32x6 __attribute__((ext_vector_type(6)));
#ifndef MK_F6_SCALE_INV
#define MK_F6_SCALE_INV 0
#endif
__device__ __forceinline__ void q6_block(const float (&v)[32], u32x4& lo, u32x4& hi) {
    float amax = 0.f;
#pragma unroll
    for (int t = 0; t < 32; ++t) amax = fmaxf(amax, fabsf(v[t]));
    const unsigned eb = ((__float_as_uint(amax * 0.13333334f) >> 23) & 255u) + 1u;
    const float sc = __uint_as_float(eb << 23);
    f32x16v a, b;
#pragma unroll
    for (int t = 0; t < 16; ++t) { a[t] = v[t]; b[t] = v[16 + t]; }
    const u32x6 q = __builtin_amdgcn_cvt_scalef32_2xpk16_fp6_f32(a, b, MK_F6_SCALE_INV ? __uint_as_float((254u - eb) << 23) : sc);
    lo = (u32x4){q[0], q[1], q[2], q[3]};
    hi = (u32x4){q[4], q[5], eb * 0x01010101u, 0u};
}
__device__ __forceinline__ void t8_load(const float* W, int N, int mode, int item, int lane, f32x4 (&a)[4][4]) {
    const int nblk = N / 32, kb = item / nblk, nb = item % nblk, k0 = 128 * kb, n0 = 32 * nb;
    const int g = lane & 7, r = lane >> 3;
    const float* p = W + (size_t)(k0 + 4 * r) * N + src_col(mode, n0 + 4 * g);
#pragma unroll
    for (int i = 0; i < 4; ++i)
#pragma unroll
        for (int q = 0; q < 4; ++q) a[i][q] = __builtin_nontemporal_load((const f32x4*)(p + (size_t)(32 * i + q) * N));
}
__device__ __forceinline__ void t8_store(const f32x4 (&a)[4][4], int K, int N, unsigned char* WT, int mode, int item, float scale, LAS unsigned* scr, int lane) {
    const int nblk = N / 32, kb = item / nblk, nb = item % nblk, k0 = 128 * kb, n0 = 32 * nb;
    const int g = lane & 7, r = lane >> 3;
#pragma unroll
    for (int i = 0; i < 4; ++i)
#pragma unroll
        for (int j = 0; j < 4; ++j) scr[(4 * g + j) * 33 + r + 8 * i] = pk4_fp8(a[i][0][j] * scale, a[i][1][j] * scale, a[i][2][j] * scale, a[i][3][j] * scale);
    asm volatile("s_waitcnt lgkmcnt(0)" ::: "memory");
    const int c = lane & 7;
#pragma unroll
    for (int ii = 0; ii < 4; ++ii) { const int n = 8 * ii + (lane >> 3); const LAS unsigned* s = scr + n * 33 + 4 * c;
        u32x4 o; o.x = s[0]; o.y = s[1]; o.z = s[2]; o.w = s[3];
        *(u32x4*)(WT + (size_t)dst_row(mode, n0 + n) * K + k0 + 16 * c) = o; }
    asm volatile("s_waitcnt lgkmcnt(0)" ::: "memory");
}
__device__ __forceinline__ void t6_store(const f32x4 (&a)[4][4], int K, int N, unsigned char* WT, int item, LAS float* scr, int lane) {
    const int nblk = N / 32, kbi = item / nblk, nb = item % nblk, k0 = 128 * kbi, n0 = 32 * nb;
    const int g = lane & 7, r = lane >> 3, n = lane & 31, kb = lane >> 5;
    LAS unsigned char* outl = (LAS unsigned char*)(scr + 64 * 36);
#pragma unroll
    for (int h = 0; h < 2; ++h) {
#pragma unroll
        for (int i = 0; i < 2; ++i)
#pragma unroll
            for (int q = 0; q < 4; ++q) *(LAS f32x4*)(scr + (4 * r + 32 * i + q) * 36 + 4 * g) = a[2 * h + i][q];
        asm volatile("s_waitcnt lgkmcnt(0)" ::: "memory");
        float v[32];
#pragma unroll
        for (int t = 0; t < 32; ++t) v[t] = scr[(32 * kb + t) * 36 + n];
        u32x4 lo, hi; q6_block(v, lo, hi);
        *(LAS u32x4*)(outl + n * 144 + 16 * (2 * h + kb)) = lo; *(LAS u32x4*)(outl + n * 144 + 64 + 16 * (2 * h + kb)) = hi;
        asm volatile("s_waitcnt lgkmcnt(0)" ::: "memory");
    }
    const int c = lane & 7;
#pragma unroll
    for (int ii = 0; ii < 4; ++ii) { const int rr = 8 * ii + (lane >> 3);
        const u32x4 o = *(const LAS u32x4*)(outl + rr * 144 + 16 * c);
        *(u32x4*)(WT + (size_t)(n0 + rr) * K + k0 + 16 * c) = o; }
    asm volatile("s_waitcnt lgkmcnt(0)" ::: "memory");
}
template <bool FP6> __device__ __forceinline__ void t8_stream(const float* W, int K, int N, unsigned char* WT, int mode, int items_per_e, int gw, int NGW, LAS unsigned* scr, int lane) {
    const int NIT = NE * items_per_e; const size_t estride = (size_t)K * N;
    f32x4 A[4][4], B[4][4];
#define T8_LD(buf, idx) do { const int i_ = (idx) < NIT ? (idx) : NIT - 1; t8_load(W + (size_t)(i_ / items_per_e) * estride, N, mode, i_ % items_per_e, lane, buf); } while (0)
#define T8_ST(buf, idx) do { if constexpr (FP6) t6_store(buf, K, N, WT + (size_t)((idx) / items_per_e) * estride, (idx) % items_per_e, (LAS float*)scr, lane); else t8_store(buf, K, N, WT + (size_t)((idx) / items_per_e) * estride, mode, (idx) % items_per_e, W8_SCALE, scr, lane); } while (0)
    T8_LD(A, gw);
    for (int it = gw; it < NIT; it += 2 * NGW) {
        T8_LD(B, it + NGW);
        T8_ST(A, it);
        T8_LD(A, it + 2 * NGW);
        if (it + NGW < NIT) T8_ST(B, it + NGW);
    }
#undef T8_LD
#undef T8_ST
}

__device__ __forceinline__ void conv_rest(Frame& F, const Args& a, int gw, int NGW) {
    LAS unsigned* scr = (LAS unsigned*)(F.lds + F.wave * 13824);
    bf16_t* Wpa = (bf16_t*)(F.ws + WS_WPA); bf16_t* Wpr = (bf16_t*)(F.ws + WS_WPR); bf16_t* Wout = (bf16_t*)(F.ws + WS_WOUT);
    unsigned char* Wgu = (unsigned char*)(F.ws + WS_WGU); unsigned char* Wdn = (unsigned char*)(F.ws + WS_WDN);
    constexpr int I_PA = (GW / 64) * (D / 32), I_PR = (D / 64) * (D / 32), I_OUT = I_PR, I_GU1 = (D / 128) * (4096 / 32), I_DN1 = (DFF / 128) * (D / 32);
    constexpr int NITEMS = I_PA + I_PR + I_OUT;
    for (int it = gw; it < NITEMS; it += NGW) {
        int r = it;
        if (r < I_PA) { transpose_item(a.in[7], GW, D, Wpa, CM_STD, r, scr, F.lane); continue; } r -= I_PA;
        if (r < I_PR) { transpose_item(a.in[8], D, D, Wpr, CM_STD, r, scr, F.lane); continue; } r -= I_PR;
        transpose_item(a.in[9], D, D, Wout, CM_NAT, r, scr, F.lane);
    }
    t8_stream<true>(a.in[13], D, 4096, Wgu, CM_SWIGLU, I_GU1, gw, NGW, scr, F.lane);
    t8_stream<false>(a.in[15], DFF, D, Wdn, CM_DN, I_DN1, gw, NGW, scr, F.lane);
}
__device__ __forceinline__ void t16_load(const float* W, int N, int mode, int item, int lane, f32x4 (&a)[4], f32x4 (&b)[4]) {
    const int nblk = N / 32, kb = item / nblk, nb = item % nblk, k0 = 64 * kb, n0 = 32 * nb;
    const int g = lane & 7, r = lane >> 3;
    const float* p = W + (size_t)(k0 + 2 * r) * N + src_col(mode, n0 + 4 * g);
#pragma unroll
    for (int i = 0; i < 4; ++i) { a[i] = __builtin_nontemporal_load((const f32x4*)(p + (size_t)(16 * i) * N)); b[i] = __builtin_nontemporal_load((const f32x4*)(p + (size_t)(16 * i + 1) * N)); }
}
__device__ __forceinline__ void t16_store(const f32x4 (&a)[4], const f32x4 (&b)[4], int K, int N, bf16_t* WT, int item, LAS unsigned* scr, int lane) {
    const int nblk = N / 32, kb = item / nblk, nb = item % nblk, k0 = 64 * kb, n0 = 32 * nb;
    const int g = lane & 7, r = lane >> 3;
#pragma unroll
    for (int i = 0; i < 4; ++i)
#pragma unroll
        for (int j = 0; j < 4; ++j) scr[(4 * g + j) * 33 + r + 8 * i] = cvt_pk_bf16(a[i][j], b[i][j]);
    asm volatile("s_waitcnt lgkmcnt(0)" ::: "memory");
    const int c = lane & 7;
#pragma unroll
    for (int ii = 0; ii < 4; ++ii) { const int n = 8 * ii + (lane >> 3); const LAS unsigned* s = scr + n * 33 + 4 * c;
        u32x4 o; o.x = s[0]; o.y = s[1]; o.z = s[2]; o.w = s[3];
        *(u32x4*)(WT + (size_t)(n0 + n) * K + k0 + 8 * c) = o; }
    asm volatile("s_waitcnt lgkmcnt(0)" ::: "memory");
}
__device__ __forceinline__ void p0_prologue(Frame& F, const Args& a) {
    LAS unsigned* scr = (LAS unsigned*)(F.lds + F.wave * 4352);
    const int gw = F.vcu * NWAVES + F.wave, NGW = F.G * NWAVES;
    bf16_t* Win = (bf16_t*)(F.ws + WS_WIN);
    constexpr int I_IN = (D / 64) * (INW / 32);
    {
        f32x4 A0[4], A1[4], B0[4], B1[4];
        t16_load(a.in[2], INW, CM_WIN, gw < I_IN ? gw : I_IN - 1, F.lane, A0, A1);
        for (int it = gw; it < I_IN; it += 2 * NGW) {
            { const int n1 = it + NGW; t16_load(a.in[2], INW, CM_WIN, n1 < I_IN ? n1 : I_IN - 1, F.lane, B0, B1); }
            t16_store(A0, A1, D, INW, Win, it, scr, F.lane);
            { const int n2 = it + 2 * NGW; t16_load(a.in[2], INW, CM_WIN, n2 < I_IN ? n2 : I_IN - 1, F.lane, A0, A1); }
            if (it + NGW < I_IN) t16_store(B0, B1, D, INW, Win, it + NGW, scr, F.lane);
        }
    }
    const float* x = a.in[0]; const float* g1 = a.in[1]; bf16_t* H = (bf16_t*)(F.ws + WS_H);
    float* rc = (float*)(F.ws + WS_ROPEC); float* rs = (float*)(F.ws + WS_ROPES);
    LAS double* invf = (LAS double*)(F.lds + 40960);
    __syncthreads();
    if (F.tid < 64) invf[F.tid] = exp2(-(double)(2 * F.tid) / 128.0 * 13.287712379549449);
    __syncthreads();
    int ridx = blockIdx.x * NTHREADS + F.tid;
#define ROPE_ENTRY() do { if (ridx < T * 64) { const int pos = ridx >> 6, i_ = ridx & 63; double ang = (double)pos * invf[i_]; const double k_ = rint(ang * 0.15915494309189535); ang = ang - k_ * 6.283185307179586; \
        const float af = (float)ang; rc[ridx] = cosf(af); rs[ridx] = sinf(af); } ridx += F.G * NTHREADS; } while (0)
    {
        f32x4 g1v[8];
#pragma unroll
        for (int j = 0; j < 8; ++j) g1v[j] = ((const f32x4*)g1)[F.lane + 64 * j];
        f32x4 vc[8];
        { const f32x4* xr = (const f32x4*)(x + (size_t)(gw < T ? gw : T - 1) * D) + F.lane;
#pragma unroll
          for (int j = 0; j < 8; ++j) vc[j] = __builtin_nontemporal_load(xr + 64 * j); }
        for (int m = gw; m < T; m += NGW) {
            f32x4 vn[8];
            { const int mn = (m + NGW) < T ? (m + NGW) : T - 1; const f32x4* xr = (const f32x4*)(x + (size_t)mn * D) + F.lane;
#pragma unroll
              for (int j = 0; j < 8; ++j) vn[j] = __builtin_nontemporal_load(xr + 64 * j); }
            float s = 0.f;
#pragma unroll
            for (int j = 0; j < 8; ++j) s += (vc[j].x * vc[j].x + vc[j].y * vc[j].y) + (vc[j].z * vc[j].z + vc[j].w * vc[j].w);
            const float rstd = 1.0f / sqrtf(wave_sum(s) * (1.f / D) + EPS);
            u32x2* o8 = (u32x2*)(H + (size_t)m * D) + F.lane;
#pragma unroll
            for (int j = 0; j < 8; ++j) { const f32x4 g = g1v[j]; u32x2 w; w.x = cvt_pk_bf16(vc[j].x * rstd * g.x, vc[j].y * rstd * g.y); w.y = cvt_pk_bf16(vc[j].z * rstd * g.z, vc[j].w * rstd * g.w); o8[64 * j] = w; }
#pragma unroll
            for (int j = 0; j < 8; ++j) vc[j] = vn[j];
            ROPE_ENTRY();
        }
    }
    while (ridx < T * 64) ROPE_ENTRY();
#undef ROPE_ENTRY
}

typedef f32x4 AccT[2][2][4][2];
struct EpiInProj {
    static constexpr bool kBiasDMA = false; static constexpr bool kRowDMA = false; static constexpr int kStores = 0, kStoresHM = 0;
    unsigned char* ws;
    __device__ __forceinline__ void operator()(const AccT& acc, const pg8::Unit& u, int wr, int wc, int fr, int fq) const {
        const int row0 = u.pm * 256 + wr * 64 + fr; const int pn = u.pn;
        if (pn < 8) {
            bf16_t* dst = (bf16_t*)(ws + (pn < 4 ? WS_U : WS_V)); const int col0 = (pn & 3) * 256 + wc * 32 + 8 * fq;
            float* vstat = (float*)(ws + WS_VSTAT);
#pragma unroll
            for (int ai = 0; ai < 2; ++ai)
#pragma unroll
                for (int m = 0; m < 4; ++m) { const int row = row0 + ai * 128 + m * 16; float s = 0.f, q = 0.f;
#pragma unroll
                    for (int bj = 0; bj < 2; ++bj) { const f32x4 v0 = gelu4(acc[ai][bj][m][0]), v1 = gelu4(acc[ai][bj][m][1]);
                        s += (v0[0] + v0[1]) + (v0[2] + v0[3]) + (v1[0] + v1[1]) + (v1[2] + v1[3]);
                        q += (v0[0] * v0[0] + v0[1] * v0[1]) + (v0[2] * v0[2] + v0[3] * v0[3]) + (v1[0] * v1[0] + v1[1] * v1[1]) + (v1[2] * v1[2] + v1[3] * v1[3]);
                        u32x4 w; w.x = cvt_pk_bf16(v0[0], v0[1]); w.y = cvt_pk_bf16(v0[2], v0[3]); w.z = cvt_pk_bf16(v1[0], v1[1]); w.w = cvt_pk_bf16(v1[2], v1[3]);
                        *(u32x4*)(dst + (size_t)row * GW + col0 + bj * 128) = w; }
                    if (pn >= 4) { s += __shfl_xor(s, 16); s += __shfl_xor(s, 32); q += __shfl_xor(q, 16); q += __shfl_xor(q, 32);
                        if (fq == 0) *(f32x2*)(vstat + (size_t)row * 32 + ((pn - 4) * 4 + wc) * 2) = (f32x2){s, q}; } }
        } else if (pn < 16) {
            bf16_t* dst = (bf16_t*)(ws + (pn < 12 ? WS_Q : WS_K)); const float sc = pn < 12 ? 1.0f : 0.08838834764831845f;
            const float* rc = (const float*)(ws + WS_ROPEC); const float* rs = (const float*)(ws + WS_ROPES);
            const int dd = 16 * wc + 4 * fq;
#pragma unroll
            for (int ai = 0; ai < 2; ++ai) {
                f32x4 cc[4], ss[4];
#pragma unroll
                for (int m = 0; m < 4; ++m) { const int row = row0 + ai * 128 + m * 16; cc[m] = *(const f32x4*)(rc + (size_t)row * 64 + dd); ss[m] = *(const f32x4*)(rs + (size_t)row * 64 + dd); }
#pragma unroll
                for (int m = 0; m < 4; ++m) { const int row = row0 + ai * 128 + m * 16;
                    const f32x4 c = cc[m] * sc, s = ss[m] * sc;
#pragma unroll
                    for (int bj = 0; bj < 2; ++bj) { const f32x4 t1 = acc[ai][bj][m][0], t2 = acc[ai][bj][m][1];
                        const f32x4 o1 = t1 * c - t2 * s, o2 = t2 * c + t1 * s;
                        bf16_t* p = dst + (size_t)row * QKW + (pn & 3) * 256 + bj * 128 + dd;
                        u32x2 w1, w2; w1.x = cvt_pk_bf16(o1[0], o1[1]); w1.y = cvt_pk_bf16(o1[2], o1[3]); w2.x = cvt_pk_bf16(o2[0], o2[1]); w2.y = cvt_pk_bf16(o2[2], o2[3]);
                        *(u32x2*)p = w1; *(u32x2*)(p + 64) = w2; } } }
        } else {
            const int kind = (pn - 16) >> 3;
            bf16_t* dst = (bf16_t*)(ws + (kind == 0 ? WS_RV : kind == 1 ? WS_RG : kind == 2 ? WS_GA : WS_GR)); const int col0 = ((pn - 16) & 7) * 256 + wc * 32 + 8 * fq;
#pragma unroll
            for (int ai = 0; ai < 2; ++ai)
#pragma unroll
                for (int m = 0; m < 4; ++m) { const int row = row0 + ai * 128 + m * 16;
#pragma unroll
                    for (int bj = 0; bj < 2; ++bj) { f32x4 v0 = acc[ai][bj][m][0], v1 = acc[ai][bj][m][1];
                        if (kind == 1) {
#pragma unroll
                            for (int j = 0; j < 4; ++j) { v0[j] = v0[j] * sigmoid_f(v0[j]); v1[j] = v1[j] * sigmoid_f(v1[j]); } }
                        else if (kind >= 2) {
#pragma unroll
                            for (int j = 0; j < 4; ++j) { v0[j] = sigmoid_f(v0[j]); v1[j] = sigmoid_f(v1[j]); } }
                        u32x4 w; w.x = cvt_pk_bf16(v0[0], v0[1]); w.y = cvt_pk_bf16(v0[2], v0[3]); w.z = cvt_pk_bf16(v1[0], v1[1]); w.w = cvt_pk_bf16(v1[2], v1[3]);
                        *(u32x4*)(dst + (size_t)row * D + col0 + bj * 128) = w; } }
        }
    }
};
template <int MODE> struct EpiMerge {
    static constexpr bool kBiasDMA = false; static constexpr bool kRowDMA = false; static constexpr int kStores = 16, kStoresHM = 0;
    unsigned char* ws;
    __device__ __forceinline__ void operator()(const AccT& acc, const pg8::Unit& u, int wr, int wc, int fr, int fq) const {
        const int row0 = u.pm * 256 + wr * 64 + fr, col0 = u.pn * 256 + wc * 32 + 8 * fq;
        const bf16_t* gate = (const bf16_t*)(ws + (MODE == 0 ? WS_GA : WS_GR)); bf16_t* mrg = (bf16_t*)(ws + WS_MRG);
#pragma unroll
        for (int ai = 0; ai < 2; ++ai) {
            u32x4 gg[4][2], pp[4][2];
#pragma unroll
            for (int m = 0; m < 4; ++m)
#pragma unroll
                for (int bj = 0; bj < 2; ++bj) { const size_t ro = (size_t)(row0 + ai * 128 + m * 16) * D + col0 + bj * 128; gg[m][bj] = __builtin_nontemporal_load((const u32x4*)(gate + ro)); if (MODE == 1) pp[m][bj] = __builtin_nontemporal_load((const u32x4*)(mrg + ro)); }
#pragma unroll
            for (int m = 0; m < 4; ++m)
#pragma unroll
                for (int bj = 0; bj < 2; ++bj) { const size_t ro = (size_t)(row0 + ai * 128 + m * 16) * D + col0 + bj * 128; const u32x4 g = gg[m][bj]; const f32x4 v0 = acc[ai][bj][m][0], v1 = acc[ai][bj][m][1];
                    float o[8] = {v0[0] * bf_lo(g.x), v0[1] * bf_hi(g.x), v0[2] * bf_lo(g.y), v0[3] * bf_hi(g.y), v1[0] * bf_lo(g.z), v1[1] * bf_hi(g.z), v1[2] * bf_lo(g.w), v1[3] * bf_hi(g.w)};
                    if (MODE == 1) { const u32x4 p = pp[m][bj];
                        o[0] += bf_lo(p.x); o[1] += bf_hi(p.x); o[2] += bf_lo(p.y); o[3] += bf_hi(p.y); o[4] += bf_lo(p.z); o[5] += bf_hi(p.z); o[6] += bf_lo(p.w); o[7] += bf_hi(p.w); }
                    u32x4 w; w.x = cvt_pk_bf16(o[0], o[1]); w.y = cvt_pk_bf16(o[2], o[3]); w.z = cvt_pk_bf16(o[4], o[5]); w.w = cvt_pk_bf16(o[6], o[7]);
                    *(u32x4*)(mrg + ro) = w; } }
    }
};
struct EpiOut {
    static constexpr bool kBiasDMA = false; static constexpr bool kRowDMA = false; static constexpr int kStores = 32, kStoresHM = 0;
    const float* x; unsigned char* ws;
    __device__ __forceinline__ void operator()(const AccT& acc, const pg8::Unit& u, int wr, int wc, int fr, int fq) const {
        const int row0 = u.pm * 256 + wr * 64 + fr, col0 = u.pn * 256 + wc * 32 + 4 * fq;
        float* x1 = (float*)(ws + WS_X1); float* ss = (float*)(ws + WS_SS);
#pragma unroll
        for (int ai = 0; ai < 2; ++ai) {
            f32x4 xx[4][2][2];
#pragma unroll
            for (int m = 0; m < 4; ++m)
#pragma unroll
                for (int bj = 0; bj < 2; ++bj)
#pragma unroll
                    for (int n = 0; n < 2; ++n) xx[m][bj][n] = __builtin_nontemporal_load((const f32x4*)(x + (size_t)(row0 + ai * 128 + m * 16) * D + col0 + bj * 128 + n * 16));
#pragma unroll
            for (int m = 0; m < 4; ++m) { const int row = row0 + ai * 128 + m * 16; const size_t ro = (size_t)row * D + col0; float q = 0.f;
#pragma unroll
                for (int bj = 0; bj < 2; ++bj)
#pragma unroll
                    for (int n = 0; n < 2; ++n) { const f32x4 o = xx[m][bj][n] + acc[ai][bj][m][n];
                        q += (o[0] * o[0] + o[1] * o[1]) + (o[2] * o[2] + o[3] * o[3]);
                        *(f32x4*)(x1 + ro + bj * 128 + n * 16) = o; }
                q += __shfl_xor(q, 16); q += __shfl_xor(q, 32);
                if (fq == 0) ss[(size_t)row * 32 + u.pn * 4 + wc] = q; } }
    }
};
struct EpiGateUp {
    static constexpr bool kBiasDMA = true; static constexpr bool kRowDMA = false; static constexpr int kStores = 8, kStoresHM = 4;
    const float* bgu; unsigned char* ws;
    __device__ __forceinline__ const char* bias_base(const pg8::Unit& u) const { return (const char*)(bgu + (size_t)u.e * 4096 + u.pn * 128); }
    __device__ __forceinline__ unsigned bias_off(const pg8::Unit&, int wc, int lane) const { return (unsigned)(((lane >> 3) & 1) * 2048 + wc * 32 + (lane & 7) * 4) * 4u; }
    __device__ __forceinline__ void operator()(const AccT& acc, const pg8::Unit& u, int wr, int wc, int fr, int fq, const LAS float* bl, int nai) const {
        const int row0 = u.pm * 256 + u.hx * 128 + wr * 64 + fr, a0 = u.pn * 128 + wc * 32 + 8 * fq;
        unsigned char* act = (unsigned char*)(ws + WS_ACT);
        const f32x4 bg0 = *(const LAS f32x4*)(bl + 8 * fq), bg1 = *(const LAS f32x4*)(bl + 8 * fq + 4), bu0 = *(const LAS f32x4*)(bl + 32 + 8 * fq), bu1 = *(const LAS f32x4*)(bl + 32 + 8 * fq + 4);
#pragma unroll
        for (int ai = 0; ai < 2; ++ai) if (ai < nai)
#pragma unroll
            for (int m = 0; m < 4; ++m) { const size_t ro = (size_t)(row0 + ai * 128 + m * 16) * DFF + a0; float o[8];
#pragma unroll
                for (int n = 0; n < 2; ++n) {
                    f32x4 g4 = acc[ai][0][m][n] + (n ? bg1 : bg0), u4 = acc[ai][1][m][n] + (n ? bu1 : bu0);
#pragma unroll
                    for (int j = 0; j < 4; ++j) { g4[j] = fminf(g4[j], 7.0f); u4[j] = __builtin_amdgcn_fmed3f(u4[j], -7.0f, 7.0f); }
                    const f32x4 t4 = g4 * (-1.702f * 1.4426950408889634f);
                    f32x4 e4;
#pragma unroll
                    for (int j = 0; j < 4; ++j) e4[j] = __builtin_amdgcn_exp2f(t4[j]);
                    e4 = e4 + 1.0f;
                    f32x4 r4;
#pragma unroll
                    for (int j = 0; j < 4; ++j) r4[j] = __builtin_amdgcn_rcpf(e4[j]);
                    const f32x4 o4 = (u4 * A8_SCALE + A8_SCALE) * (g4 * r4);
#pragma unroll
                    for (int j = 0; j < 4; ++j) o[4 * n + j] = o4[j]; }
                u32x2 w; w.x = pk4_fp8(o[0], o[1], o[2], o[3]); w.y = pk4_fp8(o[4], o[5], o[6], o[7]);
                *(u32x2*)(act + ro) = w; }
    }
};
struct EpiDown {
    static constexpr bool kBiasDMA = true; static constexpr bool kRowDMA = true; static constexpr int kStores = 0, kStoresHM = 0;
    const float* bdn; unsigned char* ws; const LAS int* cnt;
    __device__ __forceinline__ const char* bias_base(const pg8::Unit& u) const { return (const char*)(bdn + (size_t)u.e * D + u.pn * 256); }
    __device__ __forceinline__ unsigned bias_off(const pg8::Unit&, int wc, int lane) const { return (unsigned)(wc * 64 + lane * 4) * 4u; }
    __device__ __forceinline__ const char* row_base(const pg8::Unit& u) const { return (const char*)((const int*)(ws + WS_ROWTOK) + (size_t)u.e * T + u.mt * 256 + u.hx * 128); }
    __device__ __forceinline__ unsigned row_off(const pg8::Unit&, int wr, int lane) const { return (unsigned)(((lane >> 4) & 1) * 128 + wr * 64 + (lane & 15) * 4) * 4u; }
    __device__ __forceinline__ void operator()(const AccT& acc, const pg8::Unit& u, int wr, int wc, int fr, int fq, const LAS float* bl, const LAS int* rid, int nai) const {
        const int col0 = u.pn * 256 + wc * 64 + 16 * fq;
        unsigned char* y = (unsigned char*)(ws + WS_Y);
        const int nvalid = __builtin_amdgcn_readfirstlane(cnt[u.e]) - u.mt * 256;
        f32x4 bv[2][2];
#pragma unroll
        for (int bj = 0; bj < 2; ++bj) { bv[bj][0] = *(const LAS f32x4*)(bl + 16 * fq + 8 * bj) * Y8_SCALE; bv[bj][1] = *(const LAS f32x4*)(bl + 16 * fq + 8 * bj + 4) * Y8_SCALE; }
#pragma unroll
        for (int ai = 0; ai < 2; ++ai) if (ai < nai)
#pragma unroll
            for (int m = 0; m < 4; ++m) { const int rl = u.hx * 128 + ai * 128 + wr * 64 + m * 16 + fr; const int dst = rid[ai * 64 + m * 16 + fr];
                if (rl < nvalid) { const size_t ro = (size_t)dst * D + col0; unsigned wv[4];
#pragma unroll
                    for (int bj = 0; bj < 2; ++bj) { const f32x4 v0 = acc[ai][bj][m][0] * Y8_SCALE + bv[bj][0], v1 = acc[ai][bj][m][1] * Y8_SCALE + bv[bj][1];
                        wv[2 * bj] = pk4_fp8(v0[0], v0[1], v0[2], v0[3]); wv[2 * bj + 1] = pk4_fp8(v1[0], v1[1], v1[2], v1[3]); }
                    *(u32x4*)(y + ro) = (u32x4){wv[0], wv[1], wv[2], wv[3]}; } }
    }
};

__device__ __forceinline__ unsigned off_b(unsigned row, unsigned ch) { return 256u * row + 16u * (ch ^ (((row & 3) << 2) | ((row >> 2) & 3))); }
__device__ __forceinline__ unsigned row_addr16(unsigned lane, unsigned rb, unsigned s) { return off_b((lane & 15) + 16 * rb, 4 * s + (lane >> 4)); }
__device__ __forceinline__ unsigned tr_addr16(unsigned lane, unsigned c, unsigned ks, unsigned t) {
    const unsigned g = lane >> 4, q = (lane & 15) >> 2, p = lane & 3;
    return off_b(32 * ks + 8 * g + 4 * t + q, 2 * c + (p >> 1)) + 8 * (p & 1);
}
__device__ __forceinline__ bf16x8 tr_frag(LAS unsigned char* img, unsigned lane, unsigned c, unsigned ks) {
    const s16x4 a = __builtin_amdgcn_ds_read_tr16_b64_v4i16((LAS s16x4*)(img + tr_addr16(lane, c, ks, 0)));
    const s16x4 b = __builtin_amdgcn_ds_read_tr16_b64_v4i16((LAS s16x4*)(img + tr_addr16(lane, c, ks, 1)));
    return __builtin_shufflevector(a, b, 0, 1, 2, 3, 4, 5, 6, 7);
}
__device__ __forceinline__ bf16x8 row_frag(LAS unsigned char* img, unsigned lane, unsigned rb, unsigned s) { return *(const LAS bf16x8*)(img + row_addr16(lane, rb, s)); }
#define MFMA16(a, b, c) __builtin_amdgcn_mfma_f32_16x16x32_bf16(a, b, c, 0, 0, 0)
__device__ __forceinline__ unsigned row_base(unsigned lane, unsigned s) { return row_addr16(lane, 0, s); }
__device__ __forceinline__ unsigned tr_base(unsigned lane, unsigned c, unsigned t) { return tr_addr16(lane, c, 0, t); }
#define ROWF(img, base, off) (*(const LAS bf16x8*)((img) + (base) + (off)))
__device__ __forceinline__ bf16x8 trf(LAS unsigned char* img, unsigned b0, unsigned b1, unsigned off) {
    const s16x4 a = __builtin_amdgcn_ds_read_tr16_b64_v4i16((LAS s16x4*)(img + b0 + off));
    const s16x4 b = __builtin_amdgcn_ds_read_tr16_b64_v4i16((LAS s16x4*)(img + b1 + off));
    return __builtin_shufflevector(a, b, 0, 1, 2, 3, 4, 5, 6, 7);
}

__device__ __forceinline__ void spatial_unit(Frame& F, const Args& a, int n, int g) {
    LAS unsigned char* Wimg = F.lds; LAS unsigned char* Vimg = F.lds + 32768; LAS float* stats = (LAS float*)(F.lds + 65536);
    const int t0 = n * 128, ch0 = g * 128, tid = F.tid, lane = F.lane, w = F.wave;
    const bf16_t* V = (const bf16_t*)(F.ws + WS_V); const bf16_t* U = (const bf16_t*)(F.ws + WS_U); bf16_t* SG = (bf16_t*)(F.ws + WS_SG);
    const float* vstat = (const float*)(F.ws + WS_VSTAT);
    if (tid < 128) { const f32x4* p = (const f32x4*)(vstat + (size_t)(t0 + tid) * 32); float s = 0.f, q = 0.f;
#pragma unroll
        for (int j = 0; j < 8; ++j) { const f32x4 v = p[j]; s += v[0] + v[2]; q += v[1] + v[3]; }
        const float mean = s * (1.f / GW), var = q * (1.f / GW) - mean * mean;
        stats[2 * tid] = mean; stats[2 * tid + 1] = 1.0f / sqrtf(fmaxf(var, 0.f) + EPS); }
    const float* ws_g = a.in[5] + (size_t)g * 128 * 128;
#pragma unroll
    for (int i = 0; i < 4; ++i) { const int id = tid + 512 * i, t = id >> 4, ch = id & 15;
        const f32x4 x0 = *(const f32x4*)(ws_g + t * 128 + 8 * ch), x1 = *(const f32x4*)(ws_g + t * 128 + 8 * ch + 4);
        float v[8] = {x0[0], x0[1], x0[2], x0[3], x1[0], x1[1], x1[2], x1[3]};
#pragma unroll
        for (int j = 0; j < 8; ++j) v[j] = (8 * ch + j <= t) ? v[j] : 0.f;
        u32x4 o; o.x = cvt_pk_bf16(v[0], v[1]); o.y = cvt_pk_bf16(v[2], v[3]); o.z = cvt_pk_bf16(v[4], v[5]); o.w = cvt_pk_bf16(v[6], v[7]);
        *(LAS u32x4*)(Wimg + off_b(t, ch)) = o; }
    __syncthreads();
    const float* lng = a.in[3]; const float* lnb = a.in[4];
    {
        u32x4 xv[4]; const int ch = tid & 15;
#pragma unroll
        for (int i = 0; i < 4; ++i) xv[i] = __builtin_nontemporal_load((const u32x4*)(V + (size_t)(t0 + (tid >> 4) + 32 * i) * GW + ch0 + 8 * ch));
        const f32x4 g0 = *(const f32x4*)(lng + ch0 + 8 * ch), g1 = *(const f32x4*)(lng + ch0 + 8 * ch + 4), b0 = *(const f32x4*)(lnb + ch0 + 8 * ch), b1 = *(const f32x4*)(lnb + ch0 + 8 * ch + 4);
#pragma unroll
        for (int i = 0; i < 4; ++i) { const int s = (tid >> 4) + 32 * i; const u32x4 x = xv[i];
            const float mean = stats[2 * s], rstd = stats[2 * s + 1];
            float v[8] = {bf_lo(x.x), bf_hi(x.x), bf_lo(x.y), bf_hi(x.y), bf_lo(x.z), bf_hi(x.z), bf_lo(x.w), bf_hi(x.w)};
#pragma unroll
            for (int j = 0; j < 4; ++j) { v[j] = (v[j] - mean) * rstd * g0[j] + b0[j]; v[4 + j] = (v[4 + j] - mean) * rstd * g1[j] + b1[j]; }
            u32x4 o; o.x = cvt_pk_bf16(v[0], v[1]); o.y = cvt_pk_bf16(v[2], v[3]); o.z = cvt_pk_bf16(v[4], v[5]); o.w = cvt_pk_bf16(v[6], v[7]);
            *(LAS u32x4*)(Vimg + off_b(s, ch)) = o; }
    }
    __syncthreads();
    f32x4 acc[8];
#pragma unroll
    for (int c = 0; c < 8; ++c) acc[c] = (f32x4){0.f, 0.f, 0.f, 0.f};
    const int ksmax = w >> 1;
    {
        unsigned vb[8][2];
#pragma unroll
        for (int c = 0; c < 8; ++c) { vb[c][0] = tr_base(lane, c, 0); vb[c][1] = tr_base(lane, c, 1); }
        LAS unsigned char* Wrow = Wimg + 4096 * w;
#pragma unroll
        for (int ks = 0; ks < 4; ++ks) if (ks <= ksmax) {
            const bf16x8 y = ROWF(Wrow, row_base(lane, ks), 0);
            bf16x8 xf[8];
#pragma unroll
            for (int c = 0; c < 8; ++c) xf[c] = trf(Vimg, vb[c][0], vb[c][1], 8192 * ks);
            __builtin_amdgcn_sched_barrier(0);
#pragma unroll
            for (int c = 0; c < 8; ++c) acc[c] = MFMA16(xf[c], y, acc[c]);
            __builtin_amdgcn_sched_barrier(0);
        }
    }
    {
        LAS unsigned char* MT = F.lds + 66560;
        const int t = 16 * w + (lane & 15); const float bias = a.in[6][g * 128 + t];
#pragma unroll
        for (int c = 0; c < 8; ++c) *(LAS f32x4*)(MT + t * 528 + (16 * c + 4 * (lane >> 4)) * 4) = acc[c] + bias;
        __syncthreads();
        u32x4 uu[4];
#pragma unroll
        for (int i = 0; i < 4; ++i) uu[i] = __builtin_nontemporal_load((const u32x4*)(U + (size_t)(t0 + (tid >> 4) + 32 * i) * GW + ch0 + 8 * (tid & 15)));
#pragma unroll
        for (int i = 0; i < 4; ++i) { const int tt = (tid >> 4) + 32 * i, ch = tid & 15;
            const f32x4 m0 = *(const LAS f32x4*)(MT + tt * 528 + ch * 32), m1 = *(const LAS f32x4*)(MT + tt * 528 + ch * 32 + 16);
            const u32x4 u4 = uu[i];
            u32x4 r; r.x = cvt_pk_bf16(bf_lo(u4.x) * m0[0], bf_hi(u4.x) * m0[1]); r.y = cvt_pk_bf16(bf_lo(u4.y) * m0[2], bf_hi(u4.y) * m0[3]);
            r.z = cvt_pk_bf16(bf_lo(u4.z) * m1[0], bf_hi(u4.z) * m1[1]); r.w = cvt_pk_bf16(bf_lo(u4.w) * m1[2], bf_hi(u4.w) * m1[3]);
            *(u32x4*)(SG + (size_t)(t0 + tt) * GW + ch0 + 8 * ch) = r; }
    }
    __syncthreads();
}

__device__ __forceinline__ void kv_unit(Frame& F, const Args& a, int c, int h) {
    LAS unsigned char* Kimg = F.lds; LAS unsigned char* Vimg = F.lds + 32768;
    const int t0 = c * 128, tid = F.tid, lane = F.lane, w = F.wave;
    const bf16_t* Kb = (const bf16_t*)(F.ws + WS_K); const bf16_t* RV = (const bf16_t*)(F.ws + WS_RV); float* KV = (float*)(F.ws + WS_KV);
    const float l2g = a.l2g[h];
    {
        u32x4 kx[4], vx[8];
#pragma unroll
        for (int i = 0; i < 4; ++i) kx[i] = *(const u32x4*)(Kb + (size_t)(t0 + (tid >> 4) + 32 * i) * QKW + h * 128 + 8 * (tid & 15));
#pragma unroll
        for (int i = 0; i < 8; ++i) vx[i] = *(const u32x4*)(RV + (size_t)(t0 + (tid >> 5) + 16 * i) * D + h * 256 + 8 * (tid & 31));
#pragma unroll
        for (int i = 0; i < 4; ++i) *(LAS u32x4*)(Kimg + off_b((tid >> 4) + 32 * i, tid & 15)) = kx[i];
#pragma unroll
        for (int i = 0; i < 8; ++i) { const int s = (tid >> 5) + 16 * i, ch = tid & 31; const u32x4 x = vx[i]; const float z = exp2f((float)(127 - s) * l2g);
            u32x4 o; o.x = cvt_pk_bf16(bf_lo(x.x) * z, bf_hi(x.x) * z); o.y = cvt_pk_bf16(bf_lo(x.y) * z, bf_hi(x.y) * z); o.z = cvt_pk_bf16(bf_lo(x.z) * z, bf_hi(x.z) * z); o.w = cvt_pk_bf16(bf_lo(x.w) * z, bf_hi(x.w) * z);
            *(LAS u32x4*)(Vimg + (ch >> 4) * 32768 + off_b(s, ch & 15)) = o; }
    }
    __syncthreads();
    f32x4 acc[2][8];
#pragma unroll
    for (int j = 0; j < 2; ++j)
#pragma unroll
        for (int cd = 0; cd < 8; ++cd) acc[j][cd] = (f32x4){0.f, 0.f, 0.f, 0.f};
    LAS unsigned char* vi = Vimg + (w >> 2) * 32768; const int cimg = (2 * w) & 7;
    {
        unsigned kb[8][2], vb[2][2];
#pragma unroll
        for (int cd = 0; cd < 8; ++cd) { kb[cd][0] = tr_base(lane, cd, 0); kb[cd][1] = tr_base(lane, cd, 1); }
#pragma unroll
        for (int j = 0; j < 2; ++j) { vb[j][0] = tr_base(lane, cimg + j, 0); vb[j][1] = tr_base(lane, cimg + j, 1); }
#pragma unroll
        for (int ks = 0; ks < 4; ++ks) {
            const bf16x8 y0 = trf(vi, vb[0][0], vb[0][1], 8192 * ks), y1 = trf(vi, vb[1][0], vb[1][1], 8192 * ks);
            bf16x8 xf[8];
#pragma unroll
            for (int cd = 0; cd < 8; ++cd) xf[cd] = trf(Kimg, kb[cd][0], kb[cd][1], 8192 * ks);
            __builtin_amdgcn_sched_barrier(0);
#pragma unroll
            for (int cd = 0; cd < 8; ++cd) { acc[0][cd] = MFMA16(xf[cd], y0, acc[0][cd]); acc[1][cd] = MFMA16(xf[cd], y1, acc[1][cd]); }
            __builtin_amdgcn_sched_barrier(0);
        }
    }
    bf16_t* out = (bf16_t*)KV + (size_t)(c * 8 + h) * 32768;
    __syncthreads();
    LAS unsigned char* KT = F.lds;
#pragma unroll
    for (int j = 0; j < 2; ++j)
#pragma unroll
        for (int cd = 0; cd < 8; ++cd) { const int e = 16 * (2 * w + j) + (lane & 15), d = 16 * cd + 4 * (lane >> 4);
            u32x2 o; o.x = cvt_pk_bf16(acc[j][cd][0], acc[j][cd][1]); o.y = cvt_pk_bf16(acc[j][cd][2], acc[j][cd][3]); *(LAS u32x2*)(KT + e * 272 + d * 2) = o; }
    __syncthreads();
#pragma unroll
    for (int i = 0; i < 8; ++i) { const int id = tid + 512 * i, e = id >> 4, ch = id & 15;
        *(u32x4*)(out + e * 128 + 8 * ch) = *(const LAS u32x4*)(KT + e * 272 + 16 * ch); }
    __syncthreads();
}

__device__ __forceinline__ void scan_phase(Frame& F, const Args& a, int bi, int nb) {
    const unsigned* KV = (const unsigned*)(F.ws + WS_KV); unsigned* ST = (unsigned*)(F.ws + WS_ST);
    for (int pb = bi * NTHREADS; pb < 131072; pb += nb * NTHREADS) {
        const int h = __builtin_amdgcn_readfirstlane(pb >> 14); const unsigned qo = (unsigned)(pb & 16383) + (unsigned)F.tid; const float dh = exp2f(128.0f * a.l2g[h]);
        const unsigned* kvb = KV + (size_t)h * 16384; unsigned* stb = ST + (size_t)h * 16384;
        float s0 = 0.f, s1 = 0.f;
        {
            unsigned kv[NCHUNK];
#pragma unroll
            for (int j = 0; j < NCHUNK; ++j) kv[j] = __builtin_nontemporal_load(kvb + (size_t)j * 131072 + qo);
#pragma unroll
            for (int j = 0; j < NCHUNK; ++j) { (stb + (size_t)j * 131072)[qo] = cvt_pk_bf16(s0, s1); s0 = s0 * dh + bf_lo(kv[j]); s1 = s1 * dh + bf_hi(kv[j]); }
        }
    }
}

__device__ __forceinline__ void ret_unit(Frame& F, const Args& a, int c, int h) {
    LAS unsigned char* Qimg = F.lds; LAS unsigned char* Kimg = F.lds + 32768; LAS unsigned char* Vimg = F.lds + 65536;
    LAS float* part = (LAS float*)(F.lds + AUX_OFF); LAS float* stats = (LAS float*)(F.lds + AUX_OFF + 8192);
    const int t0 = c * 128, tid = F.tid, lane = F.lane, w = F.wave;
    const bf16_t* Qb = (const bf16_t*)(F.ws + WS_Q); const bf16_t* Kb = (const bf16_t*)(F.ws + WS_K); const bf16_t* RV = (const bf16_t*)(F.ws + WS_RV);
    const bf16_t* RG = (const bf16_t*)(F.ws + WS_RG); const bf16_t* ST = (const bf16_t*)(F.ws + WS_ST); bf16_t* RO = (bf16_t*)(F.ws + WS_RO);
    const float l2g = a.l2g[h];
    bf16x8 stf[2][4];
#pragma unroll
    for (int j = 0; j < 2; ++j)
#pragma unroll
        for (int ks = 0; ks < 4; ++ks) stf[j][ks] = __builtin_nontemporal_load((const bf16x8*)(ST + (size_t)(c * 8 + h) * 32768 + (16 * (2 * w + j) + (lane & 15)) * 128 + 32 * ks + 8 * (lane >> 4)));
    {
        u32x4 qx[4], kx[4], vx[8];
#pragma unroll
        for (int i = 0; i < 4; ++i) { const size_t o = (size_t)(t0 + (tid >> 4) + 32 * i) * QKW + h * 128 + 8 * (tid & 15); qx[i] = __builtin_nontemporal_load((const u32x4*)(Qb + o)); kx[i] = __builtin_nontemporal_load((const u32x4*)(Kb + o)); }
#pragma unroll
        for (int i = 0; i < 8; ++i) vx[i] = __builtin_nontemporal_load((const u32x4*)(RV + (size_t)(t0 + (tid >> 5) + 16 * i) * D + h * 256 + 8 * (tid & 31)));
#pragma unroll
        for (int i = 0; i < 4; ++i) { const unsigned o = off_b((tid >> 4) + 32 * i, tid & 15); *(LAS u32x4*)(Qimg + o) = qx[i]; *(LAS u32x4*)(Kimg + o) = kx[i]; }
#pragma unroll
        for (int i = 0; i < 8; ++i) *(LAS u32x4*)(Vimg + ((tid & 31) >> 4) * 32768 + off_b((tid >> 5) + 16 * i, tid & 15)) = vx[i];
    }
    __syncthreads();
    u32x2 pk[8];
    const int csmax = (w | 1);
    unsigned rb4[4];
#pragma unroll
    for (int ks = 0; ks < 4; ++ks) rb4[ks] = row_base(lane, ks);
    {
        bf16x8 yq[4];
#pragma unroll
        for (int ks = 0; ks < 4; ++ks) yq[ks] = ROWF(Qimg + 4096 * w, rb4[ks], 0);
        const int tt = 16 * w + (lane & 15);
#pragma unroll
        for (int cs = 0; cs < 8; ++cs) {
            pk[cs] = (u32x2){0u, 0u};
            if (cs <= csmax) {
                f32x4 sacc = (f32x4){0.f, 0.f, 0.f, 0.f};
                bf16x8 kf[4];
#pragma unroll
                for (int ks = 0; ks < 4; ++ks) kf[ks] = ROWF(Kimg, rb4[ks], 4096 * cs);
                __builtin_amdgcn_sched_barrier(0);
#pragma unroll
                for (int ks = 0; ks < 4; ++ks) sacc = MFMA16(kf[ks], yq[ks], sacc);
                float v[4];
#pragma unroll
                for (int r = 0; r < 4; ++r) { const int ss = 16 * cs + 4 * (lane >> 4) + r; v[r] = (tt >= ss) ? sacc[r] * exp2f((float)(tt - ss) * l2g) : 0.f; }
                pk[cs].x = cvt_pk_bf16(v[0], v[1]); pk[cs].y = cvt_pk_bf16(v[2], v[3]);
            }
        }
    }
    f32x4 acc[2][8];
#pragma unroll
    for (int j = 0; j < 2; ++j)
#pragma unroll
        for (int ct = 0; ct < 8; ++ct) acc[j][ct] = (f32x4){0.f, 0.f, 0.f, 0.f};
#pragma unroll
    for (int ct = 0; ct < 8; ++ct) {
        bf16x8 yy[4];
#pragma unroll
        for (int ks = 0; ks < 4; ++ks) yy[ks] = ROWF(Qimg, rb4[ks], 4096 * ct);
        __builtin_amdgcn_sched_barrier(0);
#pragma unroll
        for (int ks = 0; ks < 4; ++ks) { acc[0][ct] = MFMA16(stf[0][ks], yy[ks], acc[0][ct]); acc[1][ct] = MFMA16(stf[1][ks], yy[ks], acc[1][ct]); }
        const float xi = exp2f((float)(16 * ct + (lane & 15) + 1) * l2g);
        acc[0][ct] *= xi; acc[1][ct] *= xi;
        __builtin_amdgcn_sched_barrier(0);
    }
    __syncthreads();
    LAS unsigned char* Pimg = Kimg;
    {
        const int tt = 16 * w + (lane & 15);
#pragma unroll
        for (int cs = 0; cs < 8; ++cs) if (cs <= csmax) *(LAS u32x2*)(Pimg + off_b(tt, 2 * cs + (lane >> 5)) + 8 * ((lane >> 4) & 1)) = pk[cs];
    }
    __syncthreads();
    {
        LAS unsigned char* vi = Vimg + (w >> 2) * 32768; const int cimg = (2 * w) & 7;
        unsigned vb[2][2];
#pragma unroll
        for (int j = 0; j < 2; ++j) { vb[j][0] = tr_base(lane, cimg + j, 0); vb[j][1] = tr_base(lane, cimg + j, 1); }
        bf16x8 xv[2][4];
#pragma unroll
        for (int ks = 0; ks < 4; ++ks) { xv[0][ks] = trf(vi, vb[0][0], vb[0][1], 8192 * ks); xv[1][ks] = trf(vi, vb[1][0], vb[1][1], 8192 * ks); }
#pragma unroll
        for (int ct = 0; ct < 8; ++ct) {
            bf16x8 yy[4];
#pragma unroll
            for (int ks = 0; ks < 4; ++ks) if (ks <= (ct >> 1)) yy[ks] = ROWF(Pimg, rb4[ks], 4096 * ct);
            __builtin_amdgcn_sched_barrier(0);
#pragma unroll
            for (int ks = 0; ks < 4; ++ks) if (ks <= (ct >> 1)) { acc[0][ct] = MFMA16(xv[0][ks], yy[ks], acc[0][ct]); acc[1][ct] = MFMA16(xv[1][ks], yy[ks], acc[1][ct]); }
            __builtin_amdgcn_sched_barrier(0);
        }
    }
    {
        float s8[8], q8[8];
#pragma unroll
        for (int ct = 0; ct < 8; ++ct) { float s = 0.f, q = 0.f;
#pragma unroll
            for (int j = 0; j < 2; ++j)
#pragma unroll
                for (int r = 0; r < 4; ++r) { const float v = acc[j][ct][r]; s += v; q += v * v; }
            s8[ct] = s; q8[ct] = q; }
        float s16[8], q16[8];
#pragma unroll
        for (int ct = 0; ct < 8; ++ct) { s16[ct] = __shfl_xor(s8[ct], 16); q16[ct] = __shfl_xor(q8[ct], 16); }
        __builtin_amdgcn_sched_barrier(0);
#pragma unroll
        for (int ct = 0; ct < 8; ++ct) { s8[ct] += s16[ct]; q8[ct] += q16[ct]; }
#pragma unroll
        for (int ct = 0; ct < 8; ++ct) { s16[ct] = __shfl_xor(s8[ct], 32); q16[ct] = __shfl_xor(q8[ct], 32); }
        __builtin_amdgcn_sched_barrier(0);
#pragma unroll
        for (int ct = 0; ct < 8; ++ct) { const float s = s8[ct] + s16[ct], q = q8[ct] + q16[ct];
            if ((lane >> 4) == 0) { part[((16 * ct + lane) * 8 + w) * 2] = s; part[((16 * ct + lane) * 8 + w) * 2 + 1] = q; } }
    }
    __syncthreads();
    if (tid < 128) { float s = 0.f, q = 0.f;
#pragma unroll
        for (int j = 0; j < 8; ++j) { s += part[(tid * 8 + j) * 2]; q += part[(tid * 8 + j) * 2 + 1]; }
        const float mean = s * (1.f / 256.f), var = q * (1.f / 256.f) - mean * mean;
        stats[2 * tid] = mean; stats[2 * tid + 1] = 1.0f / sqrtf(fmaxf(var, 0.f) + EPS); }
    __syncthreads();
    {
        LAS unsigned char* OT = F.lds;
#pragma unroll
        for (int ct = 0; ct < 8; ++ct) { const int tt = 16 * ct + (lane & 15); const float mean = stats[2 * tt], rstd = stats[2 * tt + 1];
#pragma unroll
            for (int j = 0; j < 2; ++j) { const f32x4 v = (acc[j][ct] - mean) * rstd; u32x2 r; r.x = cvt_pk_bf16(v[0], v[1]); r.y = cvt_pk_bf16(v[2], v[3]);
                *(LAS u32x2*)(OT + tt * 528 + (16 * (2 * w + j) + 4 * (lane >> 4)) * 2) = r; } }
        __syncthreads();
        u32x4 gx[8];
#pragma unroll
        for (int i = 0; i < 8; ++i) gx[i] = __builtin_nontemporal_load((const u32x4*)(RG + (size_t)(t0 + (tid >> 5) + 16 * i) * D + h * 256 + 8 * (tid & 31)));
#pragma unroll
        for (int i = 0; i < 8; ++i) { const int tt = (tid >> 5) + 16 * i, ch = tid & 31;
            const u32x4 v = *(const LAS u32x4*)(OT + tt * 528 + ch * 16); const u32x4 g = gx[i];
            u32x4 r; r.x = cvt_pk_bf16(bf_lo(v.x) * bf_lo(g.x), bf_hi(v.x) * bf_hi(g.x)); r.y = cvt_pk_bf16(bf_lo(v.y) * bf_lo(g.y), bf_hi(v.y) * bf_hi(g.y));
            r.z = cvt_pk_bf16(bf_lo(v.z) * bf_lo(g.z), bf_hi(v.z) * bf_hi(g.z)); r.w = cvt_pk_bf16(bf_lo(v.w) * bf_lo(g.w), bf_hi(v.w) * bf_hi(g.w));
            *(u32x4*)(RO + (size_t)(t0 + tt) * D + h * 256 + 8 * ch) = r; }
    }
    __syncthreads();
}

__device__ __forceinline__ void router_tile(Frame& F, const Args& a, int tile) {
    LAS float* part = (LAS float*)F.lds;
    LAS int* cntl = (LAS int*)(F.lds + 40960); LAS int* basel = cntl + 32;
    const int tid = F.tid, lane = F.lane, w = F.wave, ts = w & 1, kq = w >> 1, i = lane & 31, kh = lane >> 5;
    const int tok = tile * 64 + 32 * ts + i;
    const float* X1 = (const float*)(F.ws + WS_X1); const float* SS = (const float*)(F.ws + WS_SS); unsigned char* H2 = (unsigned char*)(F.ws + WS_H);
    const float* g2 = a.in[10]; const float* rw = a.in[11]; const float* rb = a.in[12];
    if (tid < 32) cntl[tid] = 0;
    float ssum = 0.f;
#pragma unroll
    for (int j = 0; j < 8; ++j) { const f32x4 v = *(const f32x4*)(SS + (size_t)tok * 32 + 4 * j); ssum += (v[0] + v[1]) + (v[2] + v[3]); }
    const float rstd = 1.0f / sqrtf(ssum * (1.f / D) + EPS);
    f32x16 acc;
#pragma unroll
    for (int r = 0; r < 16; ++r) acc[r] = 0.f;
    LAS float* rwl = (LAS float*)(F.lds + 49152); LAS float* g2l = (LAS float*)(F.lds + 114688);
    { const f32x4 gv = *(const f32x4*)(g2 + 4 * tid); *(LAS f32x4*)(g2l + 4 * tid) = gv; }
    const unsigned rwl_u = (unsigned)__builtin_amdgcn_readfirstlane((int)((unsigned)(size_t)rwl + (unsigned)(kq * 8192 + ts * 4096)));
#define RW_STAGE(p_) do { const char* src_ = (const char*)(rw + (size_t)(512 * kq + 64 * (p_) + 32 * ts) * NE); const unsigned dst_ = rwl_u + (unsigned)(((p_) & 1) * 32768); \
        _Pragma("unroll") for (int j = 0; j < 4; ++j) pg8::glds16(src_, (unsigned)(lane * 16 + j * 1024), dst_ + (unsigned)(j * 1024)); } while (0)
    RW_STAGE(0);
    asm volatile("s_waitcnt vmcnt(0)" ::: "memory");
    {
        f32x4 xc[4]; float avp[16];
#pragma unroll
        for (int q = 0; q < 16; ++q) avp[q] = 0.f;
#define RT_LOAD(sc_, X) do { const int kb_ = 512 * kq + 64 * ((sc_) >> 1) + 32 * kh + 16 * ((sc_) & 1); \
            _Pragma("unroll") for (int q = 0; q < 4; ++q) X[q] = *(const f32x4*)(X1 + (size_t)tok * D + kb_ + 4 * q); } while (0)
        RT_LOAD(0, xc);
#pragma unroll 1
        for (int sc = 0; sc < 16; ++sc) {
            if ((sc & 1) == 0) {
                asm volatile("s_waitcnt lgkmcnt(0)" ::: "memory"); __builtin_amdgcn_s_barrier(); asm volatile("" ::: "memory");
                if (sc < 14) RW_STAGE((sc >> 1) + 1); }
            const int kb = 512 * kq + 64 * (sc >> 1) + 32 * kh + 16 * (sc & 1);
            f32x4 xn[4];
            { const int sn = sc < 15 ? sc + 1 : 15; RT_LOAD(sn, xn); }
            f32x4 gc[4]; float bc[16];
#pragma unroll
            for (int q = 0; q < 4; ++q) gc[q] = *(const LAS f32x4*)(g2l + kb + 4 * q);
            { const LAS float* rwb = rwl + ((sc >> 1) & 1) * 8192 + kq * 2048 + (32 * kh + 16 * (sc & 1)) * 32 + i;
#pragma unroll
              for (int q = 0; q < 16; ++q) bc[q] = rwb[q * 32]; }
            float av[16];
#pragma unroll
            for (int q = 0; q < 4; ++q) { av[4 * q] = xc[q][0] * rstd * gc[q][0]; av[4 * q + 1] = xc[q][1] * rstd * gc[q][1]; av[4 * q + 2] = xc[q][2] * rstd * gc[q][2]; av[4 * q + 3] = xc[q][3] * rstd * gc[q][3]; }
            if (sc & 1) {
                float v32[32];
#pragma unroll
                for (int q = 0; q < 16; ++q) { v32[q] = avp[q]; v32[16 + q] = av[q]; }
                u32x4 lo, hi; q6_block(v32, lo, hi);
                const int k0 = kb - 16, b32 = k0 >> 5;
                unsigned char* base = H2 + (size_t)tok * D + 128 * (b32 >> 2) + 16 * (b32 & 3);
                *(u32x4*)base = lo; *(u32x4*)(base + 64) = hi;
            }
#pragma unroll
            for (int q = 0; q < 16; ++q) avp[q] = av[q];
#pragma unroll
            for (int q = 0; q < 16; ++q) acc = __builtin_amdgcn_mfma_f32_32x32x2f32(av[q], bc[q], acc, 0, 0, 0);
#pragma unroll
            for (int q = 0; q < 4; ++q) xc[q] = xn[q];
        }
#undef RT_LOAD
#undef RW_STAGE
    }
#pragma unroll
    for (int r = 0; r < 16; ++r) { const int row = (r & 3) + 8 * (r >> 2) + 4 * kh; part[((kq * 2 + ts) * 32 + row) * 33 + i] = acc[r]; }
    __syncthreads();
    int te[4] = {0, 0, 0, 0}; float tv[4] = {-3.0e38f, -3.0e38f, -3.0e38f, -3.0e38f}; int lr[4] = {0, 0, 0, 0};
    if (tid < 64) {
        const int tsl = tid >> 5, rowl = tid & 31;
        for (int e = 0; e < NE; ++e) {
            float lg = rb[e];
#pragma unroll
            for (int q = 0; q < 4; ++q) lg += part[((q * 2 + tsl) * 32 + rowl) * 33 + e];
            if (lg > tv[3]) { tv[3] = lg; te[3] = e;
#pragma unroll
                for (int j = 3; j > 0; --j) if (tv[j] > tv[j - 1]) { const float fv = tv[j]; tv[j] = tv[j - 1]; tv[j - 1] = fv; const int iv = te[j]; te[j] = te[j - 1]; te[j - 1] = iv; } }
        }
#pragma unroll
        for (int k = 0; k < 4; ++k) lr[k] = __hip_atomic_fetch_add(&cntl[te[k]], 1, __ATOMIC_RELAXED, __HIP_MEMORY_SCOPE_WORKGROUP);
    }
    __syncthreads();
    if (tid < 32) { const int cn = cntl[tid]; int base = 0; if (cn > 0) base = (int)__hip_atomic_fetch_add((unsigned*)(F.ws + WS_CTL) + CW_CNT + 16 * tid, (unsigned)cn, __ATOMIC_RELAXED, __HIP_MEMORY_SCOPE_AGENT); basel[tid] = base; }
    __syncthreads();
    if (tid < 64) {
        const int t = tile * 64 + tid;
        int* TOKE = (int*)(F.ws + WS_TOKE); int* TOKR = (int*)(F.ws + WS_TOKR); float* TOKW = (float*)(F.ws + WS_TOKW); int* ROWTOK = (int*)(F.ws + WS_ROWTOK);
        float ex[4], sum = 0.f;
#pragma unroll
        for (int k = 0; k < 4; ++k) { ex[k] = __expf(tv[k] - tv[0]); sum += ex[k]; }
        const float inv = 1.0f / sum;
#pragma unroll
        for (int k = 0; k < 4; ++k) { const int rank = basel[te[k]] + lr[k]; TOKE[t * 4 + k] = te[k]; TOKR[t * 4 + k] = rank; TOKW[t * 4 + k] = ex[k] * inv; ROWTOK[te[k] * T + rank] = t * 4 + k; }
    }
    __syncthreads();
}

__device__ __forceinline__ void moe_table(Frame& F, LAS int* cnt, LAS int* tall, LAS int* tfull, LAS int* tsmall, LAS int* thalf) {
    if (F.tid < 64) {
        const int e = F.lane; int c = 0;
        if (e < NE) c = (int)__hip_atomic_load((unsigned*)(F.ws + WS_CTL) + CW_CNT + 16 * e, __ATOMIC_RELAXED, __HIP_MEMORY_SCOPE_AGENT);
        const int tl = (c + 255) >> 8; const int rem = c - 256 * (tl - 1); const int sm = (MK_HM && tl > 0 && rem <= 128) ? 1 : 0;
        int ia = tl, is = sm;
#pragma unroll
        for (int o = 1; o < 32; o <<= 1) { const int va = __shfl_up(ia, o), vs = __shfl_up(is, o); if ((F.lane & 31) >= o) { ia += va; is += vs; } }
        if (e < NE) { cnt[e] = c; tall[e + 1] = ia; tsmall[e + 1] = is; tfull[e + 1] = ia - is; thalf[e + 1] = 2 * ia; }
        if (e == 0) { tall[0] = 0; tsmall[0] = 0; tfull[0] = 0; thalf[0] = 0; }
    }
    __syncthreads();
}

__device__ __forceinline__ void combine_phase(Frame& F, const Args& a) {
    const int gw = F.vcu * NWAVES + F.wave, NGW = F.G * NWAVES, lane = F.lane;
    const float* X1 = (const float*)(F.ws + WS_X1); const unsigned char* Y = (const unsigned char*)(F.ws + WS_Y);
    const int* TOKE = (const int*)(F.ws + WS_TOKE); const int* TOKR = (const int*)(F.ws + WS_TOKR); const float* TOKW = (const float*)(F.ws + WS_TOKW);
    const float* gf = a.in[17];
    f32x4 gfv[8];
#pragma unroll
    for (int j = 0; j < 8; ++j) gfv[j] = ((const f32x4*)gf)[lane + 64 * j];
    for (int t = gw; t < T; t += NGW) {
        f32x4 v[8]; unsigned yy[4][8];
#pragma unroll
        for (int j = 0; j < 8; ++j) v[j] = __builtin_nontemporal_load((const f32x4*)(X1 + (size_t)t * D) + lane + 64 * j);
        const f32x4 w4 = *(const f32x4*)(TOKW + (size_t)t * 4);
#pragma unroll
        for (int k = 0; k < 4; ++k) { const unsigned* yr = (const unsigned*)(Y + ((size_t)t * 4 + k) * D) + lane;
#pragma unroll
            for (int j = 0; j < 8; ++j) yy[k][j] = __builtin_nontemporal_load(yr + 64 * j); }
#pragma unroll
        for (int k = 0; k < 4; ++k) { const float wq = w4[k] * (1.0f / Y8_SCALE);
#pragma unroll
            for (int j = 0; j < 8; ++j) { const unsigned y = yy[k][j]; const f32x2 lo = __builtin_amdgcn_cvt_pk_f32_fp8((int)y, false), hi = __builtin_amdgcn_cvt_pk_f32_fp8((int)y, true);
                v[j][0] += wq * lo.x; v[j][1] += wq * lo.y; v[j][2] += wq * hi.x; v[j][3] += wq * hi.y; } }
        float s = 0.f;
#pragma unroll
        for (int j = 0; j < 8; ++j) s += (v[j][0] * v[j][0] + v[j][1] * v[j][1]) + (v[j][2] * v[j][2] + v[j][3] * v[j][3]);
        const float rstd = 1.0f / sqrtf(wave_sum(s) * (1.f / D) + EPS);
#pragma unroll
        for (int j = 0; j < 8; ++j) __builtin_nontemporal_store(v[j] * rstd * gfv[j], (f32x4*)(a.out + (size_t)t * D) + lane + 64 * j);
    }
}

__device__ __forceinline__ int reframe(Frame& F) { int t_ = threadIdx.x; asm volatile("" : "+v"(t_)); F.tid = t_; F.lane = t_ & 63; F.wave = __builtin_amdgcn_readfirstlane(t_ >> 6); return 0; }
constexpr int N_PHASES = 12;
__global__ void __launch_bounds__(NTHREADS, 2) mk_fwd(Args args) {
    extern __shared__ __attribute__((aligned(16))) unsigned char lds[];
    Frame F;
    F.lds = (LAS unsigned char*)lds;
    F.tid = threadIdx.x; F.lane = F.tid & 63; F.wave = __builtin_amdgcn_readfirstlane(F.tid >> 6);
    F.G = gridDim.x; { const int bx = blockIdx.x; F.vcu = (F.G % 8 == 0) ? (bx % 8) * (F.G / 8) + bx / 8 : bx; }
    F.ws = args.ws;
    volatile LAS unsigned* MISC = (volatile LAS unsigned*)(F.lds + MISC_OFF);
    for (int u = F.tid; u < (LDS_BYTES - MISC_OFF) / 4; u += NTHREADS) MISC[u] = 0u;
    __syncthreads();
    unsigned* ctl = (unsigned*)(F.ws + WS_CTL);
    XcdBarrier bar; bar.bar = ctl + CW_BAR; bar.x = 0; bar.st = nullptr;
    if (MK_N_LAUNCHES == 1) bar = xcd_barrier_post(ctl + CW_BAR, MISC + 8);
    const int lo = args.ph_lo, hi = args.ph_hi;
#define IN(k) ((((MK_PHASES) >> (k)) & 1) && lo <= (k) && (k) < hi)
#define SEAM(k) do { if (IN(k) && IN((k) + 1)) xcd_barrier(bar); } while (0)
    LAS int* mcnt = (LAS int*)(F.lds + MISC_OFF + 256); LAS int* mtstart = mcnt + 32; LAS int* mtfull = mcnt + 96; LAS int* mtsmall = mcnt + 160; LAS int* mthalf = mcnt + 224;

#define REFRAME() do { int t_ = threadIdx.x; asm volatile("" : "+v"(t_)); F.tid = t_; F.lane = t_ & 63; F.wave = __builtin_amdgcn_readfirstlane(t_ >> 6); } while (0)
#define REP(k) for (int rep_ = reframe(F); rep_ < (((MK_DUP) >> (k)) & 1) + 1; ++rep_)
#define REPBAR(k) do { if ((((MK_DUP) >> (k)) & 1) && rep_ == 0) xcd_barrier(bar); } while (0)
    if (IN(0)) REP(0) { p0_prologue(F, args); if (MK_CONV_IN_P0) conv_rest(F, args, F.vcu * NWAVES + F.wave, F.G * NWAVES); REPBAR(0); } SEAM(0);
    if (IN(1)) REP(1) {
        const int nconv = (MK_NCONV * F.G) / 256, ngemm = F.G - nconv;
        if ((int)blockIdx.x < ngemm) {
            pg8::DenseSched S; S.init((const bf16_t*)(F.ws + WS_H), D, (const bf16_t*)(F.ws + WS_WIN), D, T, INW, ngemm, (int)blockIdx.x);
            EpiInProj E{F.ws};
            if (MK_RSYNC) pg8::gemm_phase<0, EpiInProj, pg8::DenseSched, 127, 127, true>(F.lds, S, E, &bar); else pg8::gemm_phase<0>(F.lds, S, E);
        } else if (!MK_CONV_IN_P0) conv_rest(F, args, ((int)blockIdx.x - ngemm) * NWAVES + F.wave, nconv * NWAVES);
        REPBAR(1);
    } SEAM(1);
    if (IN(2)) REP(2) {
        if (MK_NSCAN == 0) for (int u = blockIdx.x; u < 1024; u += F.G) spatial_unit(F, args, u >> 3, u & 7);
        for (int u = blockIdx.x; u < 1024; u += F.G) kv_unit(F, args, u >> 3, u & 7);
        REPBAR(2);
    } SEAM(2);
    if (IN(3)) REP(3) {
        const int nscan = (MK_NSCAN * F.G) / 256, nsp = F.G - nscan;
        if (MK_NSCAN == 0) scan_phase(F, args, (int)blockIdx.x, F.G);
        else if ((int)blockIdx.x < nsp) { for (int u = blockIdx.x; u < 1024; u += nsp) spatial_unit(F, args, u >> 3, u & 7); }
        else scan_phase(F, args, (int)blockIdx.x - nsp, nscan);
        REPBAR(3);
    } SEAM(3);
    if (IN(4)) REP(4) { for (int u = blockIdx.x; u < 1024; u += F.G) ret_unit(F, args, u >> 3, u & 7); REPBAR(4); } SEAM(4);
    if (IN(5)) REP(5) {
        { pg8::DenseSched S; S.init((const bf16_t*)(F.ws + WS_SG), GW, (const bf16_t*)(F.ws + WS_WPA), GW, T, D, F.G, (int)blockIdx.x); EpiMerge<0> E{F.ws}; pg8::gemm_phase<0>(F.lds, S, E); }
        __syncthreads();
        { pg8::DenseSched S; S.init((const bf16_t*)(F.ws + WS_RO), D, (const bf16_t*)(F.ws + WS_WPR), D, T, D, F.G, (int)blockIdx.x); EpiMerge<1> E{F.ws}; pg8::gemm_phase<0>(F.lds, S, E); }
        REPBAR(5);
    } SEAM(5);
    if (IN(6)) REP(6) {
        pg8::DenseSched S; S.init((const bf16_t*)(F.ws + WS_MRG), D, (const bf16_t*)(F.ws + WS_WOUT), D, T, D, F.G, (int)blockIdx.x);
        EpiOut E{args.in[0], F.ws};
        pg8::gemm_phase<0>(F.lds, S, E); REPBAR(6);
    } SEAM(6);
    if (IN(7)) { REFRAME(); for (int tile = blockIdx.x; tile < T / 64; tile += F.G) router_tile(F, args, tile); } SEAM(7);
#define MOE_SCHED(SV, GATHER_, MODE_, A_, LDA_, BT_, K_, NB_, NN_, TS_) pg8::MoeSched<GATHER_, MODE_> SV; SV.A = (const bf16_t*)(A_); SV.lda = (LDA_); SV.Bt = (const bf16_t*)(BT_); SV.K = (K_); SV.NB = (NB_); SV.nN = (NN_); SV.tstart = (TS_); SV.tall = mtstart; \
        SV.cnt = mcnt; SV.rowtok = (GATHER_) ? (const int*)(F.ws + WS_ROWTOK) : nullptr; SV.aux = F.lds + AUX_OFF; SV.nwg = __builtin_amdgcn_readfirstlane((TS_)[NE]) * (NN_); SV.G = F.G; SV.c = (int)blockIdx.x; SV.ecur = 0
    if (IN(8)) REP(8) {
        moe_table(F, mcnt, mtstart, mtfull, mtsmall, mthalf);
        EpiGateUp E{args.in[14], F.ws};
        if (!MK_HM_TEST) { MOE_SCHED(S, true, 0, F.ws + WS_H, D / 2, F.ws + WS_WGU, D / 2, 4096, 16, mtfull); pg8::gemm_phase<2, EpiGateUp, pg8::MoeSched<true, 0>>(F.lds, S, E); }
        __syncthreads();
        if (MK_HM_TEST) { MOE_SCHED(S, true, 2, F.ws + WS_H, D / 2, F.ws + WS_WGU, D / 2, 4096, 16, mthalf); pg8::gemm_phase<2, EpiGateUp, pg8::MoeSched<true, 2>, 127, 127, false, true>(F.lds, S, E); }
        else if (MK_HM) { MOE_SCHED(S, true, 1, F.ws + WS_H, D / 2, F.ws + WS_WGU, D / 2, 4096, 16, mtsmall); pg8::gemm_phase<2, EpiGateUp, pg8::MoeSched<true, 1>, 127, 127, false, true>(F.lds, S, E); }
        REPBAR(8);
    } SEAM(8);
    if (IN(9)) REP(9) {
        moe_table(F, mcnt, mtstart, mtfull, mtsmall, mthalf);
        EpiDown E{args.in[16], F.ws, mcnt};
        if (!MK_HM_TEST) { MOE_SCHED(S, false, 0, F.ws + WS_ACT, DFF / 2, F.ws + WS_WDN, DFF / 2, 2048, 8, mtfull); pg8::gemm_phase<1, EpiDown, pg8::MoeSched<false, 0>, 117, 125>(F.lds, S, E); }
        __syncthreads();
        if (MK_HM_TEST) { MOE_SCHED(S, false, 2, F.ws + WS_ACT, DFF / 2, F.ws + WS_WDN, DFF / 2, 2048, 8, mthalf); pg8::gemm_phase<1, EpiDown, pg8::MoeSched<false, 2>, 117, 125, false, true>(F.lds, S, E); }
        else if (MK_HM) { MOE_SCHED(S, false, 1, F.ws + WS_ACT, DFF / 2, F.ws + WS_WDN, DFF / 2, 2048, 8, mtsmall); pg8::gemm_phase<1, EpiDown, pg8::MoeSched<false, 1>, 117, 125, false, true>(F.lds, S, E); }
        REPBAR(9);
    } SEAM(9);
#undef MOE_SCHED
    if (IN(10)) REP(10) { combine_phase(F, args); REPBAR(10); }
#undef REP
#undef REFRAME
#undef REPBAR
#undef IN
#undef SEAM
}

#include <cmath>
extern "C" void kernel_launch(void* const* d_in, const int* in_sizes, int n_in, void* d_out, int out_size, void* d_ws, size_t ws_size, hipStream_t stream) {
    static int grid = 0;
    if (grid == 0) {
        if (n_in != 18 || out_size != T * D || ws_size < WS_END) { fprintf(stderr, "kernel_launch: unexpected shapes (n_in %d out %d ws %zu need %zu)\n", n_in, out_size, ws_size, (size_t)WS_END); grid = -1; return; }
        int dev = 0, cus = 0, per_cu = 0;
        if (hipGetDevice(&dev) != hipSuccess || hipDeviceGetAttribute(&cus, hipDeviceAttributeMultiprocessorCount, dev) != hipSuccess) { grid = -1; return; }
        if (hipFuncSetAttribute((const void*)mk_fwd, hipFuncAttributeMaxDynamicSharedMemorySize, LDS_BYTES) != hipSuccess) { fprintf(stderr, "kernel_launch: hipFuncSetAttribute failed\n"); grid = -1; return; }
        if (hipOccupancyMaxActiveBlocksPerMultiprocessor(&per_cu, (const void*)mk_fwd, NTHREADS, LDS_BYTES) != hipSuccess || per_cu < 1) fprintf(stderr, "kernel_launch: occupancy query says %d\n", per_cu);
        (void)hipGetLastError();
        grid = cus;
    }
    if (grid < 0) return;
    (void)hipMemsetAsync((char*)d_ws + WS_CTL, 0, CTL_ZERO_BYTES, stream);
    Args a{};
    for (int i = 0; i < 18; ++i) a.in[i] = (const float*)d_in[i];
    a.out = (float*)d_out; a.ws = (unsigned char*)d_ws;
    for (int h = 0; h < 8; ++h) a.l2g[h] = (float)std::log2(1.0 - std::exp2(-5.0 - (double)h));
#if MK_N_LAUNCHES == 1
    a.ph_lo = 0; a.ph_hi = N_PHASES;
    hipLaunchKernelGGL(mk_fwd, dim3(grid), dim3(NTHREADS), LDS_BYTES, stream, a);
#else
    for (int p = 0; p < 11; ++p) { a.ph_lo = p; a.ph_hi = p + 1; hipLaunchKernelGGL(mk_fwd, dim3(grid), dim3(NTHREADS), LDS_BYTES, stream, a); }
#endif
}
```

```cpp
#include <hip/hip_runtime.h>
#include <cstdio>
#include <cstdint>

#ifndef MK_N_LAUNCHES
#define MK_N_LAUNCHES 1
#endif
#ifndef MK_PHASES
#define MK_PHASES 0xFFFF
#endif
#ifndef MK_NCONV
#define MK_NCONV 64
#endif
#ifndef MK_CONV_IN_P0
#define MK_CONV_IN_P0 0
#endif
#ifndef MK_RSYNC
#define MK_RSYNC 0
#endif
#ifndef MK_NSCAN
#define MK_NSCAN 0
#endif
#ifndef MK_HM
#define MK_HM 1
#endif
#ifndef MK_HM_TEST
#define MK_HM_TEST 0
#endif
#ifndef MK_DUP
#define MK_DUP 0
#endif

#define GAS __attribute__((address_space(1)))
#define LAS __attribute__((address_space(3)))
typedef unsigned short bf16_t;
typedef short bf16x8 __attribute__((ext_vector_type(8)));
typedef short s16x4 __attribute__((ext_vector_type(4)));
typedef float f32x4 __attribute__((ext_vector_type(4)));
typedef float f32x2 __attribute__((ext_vector_type(2)));
typedef float f32x16 __attribute__((ext_vector_type(16)));
typedef unsigned u32x4 __attribute__((ext_vector_type(4)));
typedef unsigned u32x2 __attribute__((ext_vector_type(2)));

constexpr int T = 16384, D = 2048, GW = 1024, QKW = 1024, INW = 12288, NE = 32, DFF = 2048;
constexpr int NCHUNK = 128, NH = 8;
constexpr float EPS = 1e-6f;
constexpr int NWAVES = 8, NTHREADS = 512;
constexpr int ACT_ROWS = 73728;
constexpr float W8_SCALE = 1024.0f, H8_SCALE = 16.0f, A8_SCALE = 4.0f, Y8_SCALE = 32.0f;

constexpr size_t MiB = 1u << 20;
constexpr size_t WS_CTL = 0, CTL_ZERO_BYTES = 1 * MiB;
constexpr size_t WS_WIN = 2 * MiB;
constexpr size_t WS_WPA = WS_WIN + 48 * MiB;
constexpr size_t WS_WPR = WS_WPA + 4 * MiB;
constexpr size_t WS_WOUT = WS_WPR + 8 * MiB;
constexpr size_t WS_WGU = WS_WOUT + 8 * MiB;
constexpr size_t WS_WDN = WS_WGU + 512 * MiB;
constexpr size_t WS_H = WS_WDN + 256 * MiB;
constexpr size_t WS_U = WS_H + 64 * MiB;
constexpr size_t WS_V = WS_U + 32 * MiB;
constexpr size_t WS_Q = WS_V + 32 * MiB;
constexpr size_t WS_K = WS_Q + 32 * MiB;
constexpr size_t WS_RV = WS_K + 32 * MiB;
constexpr size_t WS_RG = WS_RV + 64 * MiB;
constexpr size_t WS_GA = WS_RG + 64 * MiB;
constexpr size_t WS_GR = WS_GA + 64 * MiB;
constexpr size_t WS_VSTAT = WS_GR + 64 * MiB;
constexpr size_t WS_ROPEC = WS_VSTAT + 2 * MiB;
constexpr size_t WS_ROPES = WS_ROPEC + 4 * MiB;
constexpr size_t WS_SG = WS_ROPES + 4 * MiB;
constexpr size_t WS_KV = WS_SG + 32 * MiB;
constexpr size_t WS_ST = WS_KV + 128 * MiB;
constexpr size_t WS_RO = WS_ST + 64 * MiB;
constexpr size_t WS_MRG = WS_RO + 64 * MiB;
constexpr size_t WS_X1 = WS_MRG + 64 * MiB;
constexpr size_t WS_SS = WS_X1 + 128 * MiB;
constexpr size_t WS_TOKE = WS_SS + 2 * MiB;
constexpr size_t WS_TOKR = WS_TOKE + 1 * MiB;
constexpr size_t WS_TOKW = WS_TOKR + 1 * MiB;
constexpr size_t WS_ROWTOK = WS_TOKW + 1 * MiB;
constexpr size_t WS_ACT = WS_ROWTOK + 2 * MiB;
constexpr size_t WS_Y = WS_ACT + 288 * MiB;
constexpr size_t WS_END = WS_Y + 288 * MiB;
constexpr int CW_TMO = 0;
constexpr int CW_BAR = 4096;
constexpr int CW_CNT = 8192;
constexpr int CW_DBG = 12288;

constexpr int RING_BYTES = 131072;
constexpr int AUX_OFF = RING_BYTES;
constexpr int MISC_OFF = AUX_OFF + 12288;
constexpr int LDS_BYTES = 147456;

typedef __bf16 bf16x2_t __attribute__((ext_vector_type(2)));
__device__ __forceinline__ unsigned cvt_pk_bf16(float lo, float hi) { f32x2 v = {lo, hi}; bf16x2_t b = __builtin_convertvector(v, bf16x2_t); return __builtin_bit_cast(unsigned, b); }
__device__ __forceinline__ unsigned pk4_fp8(float a, float b, float c, float d) { int w = 0; w = __builtin_amdgcn_cvt_pk_fp8_f32(a, b, w, false); w = __builtin_amdgcn_cvt_pk_fp8_f32(c, d, w, true); return (unsigned)w; }
__device__ __forceinline__ float bf_lo(unsigned w) { return __uint_as_float(w << 16); }
__device__ __forceinline__ float bf_hi(unsigned w) { return __uint_as_float(w & 0xffff0000u); }
__device__ __forceinline__ float bf2f(bf16_t b) { return __uint_as_float(((unsigned)b) << 16); }
__device__ __forceinline__ float wave_sum(float v) {
#pragma unroll
    for (int o = 1; o < 64; o <<= 1) v += __shfl_xor(v, o);
    return v;
}
__device__ __forceinline__ float sigmoid_f(float x) { return __builtin_amdgcn_rcpf(1.0f + __expf(-x)); }
__device__ __forceinline__ f32x2 gelu_pk(f32x2 v) {
    const f32x2 av = __builtin_elementwise_abs(v), d = av * 0.2316418882f + 1.0f;
    f32x2 t; t.x = __builtin_amdgcn_rcpf(d.x); t.y = __builtin_amdgcn_rcpf(d.y);
    f32x2 q = t * 0.5307027145f + (-0.7265760135f); q = q * t + 0.7107068705f; q = q * t + (-0.142248368f); q = q * t + 0.127414796f; q = q * t;
    const f32x2 s = (v * v) * (-0.72134752044f);
    f32x2 e; e.x = __builtin_amdgcn_exp2f(s.x); e.y = __builtin_amdgcn_exp2f(s.y);
    const f32x2 m = v * (q * e), r = v - m;
    f32x2 o; o.x = v.x < 0.f ? m.x : r.x; o.y = v.y < 0.f ? m.y : r.y; return o;
}
__device__ __forceinline__ f32x4 gelu4(f32x4 v) { f32x2 a = gelu_pk((f32x2){v[0], v[1]}), b = gelu_pk((f32x2){v[2], v[3]}); return (f32x4){a.x, a.y, b.x, b.y}; }

#define XB_TMO      128
#define XB_XCNT(j)  (256  + 64 * (j))
#define XB_XSUB(j)  (1280 + 64 * (j))
#define XB_XGEN(j)  (2304 + 64 * (j))
#define XB_TOP      3328
#define XB_TOPGEN   3392
#define XCD_BAR_WORDS 3456
#define XB_SPIN_CAP (1u << 18)
__device__ __forceinline__ unsigned xb_ld(unsigned* p)              { return __hip_atomic_load(p, __ATOMIC_RELAXED, __HIP_MEMORY_SCOPE_AGENT); }
__device__ __forceinline__ unsigned xb_add(unsigned* p, unsigned v) { return __hip_atomic_fetch_add(p, v, __ATOMIC_RELAXED, __HIP_MEMORY_SCOPE_AGENT); }
__device__ __forceinline__ unsigned xb_xcc_id() { return (unsigned)__builtin_amdgcn_s_getreg((3 << 11) | 20) & 0xFu; }
#define XB_SPIN(cond, bar) do { unsigned _sp = 0; while (cond) { __builtin_amdgcn_s_sleep(1); \
    if ((++_sp & 255u) == 0u) { if (xb_ld(&(bar)[XB_TMO])) break; if (_sp > XB_SPIN_CAP) { atomicAdd(&(bar)[XB_TMO], 1u); break; } } } } while (0)
struct XcdBarrier { unsigned* bar; unsigned x; volatile LAS unsigned* st; };
__device__ __forceinline__ XcdBarrier xcd_barrier_post(unsigned* bar, volatile LAS unsigned* st) {
    XcdBarrier b; b.bar = bar; b.x = xb_xcc_id(); b.st = st;
    if (threadIdx.x == 0) (void)xb_add(&bar[XB_XCNT(b.x)], 1u);
    return b;
}
__device__ __forceinline__ void xcd_barrier_complete(unsigned* bar, unsigned x, unsigned& nloc, unsigned& nx) {
    const unsigned G = gridDim.x * gridDim.y * gridDim.z;
    unsigned sum, cnt, mine, sp = 0u;
    for (;;) {
        sum = 0u; cnt = 0u; mine = 0u;
#pragma unroll
        for (unsigned j = 0; j < 16; ++j) { const unsigned c = xb_ld(&bar[XB_XCNT(j)]); sum += c; cnt += (c > 0u) ? 1u : 0u; mine = (j == x) ? c : mine; }
        if (sum == G) break;
        __builtin_amdgcn_s_sleep(1);
        if ((++sp & 255u) == 0u) { if (xb_ld(&bar[XB_TMO])) break; if (sp > XB_SPIN_CAP) { atomicAdd(&bar[XB_TMO], 1u); break; } }
    }
    nloc = mine > 0u ? mine : 1u; nx = cnt > 0u ? cnt : 1u;
}
__device__ __forceinline__ void xcd_barrier(const XcdBarrier& b) {
    asm volatile("s_waitcnt vmcnt(0)" ::: "memory");
    __syncthreads();
    if (threadIdx.x == 0) {
        unsigned* bar = b.bar;
        __builtin_amdgcn_s_waitcnt(0);
        unsigned nloc = b.st[0], nx = b.st[1];
        if (nloc == 0u) { xcd_barrier_complete(bar, b.x, nloc, nx); b.st[0] = nloc; b.st[1] = nx; }
        const unsigned old = xb_add(&bar[XB_XSUB(b.x)], 1u);
        const unsigned gen = old / nloc;
        if (old + 1u == (gen + 1u) * nloc) {
            __builtin_amdgcn_fence(__ATOMIC_RELEASE, "agent");
            asm volatile("s_waitcnt vmcnt(0)" ::: "memory");
            const unsigned og = xb_add(&bar[XB_TOP], 1u);
            const unsigned tg = og / nx;
            if (og + 1u == (tg + 1u) * nx) xb_add(&bar[XB_TOPGEN], 1u);
            else XB_SPIN(xb_ld(&bar[XB_TOPGEN]) == tg, bar);
            __builtin_amdgcn_fence(__ATOMIC_ACQUIRE, "agent");
            xb_add(&bar[XB_XGEN(b.x)], 1u);
            asm volatile("s_waitcnt vmcnt(0)" ::: "memory");
        } else {
            XB_SPIN(xb_ld(&bar[XB_XGEN(b.x)]) == gen, bar);
            __builtin_amdgcn_fence(__ATOMIC_ACQUIRE, "agent");
            asm volatile("s_waitcnt vmcnt(0)" ::: "memory");
        }
    }
    __syncthreads();
}

namespace pg8 {
constexpr int BM = 256, BK = 64, HALF = 128, HTB = HALF * BK * 2, STAGE_BYTES = 8 * HTB, NXCD = 8, WGM = 4;
__host__ __device__ __forceinline__ int lds_byte(int r, int c) { const int st = (r >> 4) * 2 + (c >> 5), rr = r & 15, cc = c & 31, ob = rr * 64 + cc * 2; return st * 1024 + (ob ^ (((ob >> 9) & 1) << 5)); }
__host__ __device__ __forceinline__ void stage_rc(int b, int& R, int& C) { const int st = b / 1024, sb = b % 1024, swz = sb ^ (((sb >> 9) & 1) << 5); R = (st >> 1) * 16 + swz / 64; C = (st & 1) * 32 + (swz % 64) / 2; }
__host__ __device__ __forceinline__ int perm32(int rho) { const int n = rho >> 4, i = rho & 15; return 8 * (i >> 2) + 4 * n + (i & 3); }

struct Unit { int pm, pn, e, mt, hx; };

struct DenseSched {
    const bf16_t* A; int lda; const bf16_t* Bt; int K; int nM, nN, nwg, G, c;
    static constexpr bool kGather = false;
    __device__ __forceinline__ void init(const bf16_t* A_, int lda_, const bf16_t* Bt_, int K_, int M, int N, int G_, int c_) { A = A_; lda = lda_; Bt = Bt_; K = K_; nM = M / BM; nN = N / BM; nwg = nM * nN; G = G_; c = c_; }
    __device__ __forceinline__ bool next(int i, Unit& u) const {
        const long L = (long)i * G + c; if (L >= nwg) return false;
        int wgid = (int)L; { const int q = nwg / NXCD, r = nwg % NXCD, xcd = wgid % NXCD, off = wgid / NXCD; wgid = (xcd < r ? xcd * (q + 1) : r * (q + 1) + (xcd - r) * q) + off; }
        const int nig = WGM * nN, gid = wgid / nig, fm = gid * WGM, gsz = (nM - fm) < WGM ? (nM - fm) : WGM;
        u.pm = fm + ((wgid % nig) % gsz); u.pn = (wgid % nig) / gsz; u.e = 0; u.mt = u.pm; u.hx = 0; return true;
    }
    __device__ __forceinline__ const char* a_base(const Unit& u) const { return (const char*)A + (size_t)u.pm * BM * lda * 2; }
    __device__ __forceinline__ const char* b_base(const Unit& u) const { return (const char*)Bt + (size_t)u.pn * BM * K * 2; }
    __device__ __forceinline__ void a_offs(const Unit&, const int (&R)[2], const int (&C)[2], unsigned (&off)[2][2]) const {
#pragma unroll
        for (int h = 0; h < 2; ++h)
#pragma unroll
            for (int i = 0; i < 2; ++i) off[h][i] = (unsigned)((h * HALF + R[i]) * lda + C[i]) * 2u;
    }
};
template <bool GATHER, int MODE = 0> struct MoeSched {
    const bf16_t* A; int lda; const bf16_t* Bt; int K; int NB  ; int nN; const LAS int* tstart  ; const LAS int* tall  ; const LAS int* cnt  ; const int* rowtok; LAS unsigned char* aux  ;
    int nwg, G, c; mutable int ecur;
    static constexpr bool kGather = GATHER;
    __device__ __forceinline__ bool next(int i, Unit& u) const {
        const long L = (long)i * G + c; if (L >= nwg) return false;
        int wgid = (int)L; { const int q = nwg / NXCD, r = nwg % NXCD, xcd = wgid % NXCD, off = wgid / NXCD; wgid = (xcd < r ? xcd * (q + 1) : r * (q + 1) + (xcd - r) * q) + off; }
        int e = ecur;
#pragma unroll 1
        while (e < NE - 1 && wgid >= __builtin_amdgcn_readfirstlane(tstart[e + 1]) * nN) ++e;
        ecur = e;
        const int t0 = __builtin_amdgcn_readfirstlane(tstart[e]), t1 = __builtin_amdgcn_readfirstlane(tstart[e + 1]);
        const int local = wgid - t0 * nN, tiles = t1 - t0, idx = local % tiles;
        const int a0 = __builtin_amdgcn_readfirstlane(tall[e]), a1 = __builtin_amdgcn_readfirstlane(tall[e + 1]);
        u.pn = local / tiles; u.e = e;
        if (MODE == 0) { u.mt = idx; u.hx = 0; } else if (MODE == 1) { u.mt = a1 - a0 - 1; u.hx = 0; } else { u.mt = idx >> 1; u.hx = idx & 1; }
        u.pm = a0 + u.mt; return true;
    }
    __device__ __forceinline__ const char* a_base(const Unit& u) const { return GATHER ? (const char*)A : (const char*)A + ((size_t)u.pm * BM + (size_t)u.hx * HALF) * lda * 2; }
    __device__ __forceinline__ const char* b_base(const Unit& u) const { return (const char*)Bt + ((size_t)u.e * NB + (size_t)u.pn * BM) * K * 2; }
    __device__ __forceinline__ void a_tokptrs(const Unit& u, const int (&R)[2], const int* (&gp)[4]) const {
        const int ce = __builtin_amdgcn_readfirstlane(cnt[u.e]);
#pragma unroll
        for (int h = 0; h < 2; ++h)
#pragma unroll
            for (int i = 0; i < 2; ++i) { const int g = u.mt * BM + u.hx * HALF + h * HALF + R[i]; gp[2 * h + i] = rowtok + (size_t)u.e * T + (g < ce ? g : 0); }
    }
    __device__ __forceinline__ void a_offs(const Unit& u, const int (&R)[2], const int (&C)[2], unsigned (&off)[2][2]) const {
        if constexpr (GATHER) {
            const int ce = __builtin_amdgcn_readfirstlane(cnt[u.e]);
#pragma unroll
            for (int h = 0; h < 2; ++h)
#pragma unroll
                for (int i = 0; i < 2; ++i) { const int g = u.mt * BM + u.hx * HALF + h * HALF + R[i]; const int tok = rowtok[u.e * T + (g < ce ? g : 0)] >> 2; off[h][i] = (unsigned)(tok * lda + C[i]) * 2u; }
        } else {
#pragma unroll
            for (int h = 0; h < 2; ++h)
#pragma unroll
                for (int i = 0; i < 2; ++i) off[h][i] = (unsigned)((h * HALF + R[i]) * lda + C[i]) * 2u;
        }
    }
};

__device__ __forceinline__ void glds16(const char* sbase, unsigned voff, unsigned lds_dst) {
    unsigned keep;
    asm volatile("s_mov_b32 %0, m0\n\ts_mov_b32 m0, %3\n\ts_nop 0\n\tglobal_load_lds_dwordx4 %1, %2\n\ts_mov_b32 m0, %0" : "=&s"(keep) : "v"(voff), "s"(sbase), "s"(lds_dst) : "memory");
}
typedef int v8i32 __attribute__((ext_vector_type(8)));
typedef int v4i32 __attribute__((ext_vector_type(4)));
__device__ __forceinline__ v8i32 cat8(bf16x8 a, bf16x8 b) { return __builtin_shufflevector(__builtin_bit_cast(v4i32, a), __builtin_bit_cast(v4i32, b), 0, 1, 2, 3, 4, 5, 6, 7); }
template <int FP8, class Epi, class Sched, int SCW = 127, int SCA = 127, bool RSYNC = false, bool HM = false>
__device__ __forceinline__ void gemm_phase(LAS unsigned char* lds, const Sched& S, const Epi& E, const XcdBarrier* rbar = nullptr) {
    int sclw = SCW * 0x01010101, scla = SCA * 0x01010101; asm volatile("" : "+v"(sclw), "+v"(scla));
    int tid_ = threadIdx.x; asm volatile("" : "+v"(tid_));
    const int tid = tid_, wid = __builtin_amdgcn_readfirstlane(tid >> 6), lane = tid & 63, wr = wid >> 2, wc = wid & 3, fr = lane & 15, fq = lane >> 4;
    const int K = S.K, nt = K / BK;
    unsigned voffB[2];
    { int R[2], C[2];
#pragma unroll
      for (int i = 0; i < 2; ++i) { stage_rc(tid * 16 + i * 8192, R[i], C[i]); voffB[i] = (unsigned)(R[i] * K + C[i]) * 2u; } }
#define PG8_RC() int R[2], C[2]; { int t_ = threadIdx.x; asm volatile("" : "+v"(t_)); _Pragma("unroll") for (int i = 0; i < 2; ++i) stage_rc(t_ * 16 + i * 8192, R[i], C[i]); }
    const size_t kstep = (size_t)(BK * 2);
    const size_t hstepB = (size_t)HALF * K * 2;
    const unsigned ldsbase = (unsigned)__builtin_amdgcn_readfirstlane((int)((unsigned)(size_t)lds + (unsigned)wid * 1024u));
    const int aoff = lds_byte(wr * 64 + fr, fq * 8), boff = lds_byte(wc * 32 + fr, fq * 8);
#define PG8_SA(b, h) (((b) * 2 + (h)) * HTB)
#define PG8_SB(b, h) ((4 + (b) * 2 + (h)) * HTB)
#define PG8_STAGE2(bufoff, gbase, o0, o1) do { glds16((const char*)(gbase), (o0), ldsbase + (unsigned)(bufoff)); glds16((const char*)(gbase), (o1), ldsbase + (unsigned)(bufoff) + 8192u); } while (0)
#define PG8_STAGEB(bufoff, gbase) PG8_STAGE2(bufoff, gbase, voffB[0], voffB[1])
#define PG8_STAGEA(bufoff, gbase, h) PG8_STAGE2(bufoff, gbase, voffA[h][0], voffA[h][1])
#define PG8_STAGEAS(bufoff, gbase, h) PG8_STAGE2(bufoff, gbase, voffA[h][0], voffA[h][1])
#define PG8_LDA(dst, b, h) do { _Pragma("unroll") for (int m = 0; m < 4; ++m) _Pragma("unroll") for (int k = 0; k < 2; ++k) dst[m][k] = *(const LAS bf16x8*)(lds + PG8_SA(b, h) + aoff + m * 2048 + k * 1024); } while (0)
#define PG8_LDB(dst, b, h) do { _Pragma("unroll") for (int n = 0; n < 2; ++n) _Pragma("unroll") for (int k = 0; k < 2; ++k) dst[n][k] = *(const LAS bf16x8*)(lds + PG8_SB(b, h) + boff + n * 2048 + k * 1024); } while (0)
#define PG8_MMA(ai, bj, At, Bt) do { __builtin_amdgcn_s_setprio(1); if constexpr (FP8 == 2) { _Pragma("unroll") for (int m = 0; m < 4; ++m) _Pragma("unroll") for (int n = 0; n < 2; ++n) { \
        const v8i32 wa_ = cat8(Bt[n][0], Bt[n][1]), xa_ = cat8(At[m][0], At[m][1]); \
        asm volatile("s_nop 1\n\tv_mfma_scale_f32_16x16x128_f8f6f4 %0, %1, %2, %0, %3, %4 op_sel_hi:[0,0,0] cbsz:2 blgp:2" : "+v"(acc[ai][bj][m][n]) \
                     : "v"(__builtin_shufflevector(wa_, wa_, 0, 1, 2, 3, 4, 5)), "v"(__builtin_shufflevector(xa_, xa_, 0, 1, 2, 3, 4, 5)), "v"(wa_[6]), "v"(xa_[6])); } } else if constexpr (FP8 == 1) { _Pragma("unroll") for (int m = 0; m < 4; ++m) _Pragma("unroll") for (int n = 0; n < 2; ++n) \
        asm volatile("v_mfma_scale_f32_16x16x128_f8f6f4 %0, %1, %2, %0, %3, %4 op_sel_hi:[0,0,0]" : "+v"(acc[ai][bj][m][n]) : "v"(cat8(Bt[n][0], Bt[n][1])), "v"(cat8(At[m][0], At[m][1])), "v"(sclw), "v"(scla)); } else { \
        _Pragma("unroll") for (int m = 0; m < 4; ++m) _Pragma("unroll") for (int n = 0; n < 2; ++n) _Pragma("unroll") for (int k = 0; k < 2; ++k) \
        acc[ai][bj][m][n] = __builtin_amdgcn_mfma_f32_16x16x32_bf16(Bt[n][k], At[m][k], acc[ai][bj][m][n], 0, 0, 0); } __builtin_amdgcn_s_setprio(0); } while (0)
#define PG8_WAIT_V(n) asm volatile("s_waitcnt vmcnt(" #n ")" ::: "memory")
#define PG8_WAIT_K() do { if constexpr (HM) PG8_WAIT_V(6); else PG8_WAIT_V(8); } while (0)
    constexpr int EST = HM ? Epi::kStoresHM : Epi::kStores;
#define PG8_WAIT_K0() do { if (EST > 0 && t == 0 && ui > 0) asm volatile("s_waitcnt vmcnt(%0)" :: "n"((HM ? 6 : 8) + EST) : "memory"); else PG8_WAIT_K(); } while (0)
#define PG8_WAIT_L(n) asm volatile("s_waitcnt lgkmcnt(" #n ")" ::: "memory")
#define PG8_BAR __builtin_amdgcn_s_barrier()
#define PG8_SCHED __builtin_amdgcn_sched_barrier(0)
    Unit cur, nxt; int ui = 0;
    if (!S.next(0, cur)) return;
    unsigned voffA[2][2];
    { PG8_RC(); S.a_offs(cur, R, C, voffA); }
    f32x4 acc[2][2][4][2];
#pragma unroll
    for (int a = 0; a < 2; ++a)
#pragma unroll
        for (int b = 0; b < 2; ++b)
#pragma unroll
            for (int m = 0; m < 4; ++m)
#pragma unroll
                for (int n = 0; n < 2; ++n) acc[a][b][m][n] = (f32x4){0.f, 0.f, 0.f, 0.f};
    bf16x8 At[4][2], B0[2][2], B1[2][2];
    const char* cA = S.a_base(cur); const char* cB = S.b_base(cur);
    const unsigned bias_lds = (unsigned)__builtin_amdgcn_readfirstlane((int)((unsigned)(size_t)lds + (unsigned)(AUX_OFF + 8192) + (unsigned)wid * 256u));
    if constexpr (Epi::kBiasDMA) { if (lane < 16) glds16(E.bias_base(cur), E.bias_off(cur, wc, lane), bias_lds); }
    const unsigned rowid_lds = (unsigned)__builtin_amdgcn_readfirstlane((int)((unsigned)(size_t)lds + (unsigned)AUX_OFF + (unsigned)wid * 512u));
    if constexpr (Epi::kRowDMA) { if (lane < 32) glds16(E.row_base(cur), E.row_off(cur, wr, lane), rowid_lds); }
    PG8_STAGEB(PG8_SB(0, 0), cB); PG8_STAGEB(PG8_SB(0, 1), cB + hstepB); PG8_STAGEA(PG8_SA(0, 0), cA, 0); if constexpr (!HM) PG8_STAGEA(PG8_SA(0, 1), cA, 1);
    if (wr == 1) PG8_BAR;
    if constexpr (HM) PG8_WAIT_V(0); else PG8_WAIT_V(2);
    PG8_BAR;
    PG8_STAGEB(PG8_SB(1, 0), cB + kstep); PG8_STAGEA(PG8_SA(1, 0), cA + kstep, 0); PG8_STAGEB(PG8_SB(1, 1), cB + hstepB + kstep);
    PG8_WAIT_V(6); PG8_BAR;
    for (;;) {
        const bool has_next = S.next(ui + 1, nxt);
        const char* nA = cA; const char* nB = cB;
        if (has_next) { nA = S.a_base(nxt); nB = S.b_base(nxt); }
        unsigned gtok0 = 0, gtok1 = 0, gtok2 = 0, gtok3 = 0;
        if constexpr (Sched::kGather) {
            if (has_next) { PG8_RC(); const int* gp[4]; S.a_tokptrs(nxt, R, gp);
                asm volatile("global_load_dword %0, %4, off\n\tglobal_load_dword %1, %5, off\n\tglobal_load_dword %2, %6, off\n\tglobal_load_dword %3, %7, off"
                             : "=&v"(gtok0), "=&v"(gtok1), "=&v"(gtok2), "=&v"(gtok3) : "v"(gp[0]), "v"(gp[1]), "v"(gp[2]), "v"(gp[3]) : "memory"); }
        }
        for (int t = 0; t < nt; t += 2) {
            const bool last = (t == nt - 2);
            if constexpr (Sched::kGather) {
                if (t == 2 && has_next) {
                    if constexpr (HM) asm volatile("s_waitcnt vmcnt(12)" : "+v"(gtok0), "+v"(gtok1), "+v"(gtok2), "+v"(gtok3) :: "memory");
                    else asm volatile("s_waitcnt vmcnt(16)" : "+v"(gtok0), "+v"(gtok1), "+v"(gtok2), "+v"(gtok3) :: "memory");
                    PG8_RC(); *(LAS u32x4*)(S.aux + tid * 16) = (u32x4){(unsigned)(((int)gtok0 >> 2) * S.lda + C[0]) * 2u, (unsigned)(((int)gtok1 >> 2) * S.lda + C[1]) * 2u, (unsigned)(((int)gtok2 >> 2) * S.lda + C[0]) * 2u, (unsigned)(((int)gtok3 >> 2) * S.lda + C[1]) * 2u};
                }
            }
            const char* a1 = cA + (size_t)(t + 1) * kstep;
            const char* a2 = last ? nA : cA + (size_t)(t + 2) * kstep; const char* b2 = last ? nB : cB + (size_t)(t + 2) * kstep;
            const char* a3 = a2 + kstep; const char* b3 = b2 + kstep;
            PG8_LDB(B0, 0, 0); PG8_LDB(B1, 0, 1); PG8_SCHED; PG8_LDA(At, 0, 0); if constexpr (!HM) PG8_STAGEA(PG8_SA(1, 1), a1, 1);
            if constexpr (Sched::kGather) { if (last && has_next) { const u32x4 tn = *(const LAS u32x4*)(S.aux + tid * 16); voffA[0][0] = tn.x; voffA[0][1] = tn.y; voffA[1][0] = tn.z; voffA[1][1] = tn.w; } }
            PG8_WAIT_K0(); PG8_WAIT_L(0); PG8_BAR; PG8_MMA(0, 0, At, B0); PG8_MMA(0, 1, At, B1); PG8_BAR; PG8_SCHED;
            if constexpr (!HM) PG8_LDA(At, 0, 1);
            PG8_STAGEB(PG8_SB(0, 0), b2); PG8_STAGEB(PG8_SB(0, 1), b2 + hstepB); PG8_STAGEAS(PG8_SA(0, 0), a2, 0);
            PG8_WAIT_K0(); PG8_WAIT_L(0); PG8_BAR; if constexpr (!HM) { PG8_MMA(1, 0, At, B0); PG8_MMA(1, 1, At, B1); } PG8_BAR; PG8_SCHED;
            PG8_LDB(B0, 1, 0); PG8_LDB(B1, 1, 1); PG8_SCHED; PG8_LDA(At, 1, 0); if constexpr (!HM) PG8_STAGEAS(PG8_SA(0, 1), a2, 1);
            PG8_WAIT_K(); PG8_WAIT_L(0); PG8_BAR; PG8_MMA(0, 0, At, B0); PG8_MMA(0, 1, At, B1); PG8_BAR; PG8_SCHED;
            if constexpr (!HM) PG8_LDA(At, 1, 1);
            PG8_STAGEB(PG8_SB(1, 0), b3); PG8_STAGEB(PG8_SB(1, 1), b3 + hstepB); PG8_STAGEAS(PG8_SA(1, 0), a3, 0);
            PG8_WAIT_K(); PG8_WAIT_L(0); PG8_BAR; if constexpr (!HM) { PG8_MMA(1, 0, At, B0); PG8_MMA(1, 1, At, B1); } PG8_BAR; PG8_SCHED;
        }
        if (wr == 0) PG8_BAR;
        if constexpr (FP8 >= 1) asm volatile("s_nop 15\n\ts_nop 15" ::: "memory");
        if constexpr (Epi::kRowDMA) E(acc, cur, wr, wc, fr, fq, (const LAS float*)(lds + AUX_OFF + 8192 + wid * 256), (const LAS int*)(lds + AUX_OFF + wid * 512), HM ? 1 : 2);
        else if constexpr (Epi::kBiasDMA) E(acc, cur, wr, wc, fr, fq, (const LAS float*)(lds + AUX_OFF + 8192 + wid * 256), HM ? 1 : 2); else E(acc, cur, wr, wc, fr, fq);
        if (!has_next) break;
        if constexpr (RSYNC) xcd_barrier(*rbar);
#pragma unroll
        for (int a = 0; a < 2; ++a)
#pragma unroll
            for (int b = 0; b < 2; ++b)
#pragma unroll
                for (int m = 0; m < 4; ++m)
#pragma unroll
                    for (int n = 0; n < 2; ++n) acc[a][b][m][n] = (f32x4){0.f, 0.f, 0.f, 0.f};
        cur = nxt; cA = nA; cB = nB; ++ui;
        if constexpr (Epi::kBiasDMA) { if (lane < 16) glds16(E.bias_base(cur), E.bias_off(cur, wc, lane), bias_lds); }
        if constexpr (Epi::kRowDMA) { if (lane < 32) glds16(E.row_base(cur), E.row_off(cur, wr, lane), rowid_lds); }
        if (wr == 1) PG8_BAR;
    }
    PG8_WAIT_V(0);
    PG8_BAR;
#undef PG8_SA
#undef PG8_RC
#undef PG8_SB
#undef PG8_STAGE2
#undef PG8_STAGEB
#undef PG8_STAGEA
#undef PG8_STAGEAS
#undef PG8_LDA
#undef PG8_LDB
#undef PG8_MMA
#undef PG8_WAIT_V
#undef PG8_WAIT_K
#undef PG8_WAIT_K0
#undef PG8_WAIT_L
#undef PG8_BAR
#undef PG8_SCHED
}
}

struct Args {
    const float* in[18]; float* out; unsigned char* ws;
    float l2g[8];
    int ph_lo, ph_hi;
};
struct Frame {
    LAS unsigned char* lds;
    int tid, lane, wave, G, vcu;
    unsigned char* ws;
};

enum { CM_NAT = 0, CM_STD = 1, CM_ROPE = 2, CM_SWIGLU = 3, CM_WIN = 4, CM_DN = 5 };
__device__ __forceinline__ int src_col(int mode, int n) {
    if (mode == CM_WIN) mode = (n >= 2048 && n < 4096) ? CM_ROPE : CM_STD;
    if (mode == CM_NAT) return n;
    if (mode == CM_DN) return n;
    if (mode == CM_STD) return (n & ~31) + pg8::perm32(n & 31);
    if (mode == CM_ROPE) { const int p = n & 127, wc = p >> 5, nn = (p >> 4) & 1, i = p & 15; return (n & ~127) + 16 * wc + i + 64 * nn; }
    { const int pn = n >> 8, p = n & 255, bj = p >> 7, g = (p >> 5) & 3, rho = p & 31; return bj * 2048 + 128 * pn + 32 * g + pg8::perm32(rho); }
}
__device__ __forceinline__ int dst_row(int mode, int c) {
    if (mode != CM_DN) return c;
    const int q = c & 255, wc = q >> 6, fq = (q >> 4) & 3, bj = (q >> 3) & 1, nn = (q >> 2) & 1, j = q & 3;
    return (c & ~255) + 128 * bj + 32 * wc + 16 * nn + 4 * fq + j;
}
__device__ __forceinline__ void transpose_item(const float* W, int K, int N, bf16_t* WT, int mode, int item, LAS unsigned* scr, int lane) {
    const int nblk = N / 32, kb = item / nblk, nb = item % nblk, k0 = 64 * kb, n0 = 32 * nb;
    const int g = lane & 7, r = lane >> 3;
    const int sc = src_col(mode, n0 + 4 * g);
    const float* p = W + (size_t)(k0 + 2 * r) * N + sc;
    f32x4 a[4], b[4];
#pragma unroll
    for (int i = 0; i < 4; ++i) { a[i] = *(const f32x4*)(p + (size_t)(16 * i) * N); b[i] = *(const f32x4*)(p + (size_t)(16 * i + 1) * N); }
#pragma unroll
    for (int i = 0; i < 4; ++i)
#pragma unroll
        for (int j = 0; j < 4; ++j) scr[(4 * g + j) * 33 + r + 8 * i] = cvt_pk_bf16(a[i][j], b[i][j]);
    asm volatile("s_waitcnt lgkmcnt(0)" ::: "memory");
    const int c = lane & 7;
#pragma unroll
    for (int ii = 0; ii < 4; ++ii) { const int n = 8 * ii + (lane >> 3); const LAS unsigned* s = scr + n * 33 + 4 * c;
        u32x4 o; o.x = s[0]; o.y = s[1]; o.z = s[2]; o.w = s[3];
        *(u32x4*)(WT + (size_t)(n0 + n) * K + k0 + 8 * c) = o; }
    asm volatile("s_waitcnt lgkmcnt(0)" ::: "memory");
}

typedef float f32x16v __attribute__((ext_vector_type(16)));
typedef unsigned u32x6 __attribute__((ext_vector_type(6)));
#ifndef MK_F6_SCALE_INV
#define MK_F6_SCALE_INV 0
#endif
__device__ __forceinline__ void q6_block(const float (&v)[32], u32x4& lo, u32x4& hi) {
    float amax = 0.f;
#pragma unroll
    for (int t = 0; t < 32; ++t) amax = fmaxf(amax, fabsf(v[t]));
    const unsigned eb = ((__float_as_uint(amax * 0.13333334f) >> 23) & 255u) + 1u;
    const float sc = __uint_as_float(eb << 23);
    f32x16v a, b;
#pragma unroll
    for (int t = 0; t < 16; ++t) { a[t] = v[t]; b[t] = v[16 + t]; }
    const u32x6 q = __builtin_amdgcn_cvt_scalef32_2xpk16_fp6_f32(a, b, MK_F6_SCALE_INV ? __uint_as_float((254u - eb) << 23) : sc);
    lo = (u32x4){q[0], q[1], q[2], q[3]};
    hi = (u32x4){q[4], q[5], eb * 0x01010101u, 0u};
}
__device__ __forceinline__ void t8_load(const float* W, int N, int mode, int item, int lane, f32x4 (&a)[4][4]) {
    const int nblk = N / 32, kb = item / nblk, nb = item % nblk, k0 = 128 * kb, n0 = 32 * nb;
    const int g = lane & 7, r = lane >> 3;
    const float* p = W + (size_t)(k0 + 4 * r) * N + src_col(mode, n0 + 4 * g);
#pragma unroll
    for (int i = 0; i < 4; ++i)
#pragma unroll
        for (int q = 0; q < 4; ++q) a[i][q] = __builtin_nontemporal_load((const f32x4*)(p + (size_t)(32 * i + q) * N));
}
__device__ __forceinline__ void t8_store(const f32x4 (&a)[4][4], int K, int N, unsigned char* WT, int mode, int item, float scale, LAS unsigned* scr, int lane) {
    const int nblk = N / 32, kb = item / nblk, nb = item % nblk, k0 = 128 * kb, n0 = 32 * nb;
    const int g = lane & 7, r = lane >> 3;
#pragma unroll
    for (int i = 0; i < 4; ++i)
#pragma unroll
        for (int j = 0; j < 4; ++j) scr[(4 * g + j) * 33 + r + 8 * i] = pk4_fp8(a[i][0][j] * scale, a[i][1][j] * scale, a[i][2][j] * scale, a[i][3][j] * scale);
    asm volatile("s_waitcnt lgkmcnt(0)" ::: "memory");
    const int c = lane & 7;
#pragma unroll
    for (int ii = 0; ii < 4; ++ii) { const int n = 8 * ii + (lane >> 3); const LAS unsigned* s = scr + n * 33 + 4 * c;
        u32x4 o; o.x = s[0]; o.y = s[1]; o.z = s[2]; o.w = s[3];
        *(u32x4*)(WT + (size_t)dst_row(mode, n0 + n) * K + k0 + 16 * c) = o; }
    asm volatile("s_waitcnt lgkmcnt(0)" ::: "memory");
}
__device__ __forceinline__ void t6_store(const f32x4 (&a)[4][4], int K, int N, unsigned char* WT, int item, LAS float* scr, int lane) {
    const int nblk = N / 32, kbi = item / nblk, nb = item % nblk, k0 = 128 * kbi, n0 = 32 * nb;
    const int g = lane & 7, r = lane >> 3, n = lane & 31, kb = lane >> 5;
    LAS unsigned char* outl = (LAS unsigned char*)(scr + 64 * 36);
#pragma unroll
    for (int h = 0; h < 2; ++h) {
#pragma unroll
        for (int i = 0; i < 2; ++i)
#pragma unroll
            for (int q = 0; q < 4; ++q) *(LAS f32x4*)(scr + (4 * r + 32 * i + q) * 36 + 4 * g) = a[2 * h + i][q];
        asm volatile("s_waitcnt lgkmcnt(0)" ::: "memory");
        float v[32];
#pragma unroll
        for (int t = 0; t < 32; ++t) v[t] = scr[(32 * kb + t) * 36 + n];
        u32x4 lo, hi; q6_block(v, lo, hi);
        *(LAS u32x4*)(outl + n * 144 + 16 * (2 * h + kb)) = lo; *(LAS u32x4*)(outl + n * 144 + 64 + 16 * (2 * h + kb)) = hi;
        asm volatile("s_waitcnt lgkmcnt(0)" ::: "memory");
    }
    const int c = lane & 7;
#pragma unroll
    for (int ii = 0; ii < 4; ++ii) { const int rr = 8 * ii + (lane >> 3);
        const u32x4 o = *(const LAS u32x4*)(outl + rr * 144 + 16 * c);
        *(u32x4*)(WT + (size_t)(n0 + rr) * K + k0 + 16 * c) = o; }
    asm volatile("s_waitcnt lgkmcnt(0)" ::: "memory");
}
template <bool FP6> __device__ __forceinline__ void t8_stream(const float* W, int K, int N, unsigned char* WT, int mode, int items_per_e, int gw, int NGW, LAS unsigned* scr, int lane) {
    const int NIT = NE * items_per_e; const size_t estride = (size_t)K * N;
    f32x4 A[4][4], B[4][4];
#define T8_LD(buf, idx) do { const int i_ = (idx) < NIT ? (idx) : NIT - 1; t8_load(W + (size_t)(i_ / items_per_e) * estride, N, mode, i_ % items_per_e, lane, buf); } while (0)
#define T8_ST(buf, idx) do { if constexpr (FP6) t6_store(buf, K, N, WT + (size_t)((idx) / items_per_e) * estride, (idx) % items_per_e, (LAS float*)scr, lane); else t8_store(buf, K, N, WT + (size_t)((idx) / items_per_e) * estride, mode, (idx) % items_per_e, W8_SCALE, scr, lane); } while (0)
    T8_LD(A, gw);
    for (int it = gw; it < NIT; it += 2 * NGW) {
        T8_LD(B, it + NGW);
        T8_ST(A, it);
        T8_LD(A, it + 2 * NGW);
        if (it + NGW < NIT) T8_ST(B, it + NGW);
    }
#undef T8_LD
#undef T8_ST
}

__device__ __forceinline__ void conv_rest(Frame& F, const Args& a, int gw, int NGW) {
    LAS unsigned* scr = (LAS unsigned*)(F.lds + F.wave * 13824);
    bf16_t* Wpa = (bf16_t*)(F.ws + WS_WPA); bf16_t* Wpr = (bf16_t*)(F.ws + WS_WPR); bf16_t* Wout = (bf16_t*)(F.ws + WS_WOUT);
    unsigned char* Wgu = (unsigned char*)(F.ws + WS_WGU); unsigned char* Wdn = (unsigned char*)(F.ws + WS_WDN);
    constexpr int I_PA = (GW / 64) * (D / 32), I_PR = (D / 64) * (D / 32), I_OUT = I_PR, I_GU1 = (D / 128) * (4096 / 32), I_DN1 = (DFF / 128) * (D / 32);
    constexpr int NITEMS = I_PA + I_PR + I_OUT;
    for (int it = gw; it < NITEMS; it += NGW) {
        int r = it;
        if (r < I_PA) { transpose_item(a.in[7], GW, D, Wpa, CM_STD, r, scr, F.lane); continue; } r -= I_PA;
        if (r < I_PR) { transpose_item(a.in[8], D, D, Wpr, CM_STD, r, scr, F.lane); continue; } r -= I_PR;
        transpose_item(a.in[9], D, D, Wout, CM_NAT, r, scr, F.lane);
    }
    t8_stream<true>(a.in[13], D, 4096, Wgu, CM_SWIGLU, I_GU1, gw, NGW, scr, F.lane);
    t8_stream<false>(a.in[15], DFF, D, Wdn, CM_DN, I_DN1, gw, NGW, scr, F.lane);
}
__device__ __forceinline__ void t16_load(const float* W, int N, int mode, int item, int lane, f32x4 (&a)[4], f32x4 (&b)[4]) {
    const int nblk = N / 32, kb = item / nblk, nb = item % nblk, k0 = 64 * kb, n0 = 32 * nb;
    const int g = lane & 7, r = lane >> 3;
    const float* p = W + (size_t)(k0 + 2 * r) * N + src_col(mode, n0 + 4 * g);
#pragma unroll
    for (int i = 0; i < 4; ++i) { a[i] = __builtin_nontemporal_load((const f32x4*)(p + (size_t)(16 * i) * N)); b[i] = __builtin_nontemporal_load((const f32x4*)(p + (size_t)(16 * i + 1) * N)); }
}
__device__ __forceinline__ void t16_store(const f32x4 (&a)[4], const f32x4 (&b)[4], int K, int N, bf16_t* WT, int item, LAS unsigned* scr, int lane) {
    const int nblk = N / 32, kb = item / nblk, nb = item % nblk, k0 = 64 * kb, n0 = 32 * nb;
    const int g = lane & 7, r = lane >> 3;
#pragma unroll
    for (int i = 0; i < 4; ++i)
#pragma unroll
        for (int j = 0; j < 4; ++j) scr[(4 * g + j) * 33 + r + 8 * i] = cvt_pk_bf16(a[i][j], b[i][j]);
    asm volatile("s_waitcnt lgkmcnt(0)" ::: "memory");
    const int c = lane & 7;
#pragma unroll
    for (int ii = 0; ii < 4; ++ii) { const int n = 8 * ii + (lane >> 3); const LAS unsigned* s = scr + n * 33 + 4 * c;
        u32x4 o; o.x = s[0]; o.y = s[1]; o.z = s[2]; o.w = s[3];
        *(u32x4*)(WT + (size_t)(n0 + n) * K + k0 + 8 * c) = o; }
    asm volatile("s_waitcnt lgkmcnt(0)" ::: "memory");
}
__device__ __forceinline__ void p0_prologue(Frame& F, const Args& a) {
    LAS unsigned* scr = (LAS unsigned*)(F.lds + F.wave * 4352);
    const int gw = F.vcu * NWAVES + F.wave, NGW = F.G * NWAVES;
    bf16_t* Win = (bf16_t*)(F.ws + WS_WIN);
    constexpr int I_IN = (D / 64) * (INW / 32);
    {
        f32x4 A0[4], A1[4], B0[4], B1[4];
        t16_load(a.in[2], INW, CM_WIN, gw < I_IN ? gw : I_IN - 1, F.lane, A0, A1);
        for (int it = gw; it < I_IN; it += 2 * NGW) {
            { const int n1 = it + NGW; t16_load(a.in[2], INW, CM_WIN, n1 < I_IN ? n1 : I_IN - 1, F.lane, B0, B1); }
            t16_store(A0, A1, D, INW, Win, it, scr, F.lane);
            { const int n2 = it + 2 * NGW; t16_load(a.in[2], INW, CM_WIN, n2 < I_IN ? n2 : I_IN - 1, F.lane, A0, A1); }
            if (it + NGW < I_IN) t16_store(B0, B1, D, INW, Win, it + NGW, scr, F.lane);
        }
    }
    const float* x = a.in[0]; const float* g1 = a.in[1]; bf16_t* H = (bf16_t*)(F.ws + WS_H);
    float* rc = (float*)(F.ws + WS_ROPEC); float* rs = (float*)(F.ws + WS_ROPES);
    LAS double* invf = (LAS double*)(F.lds + 40960);
    __syncthreads();
    if (F.tid < 64) invf[F.tid] = exp2(-(double)(2 * F.tid) / 128.0 * 13.287712379549449);
    __syncthreads();
    int ridx = blockIdx.x * NTHREADS + F.tid;
#define ROPE_ENTRY() do { if (ridx < T * 64) { const int pos = ridx >> 6, i_ = ridx & 63; double ang = (double)pos * invf[i_]; const double k_ = rint(ang * 0.15915494309189535); ang = ang - k_ * 6.283185307179586; \
        const float af = (float)ang; rc[ridx] = cosf(af); rs[ridx] = sinf(af); } ridx += F.G * NTHREADS; } while (0)
    {
        f32x4 g1v[8];
#pragma unroll
        for (int j = 0; j < 8; ++j) g1v[j] = ((const f32x4*)g1)[F.lane + 64 * j];
        f32x4 vc[8];
        { const f32x4* xr = (const f32x4*)(x + (size_t)(gw < T ? gw : T - 1) * D) + F.lane;
#pragma unroll
          for (int j = 0; j < 8; ++j) vc[j] = __builtin_nontemporal_load(xr + 64 * j); }
        for (int m = gw; m < T; m += NGW) {
            f32x4 vn[8];
            { const int mn = (m + NGW) < T ? (m + NGW) : T - 1; const f32x4* xr = (const f32x4*)(x + (size_t)mn * D) + F.lane;
#pragma unroll
              for (int j = 0; j < 8; ++j) vn[j] = __builtin_nontemporal_load(xr + 64 * j); }
            float s = 0.f;
#pragma unroll
            for (int j = 0; j < 8; ++j) s += (vc[j].x * vc[j].x + vc[j].y * vc[j].y) + (vc[j].z * vc[j].z + vc[j].w * vc[j].w);
            const float rstd = 1.0f / sqrtf(wave_sum(s) * (1.f / D) + EPS);
            u32x2* o8 = (u32x2*)(H + (size_t)m * D) + F.lane;
#pragma unroll
            for (int j = 0; j < 8; ++j) { const f32x4 g = g1v[j]; u32x2 w; w.x = cvt_pk_bf16(vc[j].x * rstd * g.x, vc[j].y * rstd * g.y); w.y = cvt_pk_bf16(vc[j].z * rstd * g.z, vc[j].w * rstd * g.w); o8[64 * j] = w; }
#pragma unroll
            for (int j = 0; j < 8; ++j) vc[j] = vn[j];
            ROPE_ENTRY();
        }
    }
    while (ridx < T * 64) ROPE_ENTRY();
#undef ROPE_ENTRY
}

typedef f32x4 AccT[2][2][4][2];
struct EpiInProj {
    static constexpr bool kBiasDMA = false; static constexpr bool kRowDMA = false; static constexpr int kStores = 0, kStoresHM = 0;
    unsigned char* ws;
    __device__ __forceinline__ void operator()(const AccT& acc, const pg8::Unit& u, int wr, int wc, int fr, int fq) const {
        const int row0 = u.pm * 256 + wr * 64 + fr; const int pn = u.pn;
        if (pn < 8) {
            bf16_t* dst = (bf16_t*)(ws + (pn < 4 ? WS_U : WS_V)); const int col0 = (pn & 3) * 256 + wc * 32 + 8 * fq;
            float* vstat = (float*)(ws + WS_VSTAT);
#pragma unroll
            for (int ai = 0; ai < 2; ++ai)
#pragma unroll
                for (int m = 0; m < 4; ++m) { const int row = row0 + ai * 128 + m * 16; float s = 0.f, q = 0.f;
#pragma unroll
                    for (int bj = 0; bj < 2; ++bj) { const f32x4 v0 = gelu4(acc[ai][bj][m][0]), v1 = gelu4(acc[ai][bj][m][1]);
                        s += (v0[0] + v0[1]) + (v0[2] + v0[3]) + (v1[0] + v1[1]) + (v1[2] + v1[3]);
                        q += (v0[0] * v0[0] + v0[1] * v0[1]) + (v0[2] * v0[2] + v0[3] * v0[3]) + (v1[0] * v1[0] + v1[1] * v1[1]) + (v1[2] * v1[2] + v1[3] * v1[3]);
                        u32x4 w; w.x = cvt_pk_bf16(v0[0], v0[1]); w.y = cvt_pk_bf16(v0[2], v0[3]); w.z = cvt_pk_bf16(v1[0], v1[1]); w.w = cvt_pk_bf16(v1[2], v1[3]);
                        *(u32x4*)(dst + (size_t)row * GW + col0 + bj * 128) = w; }
                    if (pn >= 4) { s += __shfl_xor(s, 16); s += __shfl_xor(s, 32); q += __shfl_xor(q, 16); q += __shfl_xor(q, 32);
                        if (fq == 0) *(f32x2*)(vstat + (size_t)row * 32 + ((pn - 4) * 4 + wc) * 2) = (f32x2){s, q}; } }
        } else if (pn < 16) {
            bf16_t* dst = (bf16_t*)(ws + (pn < 12 ? WS_Q : WS_K)); const float sc = pn < 12 ? 1.0f : 0.08838834764831845f;
            const float* rc = (const float*)(ws + WS_ROPEC); const float* rs = (const float*)(ws + WS_ROPES);
            const int dd = 16 * wc + 4 * fq;
#pragma unroll
            for (int ai = 0; ai < 2; ++ai) {
                f32x4 cc[4], ss[4];
#pragma unroll
                for (int m = 0; m < 4; ++m) { const int row = row0 + ai * 128 + m * 16; cc[m] = *(const f32x4*)(rc + (size_t)row * 64 + dd); ss[m] = *(const f32x4*)(rs + (size_t)row * 64 + dd); }
#pragma unroll
                for (int m = 0; m < 4; ++m) { const int row = row0 + ai * 128 + m * 16;
                    const f32x4 c = cc[m] * sc, s = ss[m] * sc;
#pragma unroll
                    for (int bj = 0; bj < 2; ++bj) { const f32x4 t1 = acc[ai][bj][m][0], t2 = acc[ai][bj][m][1];
                        const f32x4 o1 = t1 * c - t2 * s, o2 = t2 * c + t1 * s;
                        bf16_t* p = dst + (size_t)row * QKW + (pn & 3) * 256 + bj * 128 + dd;
                        u32x2 w1, w2; w1.x = cvt_pk_bf16(o1[0], o1[1]); w1.y = cvt_pk_bf16(o1[2], o1[3]); w2.x = cvt_pk_bf16(o2[0], o2[1]); w2.y = cvt_pk_bf16(o2[2], o2[3]);
                        if (pn < 12) { __builtin_nontemporal_store(w1, (u32x2*)p); __builtin_nontemporal_store(w2, (u32x2*)(p + 64)); }
                        else { *(u32x2*)p = w1; *(u32x2*)(p + 64) = w2; } } } }
        } else {
            const int kind = (pn - 16) >> 3;
            bf16_t* dst = (bf16_t*)(ws + (kind == 0 ? WS_RV : kind == 1 ? WS_RG : kind == 2 ? WS_GA : WS_GR)); const int col0 = ((pn - 16) & 7) * 256 + wc * 32 + 8 * fq;
#pragma unroll
            for (int ai = 0; ai < 2; ++ai)
#pragma unroll
                for (int m = 0; m < 4; ++m) { const int row = row0 + ai * 128 + m * 16;
#pragma unroll
                    for (int bj = 0; bj < 2; ++bj) { f32x4 v0 = acc[ai][bj][m][0], v1 = acc[ai][bj][m][1];
                        if (kind == 1) {
#pragma unroll
                            for (int j = 0; j < 4; ++j) { v0[j] = v0[j] * sigmoid_f(v0[j]); v1[j] = v1[j] * sigmoid_f(v1[j]); } }
                        else if (kind >= 2) {
#pragma unroll
                            for (int j = 0; j < 4; ++j) { v0[j] = sigmoid_f(v0[j]); v1[j] = sigmoid_f(v1[j]); } }
                        u32x4 w; w.x = cvt_pk_bf16(v0[0], v0[1]); w.y = cvt_pk_bf16(v0[2], v0[3]); w.z = cvt_pk_bf16(v1[0], v1[1]); w.w = cvt_pk_bf16(v1[2], v1[3]);
                        if (kind >= 1) __builtin_nontemporal_store(w, (u32x4*)(dst + (size_t)row * D + col0 + bj * 128));
                        else *(u32x4*)(dst + (size_t)row * D + col0 + bj * 128) = w; } }
        }
    }
};
template <int MODE> struct EpiMerge {
    static constexpr bool kBiasDMA = false; static constexpr bool kRowDMA = false; static constexpr int kStores = 16, kStoresHM = 0;
    unsigned char* ws;
    __device__ __forceinline__ void operator()(const AccT& acc, const pg8::Unit& u, int wr, int wc, int fr, int fq) const {
        const int row0 = u.pm * 256 + wr * 64 + fr, col0 = u.pn * 256 + wc * 32 + 8 * fq;
        const bf16_t* gate = (const bf16_t*)(ws + (MODE == 0 ? WS_GA : WS_GR)); bf16_t* mrg = (bf16_t*)(ws + WS_MRG);
#pragma unroll
        for (int ai = 0; ai < 2; ++ai) {
            u32x4 gg[4][2], pp[4][2];
#pragma unroll
            for (int m = 0; m < 4; ++m)
#pragma unroll
                for (int bj = 0; bj < 2; ++bj) { const size_t ro = (size_t)(row0 + ai * 128 + m * 16) * D + col0 + bj * 128; gg[m][bj] = *(const u32x4*)(gate + ro); if (MODE == 1) pp[m][bj] = *(const u32x4*)(mrg + ro); }
#pragma unroll
            for (int m = 0; m < 4; ++m)
#pragma unroll
                for (int bj = 0; bj < 2; ++bj) { const size_t ro = (size_t)(row0 + ai * 128 + m * 16) * D + col0 + bj * 128; const u32x4 g = gg[m][bj]; const f32x4 v0 = acc[ai][bj][m][0], v1 = acc[ai][bj][m][1];
                    float o[8] = {v0[0] * bf_lo(g.x), v0[1] * bf_hi(g.x), v0[2] * bf_lo(g.y), v0[3] * bf_hi(g.y), v1[0] * bf_lo(g.z), v1[1] * bf_hi(g.z), v1[2] * bf_lo(g.w), v1[3] * bf_hi(g.w)};
                    if (MODE == 1) { const u32x4 p = pp[m][bj];
                        o[0] += bf_lo(p.x); o[1] += bf_hi(p.x); o[2] += bf_lo(p.y); o[3] += bf_hi(p.y); o[4] += bf_lo(p.z); o[5] += bf_hi(p.z); o[6] += bf_lo(p.w); o[7] += bf_hi(p.w); }
                    u32x4 w; w.x = cvt_pk_bf16(o[0], o[1]); w.y = cvt_pk_bf16(o[2], o[3]); w.z = cvt_pk_bf16(o[4], o[5]); w.w = cvt_pk_bf16(o[6], o[7]);
                    *(u32x4*)(mrg + ro) = w; } }
    }
};
struct EpiOut {
    static constexpr bool kBiasDMA = false; static constexpr bool kRowDMA = false; static constexpr int kStores = 32, kStoresHM = 0;
    const float* x; unsigned char* ws;
    __device__ __forceinline__ void operator()(const AccT& acc, const pg8::Unit& u, int wr, int wc, int fr, int fq) const {
        const int row0 = u.pm * 256 + wr * 64 + fr, col0 = u.pn * 256 + wc * 32 + 4 * fq;
        float* x1 = (float*)(ws + WS_X1); float* ss = (float*)(ws + WS_SS);
#pragma unroll
        for (int ai = 0; ai < 2; ++ai) {
            f32x4 xx[4][2][2];
#pragma unroll
            for (int m = 0; m < 4; ++m)
#pragma unroll
                for (int bj = 0; bj < 2; ++bj)
#pragma unroll
                    for (int n = 0; n < 2; ++n) xx[m][bj][n] = *(const f32x4*)(x + (size_t)(row0 + ai * 128 + m * 16) * D + col0 + bj * 128 + n * 16);
#pragma unroll
            for (int m = 0; m < 4; ++m) { const int row = row0 + ai * 128 + m * 16; const size_t ro = (size_t)row * D + col0; float q = 0.f;
#pragma unroll
                for (int bj = 0; bj < 2; ++bj)
#pragma unroll
                    for (int n = 0; n < 2; ++n) { const f32x4 o = xx[m][bj][n] + acc[ai][bj][m][n];
                        q += (o[0] * o[0] + o[1] * o[1]) + (o[2] * o[2] + o[3] * o[3]);
                        *(f32x4*)(x1 + ro + bj * 128 + n * 16) = o; }
                q += __shfl_xor(q, 16); q += __shfl_xor(q, 32);
                if (fq == 0) ss[(size_t)row * 32 + u.pn * 4 + wc] = q; } }
    }
};
struct EpiGateUp {
    static constexpr bool kBiasDMA = true; static constexpr bool kRowDMA = false; static constexpr int kStores = 8, kStoresHM = 4;
    const float* bgu; unsigned char* ws;
    __device__ __forceinline__ const char* bias_base(const pg8::Unit& u) const { return (const char*)(bgu + (size_t)u.e * 4096 + u.pn * 128); }
    __device__ __forceinline__ unsigned bias_off(const pg8::Unit&, int wc, int lane) const { return (unsigned)(((lane >> 3) & 1) * 2048 + wc * 32 + (lane & 7) * 4) * 4u; }
    __device__ __forceinline__ void operator()(const AccT& acc, const pg8::Unit& u, int wr, int wc, int fr, int fq, const LAS float* bl, int nai) const {
        const int row0 = u.pm * 256 + u.hx * 128 + wr * 64 + fr, a0 = u.pn * 128 + wc * 32 + 8 * fq;
        unsigned char* act = (unsigned char*)(ws + WS_ACT);
        const f32x4 bg0 = *(const LAS f32x4*)(bl + 8 * fq), bg1 = *(const LAS f32x4*)(bl + 8 * fq + 4), bu0 = *(const LAS f32x4*)(bl + 32 + 8 * fq), bu1 = *(const LAS f32x4*)(bl + 32 + 8 * fq + 4);
#pragma unroll
        for (int ai = 0; ai < 2; ++ai) if (ai < nai)
#pragma unroll
            for (int m = 0; m < 4; ++m) { const size_t ro = (size_t)(row0 + ai * 128 + m * 16) * DFF + a0; float o[8];
#pragma unroll
                for (int n = 0; n < 2; ++n) {
                    f32x4 g4 = acc[ai][0][m][n] + (n ? bg1 : bg0), u4 = acc[ai][1][m][n] + (n ? bu1 : bu0);
#pragma unroll
                    for (int j = 0; j < 4; ++j) { g4[j] = fminf(g4[j], 7.0f); u4[j] = __builtin_amdgcn_fmed3f(u4[j], -7.0f, 7.0f); }
                    const f32x4 t4 = g4 * (-1.702f * 1.4426950408889634f);
                    f32x4 e4;
#pragma unroll
                    for (int j = 0; j < 4; ++j) e4[j] = __builtin_amdgcn_exp2f(t4[j]);
                    e4 = e4 + 1.0f;
                    f32x4 r4;
#pragma unroll
                    for (int j = 0; j < 4; ++j) r4[j] = __builtin_amdgcn_rcpf(e4[j]);
                    const f32x4 o4 = (u4 * A8_SCALE + A8_SCALE) * (g4 * r4);
#pragma unroll
                    for (int j = 0; j < 4; ++j) o[4 * n + j] = o4[j]; }
                u32x2 w; w.x = pk4_fp8(o[0], o[1], o[2], o[3]); w.y = pk4_fp8(o[4], o[5], o[6], o[7]);
                *(u32x2*)(act + ro) = w; }
    }
};
struct EpiDown {
    static constexpr bool kBiasDMA = true; static constexpr bool kRowDMA = true; static constexpr int kStores = 0, kStoresHM = 0;
    const float* bdn; unsigned char* ws; const LAS int* cnt;
    __device__ __forceinline__ const char* bias_base(const pg8::Unit& u) const { return (const char*)(bdn + (size_t)u.e * D + u.pn * 256); }
    __device__ __forceinline__ unsigned bias_off(const pg8::Unit&, int wc, int lane) const { return (unsigned)(wc * 64 + lane * 4) * 4u; }
    __device__ __forceinline__ const char* row_base(const pg8::Unit& u) const { return (const char*)((const int*)(ws + WS_ROWTOK) + (size_t)u.e * T + u.mt * 256 + u.hx * 128); }
    __device__ __forceinline__ unsigned row_off(const pg8::Unit&, int wr, int lane) const { return (unsigned)(((lane >> 4) & 1) * 128 + wr * 64 + (lane & 15) * 4) * 4u; }
    __device__ __forceinline__ void operator()(const AccT& acc, const pg8::Unit& u, int wr, int wc, int fr, int fq, const LAS float* bl, const LAS int* rid, int nai) const {
        const int col0 = u.pn * 256 + wc * 64 + 16 * fq;
        unsigned char* y = (unsigned char*)(ws + WS_Y);
        const int nvalid = __builtin_amdgcn_readfirstlane(cnt[u.e]) - u.mt * 256;
        f32x4 bv[2][2];
#pragma unroll
        for (int bj = 0; bj < 2; ++bj) { bv[bj][0] = *(const LAS f32x4*)(bl + 16 * fq + 8 * bj) * Y8_SCALE; bv[bj][1] = *(const LAS f32x4*)(bl + 16 * fq + 8 * bj + 4) * Y8_SCALE; }
#pragma unroll
        for (int ai = 0; ai < 2; ++ai) if (ai < nai)
#pragma unroll
            for (int m = 0; m < 4; ++m) { const int rl = u.hx * 128 + ai * 128 + wr * 64 + m * 16 + fr; const int dst = rid[ai * 64 + m * 16 + fr];
                if (rl < nvalid) { const size_t ro = (size_t)dst * D + col0; unsigned wv[4];
#pragma unroll
                    for (int bj = 0; bj < 2; ++bj) { const f32x4 v0 = acc[ai][bj][m][0] * Y8_SCALE + bv[bj][0], v1 = acc[ai][bj][m][1] * Y8_SCALE + bv[bj][1];
                        wv[2 * bj] = pk4_fp8(v0[0], v0[1], v0[2], v0[3]); wv[2 * bj + 1] = pk4_fp8(v1[0], v1[1], v1[2], v1[3]); }
                    *(u32x4*)(y + ro) = (u32x4){wv[0], wv[1], wv[2], wv[3]}; } }
    }
};

__device__ __forceinline__ unsigned off_b(unsigned row, unsigned ch) { return 256u * row + 16u * (ch ^ (((row & 3) << 2) | ((row >> 2) & 3))); }
__device__ __forceinline__ unsigned row_addr16(unsigned lane, unsigned rb, unsigned s) { return off_b((lane & 15) + 16 * rb, 4 * s + (lane >> 4)); }
__device__ __forceinline__ unsigned tr_addr16(unsigned lane, unsigned c, unsigned ks, unsigned t) {
    const unsigned g = lane >> 4, q = (lane & 15) >> 2, p = lane & 3;
    return off_b(32 * ks + 8 * g + 4 * t + q, 2 * c + (p >> 1)) + 8 * (p & 1);
}
__device__ __forceinline__ bf16x8 tr_frag(LAS unsigned char* img, unsigned lane, unsigned c, unsigned ks) {
    const s16x4 a = __builtin_amdgcn_ds_read_tr16_b64_v4i16((LAS s16x4*)(img + tr_addr16(lane, c, ks, 0)));
    const s16x4 b = __builtin_amdgcn_ds_read_tr16_b64_v4i16((LAS s16x4*)(img + tr_addr16(lane, c, ks, 1)));
    return __builtin_shufflevector(a, b, 0, 1, 2, 3, 4, 5, 6, 7);
}
__device__ __forceinline__ bf16x8 row_frag(LAS unsigned char* img, unsigned lane, unsigned rb, unsigned s) { return *(const LAS bf16x8*)(img + row_addr16(lane, rb, s)); }
#define MFMA16(a, b, c) __builtin_amdgcn_mfma_f32_16x16x32_bf16(a, b, c, 0, 0, 0)
__device__ __forceinline__ unsigned row_base(unsigned lane, unsigned s) { return row_addr16(lane, 0, s); }
__device__ __forceinline__ unsigned tr_base(unsigned lane, unsigned c, unsigned t) { return tr_addr16(lane, c, 0, t); }
#define ROWF(img, base, off) (*(const LAS bf16x8*)((img) + (base) + (off)))
__device__ __forceinline__ bf16x8 trf(LAS unsigned char* img, unsigned b0, unsigned b1, unsigned off) {
    const s16x4 a = __builtin_amdgcn_ds_read_tr16_b64_v4i16((LAS s16x4*)(img + b0 + off));
    const s16x4 b = __builtin_amdgcn_ds_read_tr16_b64_v4i16((LAS s16x4*)(img + b1 + off));
    return __builtin_shufflevector(a, b, 0, 1, 2, 3, 4, 5, 6, 7);
}

__device__ __forceinline__ void spatial_unit(Frame& F, const Args& a, int n, int g) {
    LAS unsigned char* Wimg = F.lds; LAS unsigned char* Vimg = F.lds + 32768; LAS float* stats = (LAS float*)(F.lds + 65536);
    const int t0 = n * 128, ch0 = g * 128, tid = F.tid, lane = F.lane, w = F.wave;
    const bf16_t* V = (const bf16_t*)(F.ws + WS_V); const bf16_t* U = (const bf16_t*)(F.ws + WS_U); bf16_t* SG = (bf16_t*)(F.ws + WS_SG);
    const float* vstat = (const float*)(F.ws + WS_VSTAT);
    if (tid < 128) { const f32x4* p = (const f32x4*)(vstat + (size_t)(t0 + tid) * 32); float s = 0.f, q = 0.f;
#pragma unroll
        for (int j = 0; j < 8; ++j) { const f32x4 v = p[j]; s += v[0] + v[2]; q += v[1] + v[3]; }
        const float mean = s * (1.f / GW), var = q * (1.f / GW) - mean * mean;
        stats[2 * tid] = mean; stats[2 * tid + 1] = 1.0f / sqrtf(fmaxf(var, 0.f) + EPS); }
    const float* ws_g = a.in[5] + (size_t)g * 128 * 128;
#pragma unroll
    for (int i = 0; i < 4; ++i) { const int id = tid + 512 * i, t = id >> 4, ch = id & 15;
        const f32x4 x0 = *(const f32x4*)(ws_g + t * 128 + 8 * ch), x1 = *(const f32x4*)(ws_g + t * 128 + 8 * ch + 4);
        float v[8] = {x0[0], x0[1], x0[2], x0[3], x1[0], x1[1], x1[2], x1[3]};
#pragma unroll
        for (int j = 0; j < 8; ++j) v[j] = (8 * ch + j <= t) ? v[j] : 0.f;
        u32x4 o; o.x = cvt_pk_bf16(v[0], v[1]); o.y = cvt_pk_bf16(v[2], v[3]); o.z = cvt_pk_bf16(v[4], v[5]); o.w = cvt_pk_bf16(v[6], v[7]);
        *(LAS u32x4*)(Wimg + off_b(t, ch)) = o; }
    __syncthreads();
    const float* lng = a.in[3]; const float* lnb = a.in[4];
    {
        u32x4 xv[4]; const int ch = tid & 15;
#pragma unroll
        for (int i = 0; i < 4; ++i) xv[i] = __builtin_nontemporal_load((const u32x4*)(V + (size_t)(t0 + (tid >> 4) + 32 * i) * GW + ch0 + 8 * ch));
        const f32x4 g0 = *(const f32x4*)(lng + ch0 + 8 * ch), g1 = *(const f32x4*)(lng + ch0 + 8 * ch + 4), b0 = *(const f32x4*)(lnb + ch0 + 8 * ch), b1 = *(const f32x4*)(lnb + ch0 + 8 * ch + 4);
#pragma unroll
        for (int i = 0; i < 4; ++i) { const int s = (tid >> 4) + 32 * i; const u32x4 x = xv[i];
            const float mean = stats[2 * s], rstd = stats[2 * s + 1];
            float v[8] = {bf_lo(x.x), bf_hi(x.x), bf_lo(x.y), bf_hi(x.y), bf_lo(x.z), bf_hi(x.z), bf_lo(x.w), bf_hi(x.w)};
#pragma unroll
            for (int j = 0; j < 4; ++j) { v[j] = (v[j] - mean) * rstd * g0[j] + b0[j]; v[4 + j] = (v[4 + j] - mean) * rstd * g1[j] + b1[j]; }
            u32x4 o; o.x = cvt_pk_bf16(v[0], v[1]); o.y = cvt_pk_bf16(v[2], v[3]); o.z = cvt_pk_bf16(v[4], v[5]); o.w = cvt_pk_bf16(v[6], v[7]);
            *(LAS u32x4*)(Vimg + off_b(s, ch)) = o; }
    }
    __syncthreads();
    f32x4 acc[8];
#pragma unroll
    for (int c = 0; c < 8; ++c) acc[c] = (f32x4){0.f, 0.f, 0.f, 0.f};
    const int ksmax = w >> 1;
    {
        unsigned vb[8][2];
#pragma unroll
        for (int c = 0; c < 8; ++c) { vb[c][0] = tr_base(lane, c, 0); vb[c][1] = tr_base(lane, c, 1); }
        LAS unsigned char* Wrow = Wimg + 4096 * w;
#pragma unroll
        for (int ks = 0; ks < 4; ++ks) if (ks <= ksmax) {
            const bf16x8 y = ROWF(Wrow, row_base(lane, ks), 0);
            bf16x8 xf[8];
#pragma unroll
            for (int c = 0; c < 8; ++c) xf[c] = trf(Vimg, vb[c][0], vb[c][1], 8192 * ks);
            __builtin_amdgcn_sched_barrier(0);
#pragma unroll
            for (int c = 0; c < 8; ++c) acc[c] = MFMA16(xf[c], y, acc[c]);
            __builtin_amdgcn_sched_barrier(0);
        }
    }
    {
        LAS unsigned char* MT = F.lds + 66560;
        const int t = 16 * w + (lane & 15); const float bias = a.in[6][g * 128 + t];
#pragma unroll
        for (int c = 0; c < 8; ++c) *(LAS f32x4*)(MT + t * 528 + (16 * c + 4 * (lane >> 4)) * 4) = acc[c] + bias;
        __syncthreads();
        u32x4 uu[4];
#pragma unroll
        for (int i = 0; i < 4; ++i) uu[i] = __builtin_nontemporal_load((const u32x4*)(U + (size_t)(t0 + (tid >> 4) + 32 * i) * GW + ch0 + 8 * (tid & 15)));
#pragma unroll
        for (int i = 0; i < 4; ++i) { const int tt = (tid >> 4) + 32 * i, ch = tid & 15;
            const f32x4 m0 = *(const LAS f32x4*)(MT + tt * 528 + ch * 32), m1 = *(const LAS f32x4*)(MT + tt * 528 + ch * 32 + 16);
            const u32x4 u4 = uu[i];
            u32x4 r; r.x = cvt_pk_bf16(bf_lo(u4.x) * m0[0], bf_hi(u4.x) * m0[1]); r.y = cvt_pk_bf16(bf_lo(u4.y) * m0[2], bf_hi(u4.y) * m0[3]);
            r.z = cvt_pk_bf16(bf_lo(u4.z) * m1[0], bf_hi(u4.z) * m1[1]); r.w = cvt_pk_bf16(bf_lo(u4.w) * m1[2], bf_hi(u4.w) * m1[3]);
            *(u32x4*)(SG + (size_t)(t0 + tt) * GW + ch0 + 8 * ch) = r; }
    }
    __syncthreads();
}

__device__ __forceinline__ void kv_unit(Frame& F, const Args& a, int c, int h) {
    LAS unsigned char* Kimg = F.lds; LAS unsigned char* Vimg = F.lds + 32768;
    const int t0 = c * 128, tid = F.tid, lane = F.lane, w = F.wave;
    const bf16_t* Kb = (const bf16_t*)(F.ws + WS_K); const bf16_t* RV = (const bf16_t*)(F.ws + WS_RV); float* KV = (float*)(F.ws + WS_KV);
    const float l2g = a.l2g[h];
    {
        u32x4 kx[4], vx[8];
#pragma unroll
        for (int i = 0; i < 4; ++i) kx[i] = *(const u32x4*)(Kb + (size_t)(t0 + (tid >> 4) + 32 * i) * QKW + h * 128 + 8 * (tid & 15));
#pragma unroll
        for (int i = 0; i < 8; ++i) vx[i] = *(const u32x4*)(RV + (size_t)(t0 + (tid >> 5) + 16 * i) * D + h * 256 + 8 * (tid & 31));
#pragma unroll
        for (int i = 0; i < 4; ++i) *(LAS u32x4*)(Kimg + off_b((tid >> 4) + 32 * i, tid & 15)) = kx[i];
#pragma unroll
        for (int i = 0; i < 8; ++i) { const int s = (tid >> 5) + 16 * i, ch = tid & 31; const u32x4 x = vx[i]; const float z = exp2f((float)(127 - s) * l2g);
            u32x4 o; o.x = cvt_pk_bf16(bf_lo(x.x) * z, bf_hi(x.x) * z); o.y = cvt_pk_bf16(bf_lo(x.y) * z, bf_hi(x.y) * z); o.z = cvt_pk_bf16(bf_lo(x.z) * z, bf_hi(x.z) * z); o.w = cvt_pk_bf16(bf_lo(x.w) * z, bf_hi(x.w) * z);
            *(LAS u32x4*)(Vimg + (ch >> 4) * 32768 + off_b(s, ch & 15)) = o; }
    }
    __syncthreads();
    f32x4 acc[2][8];
#pragma unroll
    for (int j = 0; j < 2; ++j)
#pragma unroll
        for (int cd = 0; cd < 8; ++cd) acc[j][cd] = (f32x4){0.f, 0.f, 0.f, 0.f};
    LAS unsigned char* vi = Vimg + (w >> 2) * 32768; const int cimg = (2 * w) & 7;
    {
        unsigned kb[8][2], vb[2][2];
#pragma unroll
        for (int cd = 0; cd < 8; ++cd) { kb[cd][0] = tr_base(lane, cd, 0); kb[cd][1] = tr_base(lane, cd, 1); }
#pragma unroll
        for (int j = 0; j < 2; ++j) { vb[j][0] = tr_base(lane, cimg + j, 0); vb[j][1] = tr_base(lane, cimg + j, 1); }
#pragma unroll
        for (int ks = 0; ks < 4; ++ks) {
            const bf16x8 y0 = trf(vi, vb[0][0], vb[0][1], 8192 * ks), y1 = trf(vi, vb[1][0], vb[1][1], 8192 * ks);
            bf16x8 xf[8];
#pragma unroll
            for (int cd = 0; cd < 8; ++cd) xf[cd] = trf(Kimg, kb[cd][0], kb[cd][1], 8192 * ks);
            __builtin_amdgcn_sched_barrier(0);
#pragma unroll
            for (int cd = 0; cd < 8; ++cd) { acc[0][cd] = MFMA16(xf[cd], y0, acc[0][cd]); acc[1][cd] = MFMA16(xf[cd], y1, acc[1][cd]); }
            __builtin_amdgcn_sched_barrier(0);
        }
    }
    bf16_t* out = (bf16_t*)KV + (size_t)(c * 8 + h) * 32768;
    __syncthreads();
    LAS unsigned char* KT = F.lds;
#pragma unroll
    for (int j = 0; j < 2; ++j)
#pragma unroll
        for (int cd = 0; cd < 8; ++cd) { const int e = 16 * (2 * w + j) + (lane & 15), d = 16 * cd + 4 * (lane >> 4);
            u32x2 o; o.x = cvt_pk_bf16(acc[j][cd][0], acc[j][cd][1]); o.y = cvt_pk_bf16(acc[j][cd][2], acc[j][cd][3]); *(LAS u32x2*)(KT + e * 272 + d * 2) = o; }
    __syncthreads();
#pragma unroll
    for (int i = 0; i < 8; ++i) { const int id = tid + 512 * i, e = id >> 4, ch = id & 15;
        *(u32x4*)(out + e * 128 + 8 * ch) = *(const LAS u32x4*)(KT + e * 272 + 16 * ch); }
    __syncthreads();
}

__device__ __forceinline__ void scan_phase(Frame& F, const Args& a, int bi, int nb) {
    const unsigned* KV = (const unsigned*)(F.ws + WS_KV); unsigned* ST = (unsigned*)(F.ws + WS_ST);
    for (int pb = bi * NTHREADS; pb < 131072; pb += nb * NTHREADS) {
        const int h = __builtin_amdgcn_readfirstlane(pb >> 14); const unsigned qo = (unsigned)(pb & 16383) + (unsigned)F.tid; const float dh = exp2f(128.0f * a.l2g[h]);
        const unsigned* kvb = KV + (size_t)h * 16384; unsigned* stb = ST + (size_t)h * 16384;
        float s0 = 0.f, s1 = 0.f;
        {
            unsigned kv[NCHUNK];
#pragma unroll
            for (int j = 0; j < NCHUNK; ++j) kv[j] = __builtin_nontemporal_load(kvb + (size_t)j * 131072 + qo);
#pragma unroll
            for (int j = 0; j < NCHUNK; ++j) { (stb + (size_t)j * 131072)[qo] = cvt_pk_bf16(s0, s1); s0 = s0 * dh + bf_lo(kv[j]); s1 = s1 * dh + bf_hi(kv[j]); }
        }
    }
}

__device__ __forceinline__ void ret_unit(Frame& F, const Args& a, int c, int h) {
    LAS unsigned char* Qimg = F.lds; LAS unsigned char* Kimg = F.lds + 32768; LAS unsigned char* Vimg = F.lds + 65536;
    LAS float* part = (LAS float*)(F.lds + AUX_OFF); LAS float* stats = (LAS float*)(F.lds + AUX_OFF + 8192);
    const int t0 = c * 128, tid = F.tid, lane = F.lane, w = F.wave;
    const bf16_t* Qb = (const bf16_t*)(F.ws + WS_Q); const bf16_t* Kb = (const bf16_t*)(F.ws + WS_K); const bf16_t* RV = (const bf16_t*)(F.ws + WS_RV);
    const bf16_t* RG = (const bf16_t*)(F.ws + WS_RG); const bf16_t* ST = (const bf16_t*)(F.ws + WS_ST); bf16_t* RO = (bf16_t*)(F.ws + WS_RO);
    const float l2g = a.l2g[h];
    bf16x8 stf[2][4];
#pragma unroll
    for (int j = 0; j < 2; ++j)
#pragma unroll
        for (int ks = 0; ks < 4; ++ks) stf[j][ks] = __builtin_nontemporal_load((const bf16x8*)(ST + (size_t)(c * 8 + h) * 32768 + (16 * (2 * w + j) + (lane & 15)) * 128 + 32 * ks + 8 * (lane >> 4)));
    {
        u32x4 qx[4], kx[4], vx[8];
#pragma unroll
        for (int i = 0; i < 4; ++i) { const size_t o = (size_t)(t0 + (tid >> 4) + 32 * i) * QKW + h * 128 + 8 * (tid & 15); qx[i] = __builtin_nontemporal_load((const u32x4*)(Qb + o)); kx[i] = __builtin_nontemporal_load((const u32x4*)(Kb + o)); }
#pragma unroll
        for (int i = 0; i < 8; ++i) vx[i] = __builtin_nontemporal_load((const u32x4*)(RV + (size_t)(t0 + (tid >> 5) + 16 * i) * D + h * 256 + 8 * (tid & 31)));
#pragma unroll
        for (int i = 0; i < 4; ++i) { const unsigned o = off_b((tid >> 4) + 32 * i, tid & 15); *(LAS u32x4*)(Qimg + o) = qx[i]; *(LAS u32x4*)(Kimg + o) = kx[i]; }
#pragma unroll
        for (int i = 0; i < 8; ++i) *(LAS u32x4*)(Vimg + ((tid & 31) >> 4) * 32768 + off_b((tid >> 5) + 16 * i, tid & 15)) = vx[i];
    }
    __syncthreads();
    u32x2 pk[8];
    const int csmax = (w | 1);
    unsigned rb4[4];
#pragma unroll
    for (int ks = 0; ks < 4; ++ks) rb4[ks] = row_base(lane, ks);
    {
        bf16x8 yq[4];
#pragma unroll
        for (int ks = 0; ks < 4; ++ks) yq[ks] = ROWF(Qimg + 4096 * w, rb4[ks], 0);
        const int tt = 16 * w + (lane & 15);
#pragma unroll
        for (int cs = 0; cs < 8; ++cs) {
            pk[cs] = (u32x2){0u, 0u};
            if (cs <= csmax) {
                f32x4 sacc = (f32x4){0.f, 0.f, 0.f, 0.f};
                bf16x8 kf[4];
#pragma unroll
                for (int ks = 0; ks < 4; ++ks) kf[ks] = ROWF(Kimg, rb4[ks], 4096 * cs);
                __builtin_amdgcn_sched_barrier(0);
#pragma unroll
                for (int ks = 0; ks < 4; ++ks) sacc = MFMA16(kf[ks], yq[ks], sacc);
                float v[4];
#pragma unroll
                for (int r = 0; r < 4; ++r) { const int ss = 16 * cs + 4 * (lane >> 4) + r; v[r] = (tt >= ss) ? sacc[r] * exp2f((float)(tt - ss) * l2g) : 0.f; }
                pk[cs].x = cvt_pk_bf16(v[0], v[1]); pk[cs].y = cvt_pk_bf16(v[2], v[3]);
            }
        }
    }
    f32x4 acc[2][8];
#pragma unroll
    for (int j = 0; j < 2; ++j)
#pragma unroll
        for (int ct = 0; ct < 8; ++ct) acc[j][ct] = (f32x4){0.f, 0.f, 0.f, 0.f};
#pragma unroll
    for (int ct = 0; ct < 8; ++ct) {
        bf16x8 yy[4];
#pragma unroll
        for (int ks = 0; ks < 4; ++ks) yy[ks] = ROWF(Qimg, rb4[ks], 4096 * ct);
        __builtin_amdgcn_sched_barrier(0);
#pragma unroll
        for (int ks = 0; ks < 4; ++ks) { acc[0][ct] = MFMA16(stf[0][ks], yy[ks], acc[0][ct]); acc[1][ct] = MFMA16(stf[1][ks], yy[ks], acc[1][ct]); }
        const float xi = exp2f((float)(16 * ct + (lane & 15) + 1) * l2g);
        acc[0][ct] *= xi; acc[1][ct] *= xi;
        __builtin_amdgcn_sched_barrier(0);
    }
    __syncthreads();
    LAS unsigned char* Pimg = Kimg;
    {
        const int tt = 16 * w + (lane & 15);
#pragma unroll
        for (int cs = 0; cs < 8; ++cs) if (cs <= csmax) *(LAS u32x2*)(Pimg + off_b(tt, 2 * cs + (lane >> 5)) + 8 * ((lane >> 4) & 1)) = pk[cs];
    }
    __syncthreads();
    {
        LAS unsigned char* vi = Vimg + (w >> 2) * 32768; const int cimg = (2 * w) & 7;
        unsigned vb[2][2];
#pragma unroll
        for (int j = 0; j < 2; ++j) { vb[j][0] = tr_base(lane, cimg + j, 0); vb[j][1] = tr_base(lane, cimg + j, 1); }
        bf16x8 xv[2][4];
#pragma unroll
        for (int ks = 0; ks < 4; ++ks) { xv[0][ks] = trf(vi, vb[0][0], vb[0][1], 8192 * ks); xv[1][ks] = trf(vi, vb[1][0], vb[1][1], 8192 * ks); }
#pragma unroll
        for (int ct = 0; ct < 8; ++ct) {
            bf16x8 yy[4];
#pragma unroll
            for (int ks = 0; ks < 4; ++ks) if (ks <= (ct >> 1)) yy[ks] = ROWF(Pimg, rb4[ks], 4096 * ct);
            __builtin_amdgcn_sched_barrier(0);
#pragma unroll
            for (int ks = 0; ks < 4; ++ks) if (ks <= (ct >> 1)) { acc[0][ct] = MFMA16(xv[0][ks], yy[ks], acc[0][ct]); acc[1][ct] = MFMA16(xv[1][ks], yy[ks], acc[1][ct]); }
            __builtin_amdgcn_sched_barrier(0);
        }
    }
    {
        float s8[8], q8[8];
#pragma unroll
        for (int ct = 0; ct < 8; ++ct) { float s = 0.f, q = 0.f;
#pragma unroll
            for (int j = 0; j < 2; ++j)
#pragma unroll
                for (int r = 0; r < 4; ++r) { const float v = acc[j][ct][r]; s += v; q += v * v; }
            s8[ct] = s; q8[ct] = q; }
        float s16[8], q16[8];
#pragma unroll
        for (int ct = 0; ct < 8; ++ct) { s16[ct] = __shfl_xor(s8[ct], 16); q16[ct] = __shfl_xor(q8[ct], 16); }
        __builtin_amdgcn_sched_barrier(0);
#pragma unroll
        for (int ct = 0; ct < 8; ++ct) { s8[ct] += s16[ct]; q8[ct] += q16[ct]; }
#pragma unroll
        for (int ct = 0; ct < 8; ++ct) { s16[ct] = __shfl_xor(s8[ct], 32); q16[ct] = __shfl_xor(q8[ct], 32); }
        __builtin_amdgcn_sched_barrier(0);
#pragma unroll
        for (int ct = 0; ct < 8; ++ct) { const float s = s8[ct] + s16[ct], q = q8[ct] + q16[ct];
            if ((lane >> 4) == 0) { part[((16 * ct + lane) * 8 + w) * 2] = s; part[((16 * ct + lane) * 8 + w) * 2 + 1] = q; } }
    }
    __syncthreads();
    if (tid < 128) { float s = 0.f, q = 0.f;
#pragma unroll
        for (int j = 0; j < 8; ++j) { s += part[(tid * 8 + j) * 2]; q += part[(tid * 8 + j) * 2 + 1]; }
        const float mean = s * (1.f / 256.f), var = q * (1.f / 256.f) - mean * mean;
        stats[2 * tid] = mean; stats[2 * tid + 1] = 1.0f / sqrtf(fmaxf(var, 0.f) + EPS); }
    __syncthreads();
    {
        LAS unsigned char* OT = F.lds;
#pragma unroll
        for (int ct = 0; ct < 8; ++ct) { const int tt = 16 * ct + (lane & 15); const float mean = stats[2 * tt], rstd = stats[2 * tt + 1];
#pragma unroll
            for (int j = 0; j < 2; ++j) { const f32x4 v = (acc[j][ct] - mean) * rstd; u32x2 r; r.x = cvt_pk_bf16(v[0], v[1]); r.y = cvt_pk_bf16(v[2], v[3]);
                *(LAS u32x2*)(OT + tt * 528 + (16 * (2 * w + j) + 4 * (lane >> 4)) * 2) = r; } }
        __syncthreads();
        u32x4 gx[8];
#pragma unroll
        for (int i = 0; i < 8; ++i) gx[i] = __builtin_nontemporal_load((const u32x4*)(RG + (size_t)(t0 + (tid >> 5) + 16 * i) * D + h * 256 + 8 * (tid & 31)));
#pragma unroll
        for (int i = 0; i < 8; ++i) { const int tt = (tid >> 5) + 16 * i, ch = tid & 31;
            const u32x4 v = *(const LAS u32x4*)(OT + tt * 528 + ch * 16); const u32x4 g = gx[i];
            u32x4 r; r.x = cvt_pk_bf16(bf_lo(v.x) * bf_lo(g.x), bf_hi(v.x) * bf_hi(g.x)); r.y = cvt_pk_bf16(bf_lo(v.y) * bf_lo(g.y), bf_hi(v.y) * bf_hi(g.y));
            r.z = cvt_pk_bf16(bf_lo(v.z) * bf_lo(g.z), bf_hi(v.z) * bf_hi(g.z)); r.w = cvt_pk_bf16(bf_lo(v.w) * bf_lo(g.w), bf_hi(v.w) * bf_hi(g.w));
            *(u32x4*)(RO + (size_t)(t0 + tt) * D + h * 256 + 8 * ch) = r; }
    }
    __syncthreads();
}

__device__ __forceinline__ void router_tile(Frame& F, const Args& a, int tile) {
    LAS float* part = (LAS float*)F.lds;
    LAS int* cntl = (LAS int*)(F.lds + 40960); LAS int* basel = cntl + 32;
    const int tid = F.tid, lane = F.lane, w = F.wave, ts = w & 1, kq = w >> 1, i = lane & 31, kh = lane >> 5;
    const int tok = tile * 64 + 32 * ts + i;
    const float* X1 = (const float*)(F.ws + WS_X1); const float* SS = (const float*)(F.ws + WS_SS); unsigned char* H2 = (unsigned char*)(F.ws + WS_H);
    const float* g2 = a.in[10]; const float* rw = a.in[11]; const float* rb = a.in[12];
    if (tid < 32) cntl[tid] = 0;
    float ssum = 0.f;
#pragma unroll
    for (int j = 0; j < 8; ++j) { const f32x4 v = *(const f32x4*)(SS + (size_t)tok * 32 + 4 * j); ssum += (v[0] + v[1]) + (v[2] + v[3]); }
    const float rstd = 1.0f / sqrtf(ssum * (1.f / D) + EPS);
    f32x16 acc;
#pragma unroll
    for (int r = 0; r < 16; ++r) acc[r] = 0.f;
    LAS float* rwl = (LAS float*)(F.lds + 49152); LAS float* g2l = (LAS float*)(F.lds + 114688);
    { const f32x4 gv = *(const f32x4*)(g2 + 4 * tid); *(LAS f32x4*)(g2l + 4 * tid) = gv; }
    const unsigned rwl_u = (unsigned)__builtin_amdgcn_readfirstlane((int)((unsigned)(size_t)rwl + (unsigned)(kq * 8192 + ts * 4096)));
#define RW_STAGE(p_) do { const char* src_ = (const char*)(rw + (size_t)(512 * kq + 64 * (p_) + 32 * ts) * NE); const unsigned dst_ = rwl_u + (unsigned)(((p_) & 1) * 32768); \
        _Pragma("unroll") for (int j = 0; j < 4; ++j) pg8::glds16(src_, (unsigned)(lane * 16 + j * 1024), dst_ + (unsigned)(j * 1024)); } while (0)
    RW_STAGE(0);
    asm volatile("s_waitcnt vmcnt(0)" ::: "memory");
    {
        f32x4 xc[4]; float avp[16];
#pragma unroll
        for (int q = 0; q < 16; ++q) avp[q] = 0.f;
#define RT_LOAD(sc_, X) do { const int kb_ = 512 * kq + 64 * ((sc_) >> 1) + 32 * kh + 16 * ((sc_) & 1); \
            _Pragma("unroll") for (int q = 0; q < 4; ++q) X[q] = *(const f32x4*)(X1 + (size_t)tok * D + kb_ + 4 * q); } while (0)
        RT_LOAD(0, xc);
#pragma unroll 1
        for (int sc = 0; sc < 16; ++sc) {
            if ((sc & 1) == 0) {
                asm volatile("s_waitcnt lgkmcnt(0)" ::: "memory"); __builtin_amdgcn_s_barrier(); asm volatile("" ::: "memory");
                if (sc < 14) RW_STAGE((sc >> 1) + 1); }
            const int kb = 512 * kq + 64 * (sc >> 1) + 32 * kh + 16 * (sc & 1);
            f32x4 xn[4];
            { const int sn = sc < 15 ? sc + 1 : 15; RT_LOAD(sn, xn); }
            f32x4 gc[4]; float bc[16];
#pragma unroll
            for (int q = 0; q < 4; ++q) gc[q] = *(const LAS f32x4*)(g2l + kb + 4 * q);
            { const LAS float* rwb = rwl + ((sc >> 1) & 1) * 8192 + kq * 2048 + (32 * kh + 16 * (sc & 1)) * 32 + i;
#pragma unroll
              for (int q = 0; q < 16; ++q) bc[q] = rwb[q * 32]; }
            float av[16];
#pragma unroll
            for (int q = 0; q < 4; ++q) { av[4 * q] = xc[q][0] * rstd * gc[q][0]; av[4 * q + 1] = xc[q][1] * rstd * gc[q][1]; av[4 * q + 2] = xc[q][2] * rstd * gc[q][2]; av[4 * q + 3] = xc[q][3] * rstd * gc[q][3]; }
            if (sc & 1) {
                float v32[32];
#pragma unroll
                for (int q = 0; q < 16; ++q) { v32[q] = avp[q]; v32[16 + q] = av[q]; }
                u32x4 lo, hi; q6_block(v32, lo, hi);
                const int k0 = kb - 16, b32 = k0 >> 5;
                unsigned char* base = H2 + (size_t)tok * D + 128 * (b32 >> 2) + 16 * (b32 & 3);
                *(u32x4*)base = lo; *(u32x4*)(base + 64) = hi;
            }
#pragma unroll
            for (int q = 0; q < 16; ++q) avp[q] = av[q];
#pragma unroll
            for (int q = 0; q < 16; ++q) acc = __builtin_amdgcn_mfma_f32_32x32x2f32(av[q], bc[q], acc, 0, 0, 0);
#pragma unroll
            for (int q = 0; q < 4; ++q) xc[q] = xn[q];
        }
#undef RT_LOAD
#undef RW_STAGE
    }
#pragma unroll
    for (int r = 0; r < 16; ++r) { const int row = (r & 3) + 8 * (r >> 2) + 4 * kh; part[((kq * 2 + ts) * 32 + row) * 33 + i] = acc[r]; }
    __syncthreads();
    int te[4] = {0, 0, 0, 0}; float tv[4] = {-3.0e38f, -3.0e38f, -3.0e38f, -3.0e38f}; int lr[4] = {0, 0, 0, 0};
    if (tid < 64) {
        const int tsl = tid >> 5, rowl = tid & 31;
        for (int e = 0; e < NE; ++e) {
            float lg = rb[e];
#pragma unroll
            for (int q = 0; q < 4; ++q) lg += part[((q * 2 + tsl) * 32 + rowl) * 33 + e];
            if (lg > tv[3]) { tv[3] = lg; te[3] = e;
#pragma unroll
                for (int j = 3; j > 0; --j) if (tv[j] > tv[j - 1]) { const float fv = tv[j]; tv[j] = tv[j - 1]; tv[j - 1] = fv; const int iv = te[j]; te[j] = te[j - 1]; te[j - 1] = iv; } }
        }
#pragma unroll
        for (int k = 0; k < 4; ++k) lr[k] = __hip_atomic_fetch_add(&cntl[te[k]], 1, __ATOMIC_RELAXED, __HIP_MEMORY_SCOPE_WORKGROUP);
    }
    __syncthreads();
    if (tid < 32) { const int cn = cntl[tid]; int base = 0; if (cn > 0) base = (int)__hip_atomic_fetch_add((unsigned*)(F.ws + WS_CTL) + CW_CNT + 16 * tid, (unsigned)cn, __ATOMIC_RELAXED, __HIP_MEMORY_SCOPE_AGENT); basel[tid] = base; }
    __syncthreads();
    if (tid < 64) {
        const int t = tile * 64 + tid;
        int* TOKE = (int*)(F.ws + WS_TOKE); int* TOKR = (int*)(F.ws + WS_TOKR); float* TOKW = (float*)(F.ws + WS_TOKW); int* ROWTOK = (int*)(F.ws + WS_ROWTOK);
        float ex[4], sum = 0.f;
#pragma unroll
        for (int k = 0; k < 4; ++k) { ex[k] = __expf(tv[k] - tv[0]); sum += ex[k]; }
        const float inv = 1.0f / sum;
#pragma unroll
        for (int k = 0; k < 4; ++k) { const int rank = basel[te[k]] + lr[k]; TOKE[t * 4 + k] = te[k]; TOKR[t * 4 + k] = rank; TOKW[t * 4 + k] = ex[k] * inv; ROWTOK[te[k] * T + rank] = t * 4 + k; }
    }
    __syncthreads();
}

__device__ __forceinline__ void moe_table(Frame& F, LAS int* cnt, LAS int* tall, LAS int* tfull, LAS int* tsmall, LAS int* thalf) {
    if (F.tid < 64) {
        const int e = F.lane; int c = 0;
        if (e < NE) c = (int)__hip_atomic_load((unsigned*)(F.ws + WS_CTL) + CW_CNT + 16 * e, __ATOMIC_RELAXED, __HIP_MEMORY_SCOPE_AGENT);
        const int tl = (c + 255) >> 8; const int rem = c - 256 * (tl - 1); const int sm = (MK_HM && tl > 0 && rem <= 128) ? 1 : 0;
        int ia = tl, is = sm;
#pragma unroll
        for (int o = 1; o < 32; o <<= 1) { const int va = __shfl_up(ia, o), vs = __shfl_up(is, o); if ((F.lane & 31) >= o) { ia += va; is += vs; } }
        if (e < NE) { cnt[e] = c; tall[e + 1] = ia; tsmall[e + 1] = is; tfull[e + 1] = ia - is; thalf[e + 1] = 2 * ia; }
        if (e == 0) { tall[0] = 0; tsmall[0] = 0; tfull[0] = 0; thalf[0] = 0; }
    }
    __syncthreads();
}

__device__ __forceinline__ void combine_phase(Frame& F, const Args& a) {
    const int gw = F.vcu * NWAVES + F.wave, NGW = F.G * NWAVES, lane = F.lane;
    const float* X1 = (const float*)(F.ws + WS_X1); const unsigned char* Y = (const unsigned char*)(F.ws + WS_Y);
    const int* TOKE = (const int*)(F.ws + WS_TOKE); const int* TOKR = (const int*)(F.ws + WS_TOKR); const float* TOKW = (const float*)(F.ws + WS_TOKW);
    const float* gf = a.in[17];
    f32x4 gfv[8];
#pragma unroll
    for (int j = 0; j < 8; ++j) gfv[j] = ((const f32x4*)gf)[lane + 64 * j];
    for (int t = gw; t < T; t += NGW) {
        f32x4 v[8]; unsigned yy[4][8];
#pragma unroll
        for (int j = 0; j < 8; ++j) v[j] = __builtin_nontemporal_load((const f32x4*)(X1 + (size_t)t * D) + lane + 64 * j);
        const f32x4 w4 = *(const f32x4*)(TOKW + (size_t)t * 4);
#pragma unroll
        for (int k = 0; k < 4; ++k) { const unsigned* yr = (const unsigned*)(Y + ((size_t)t * 4 + k) * D) + lane;
#pragma unroll
            for (int j = 0; j < 8; ++j) yy[k][j] = __builtin_nontemporal_load(yr + 64 * j); }
#pragma unroll
        for (int k = 0; k < 4; ++k) { const float wq = w4[k] * (1.0f / Y8_SCALE);
#pragma unroll
            for (int j = 0; j < 8; ++j) { const unsigned y = yy[k][j]; const f32x2 lo = __builtin_amdgcn_cvt_pk_f32_fp8((int)y, false), hi = __builtin_amdgcn_cvt_pk_f32_fp8((int)y, true);
                v[j][0] += wq * lo.x; v[j][1] += wq * lo.y; v[j][2] += wq * hi.x; v[j][3] += wq * hi.y; } }
        float s = 0.f;
#pragma unroll
        for (int j = 0; j < 8; ++j) s += (v[j][0] * v[j][0] + v[j][1] * v[j][1]) + (v[j][2] * v[j][2] + v[j][3] * v[j][3]);
        const float rstd = 1.0f / sqrtf(wave_sum(s) * (1.f / D) + EPS);
#pragma unroll
        for (int j = 0; j < 8; ++j) __builtin_nontemporal_store(v[j] * rstd * gfv[j], (f32x4*)(a.out + (size_t)t * D) + lane + 64 * j);
    }
}

__device__ __forceinline__ int reframe(Frame& F) { int t_ = threadIdx.x; asm volatile("" : "+v"(t_)); F.tid = t_; F.lane = t_ & 63; F.wave = __builtin_amdgcn_readfirstlane(t_ >> 6); return 0; }
constexpr int N_PHASES = 12;
__global__ void __launch_bounds__(NTHREADS, 2) mk_fwd(Args args) {
    extern __shared__ __attribute__((aligned(16))) unsigned char lds[];
    Frame F;
    F.lds = (LAS unsigned char*)lds;
    F.tid = threadIdx.x; F.lane = F.tid & 63; F.wave = __builtin_amdgcn_readfirstlane(F.tid >> 6);
    F.G = gridDim.x; { const int bx = blockIdx.x; F.vcu = (F.G % 8 == 0) ? (bx % 8) * (F.G / 8) + bx / 8 : bx; }
    F.ws = args.ws;
    volatile LAS unsigned* MISC = (volatile LAS unsigned*)(F.lds + MISC_OFF);
    for (int u = F.tid; u < (LDS_BYTES - MISC_OFF) / 4; u += NTHREADS) MISC[u] = 0u;
    __syncthreads();
    unsigned* ctl = (unsigned*)(F.ws + WS_CTL);
    XcdBarrier bar; bar.bar = ctl + CW_BAR; bar.x = 0; bar.st = nullptr;
    if (MK_N_LAUNCHES == 1) bar = xcd_barrier_post(ctl + CW_BAR, MISC + 8);
    const int lo = args.ph_lo, hi = args.ph_hi;
#define IN(k) ((((MK_PHASES) >> (k)) & 1) && lo <= (k) && (k) < hi)
#define SEAM(k) do { if (IN(k) && IN((k) + 1)) xcd_barrier(bar); } while (0)
    LAS int* mcnt = (LAS int*)(F.lds + MISC_OFF + 256); LAS int* mtstart = mcnt + 32; LAS int* mtfull = mcnt + 96; LAS int* mtsmall = mcnt + 160; LAS int* mthalf = mcnt + 224;

#define REFRAME() do { int t_ = threadIdx.x; asm volatile("" : "+v"(t_)); F.tid = t_; F.lane = t_ & 63; F.wave = __builtin_amdgcn_readfirstlane(t_ >> 6); } while (0)
#define REP(k) for (int rep_ = reframe(F); rep_ < (((MK_DUP) >> (k)) & 1) + 1; ++rep_)
#define REPBAR(k) do { if ((((MK_DUP) >> (k)) & 1) && rep_ == 0) xcd_barrier(bar); } while (0)
    if (IN(0)) REP(0) { p0_prologue(F, args); if (MK_CONV_IN_P0) conv_rest(F, args, F.vcu * NWAVES + F.wave, F.G * NWAVES); REPBAR(0); } SEAM(0);
    if (IN(1)) REP(1) {
        const int nconv = (MK_NCONV * F.G) / 256, ngemm = F.G - nconv;
        if ((int)blockIdx.x < ngemm) {
            pg8::DenseSched S; S.init((const bf16_t*)(F.ws + WS_H), D, (const bf16_t*)(F.ws + WS_WIN), D, T, INW, ngemm, (int)blockIdx.x);
            EpiInProj E{F.ws};
            if (MK_RSYNC) pg8::gemm_phase<0, EpiInProj, pg8::DenseSched, 127, 127, true>(F.lds, S, E, &bar); else pg8::gemm_phase<0>(F.lds, S, E);
        } else if (!MK_CONV_IN_P0) conv_rest(F, args, ((int)blockIdx.x - ngemm) * NWAVES + F.wave, nconv * NWAVES);
        REPBAR(1);
    } SEAM(1);
    if (IN(2)) REP(2) {
        if (MK_NSCAN == 0) for (int u = blockIdx.x; u < 1024; u += F.G) spatial_unit(F, args, u >> 3, u & 7);
        for (int u = blockIdx.x; u < 1024; u += F.G) kv_unit(F, args, u >> 3, u & 7);
        REPBAR(2);
    } SEAM(2);
    if (IN(3)) REP(3) {
        const int nscan = (MK_NSCAN * F.G) / 256, nsp = F.G - nscan;
        if (MK_NSCAN == 0) scan_phase(F, args, (int)blockIdx.x, F.G);
        else if ((int)blockIdx.x < nsp) { for (int u = blockIdx.x; u < 1024; u += nsp) spatial_unit(F, args, u >> 3, u & 7); }
        else scan_phase(F, args, (int)blockIdx.x - nsp, nscan);
        REPBAR(3);
    } SEAM(3);
    if (IN(4)) REP(4) { for (int u = blockIdx.x; u < 1024; u += F.G) ret_unit(F, args, u >> 3, u & 7); REPBAR(4); } SEAM(4);
    if (IN(5)) REP(5) {
        { pg8::DenseSched S; S.init((const bf16_t*)(F.ws + WS_SG), GW, (const bf16_t*)(F.ws + WS_WPA), GW, T, D, F.G, (int)blockIdx.x); EpiMerge<0> E{F.ws}; pg8::gemm_phase<0>(F.lds, S, E); }
        __syncthreads();
        { pg8::DenseSched S; S.init((const bf16_t*)(F.ws + WS_RO), D, (const bf16_t*)(F.ws + WS_WPR), D, T, D, F.G, (int)blockIdx.x); EpiMerge<1> E{F.ws}; pg8::gemm_phase<0>(F.lds, S, E); }
        REPBAR(5);
    } SEAM(5);
    if (IN(6)) REP(6) {
        pg8::DenseSched S; S.init((const bf16_t*)(F.ws + WS_MRG), D, (const bf16_t*)(F.ws + WS_WOUT), D, T, D, F.G, (int)blockIdx.x);
        EpiOut E{args.in[0], F.ws};
        pg8::gemm_phase<0>(F.lds, S, E); REPBAR(6);
    } SEAM(6);
    if (IN(7)) { REFRAME(); for (int tile = blockIdx.x; tile < T / 64; tile += F.G) router_tile(F, args, tile); } SEAM(7);
#define MOE_SCHED(SV, GATHER_, MODE_, A_, LDA_, BT_, K_, NB_, NN_, TS_) pg8::MoeSched<GATHER_, MODE_> SV; SV.A = (const bf16_t*)(A_); SV.lda = (LDA_); SV.Bt = (const bf16_t*)(BT_); SV.K = (K_); SV.NB = (NB_); SV.nN = (NN_); SV.tstart = (TS_); SV.tall = mtstart; \
        SV.cnt = mcnt; SV.rowtok = (GATHER_) ? (const int*)(F.ws + WS_ROWTOK) : nullptr; SV.aux = F.lds + AUX_OFF; SV.nwg = __builtin_amdgcn_readfirstlane((TS_)[NE]) * (NN_); SV.G = F.G; SV.c = (int)blockIdx.x; SV.ecur = 0
    if (IN(8)) REP(8) {
        moe_table(F, mcnt, mtstart, mtfull, mtsmall, mthalf);
        EpiGateUp E{args.in[14], F.ws};
        if (!MK_HM_TEST) { MOE_SCHED(S, true, 0, F.ws + WS_H, D / 2, F.ws + WS_WGU, D / 2, 4096, 16, mtfull); pg8::gemm_phase<2, EpiGateUp, pg8::MoeSched<true, 0>>(F.lds, S, E); }
        __syncthreads();
        if (MK_HM_TEST) { MOE_SCHED(S, true, 2, F.ws + WS_H, D / 2, F.ws + WS_WGU, D / 2, 4096, 16, mthalf); pg8::gemm_phase<2, EpiGateUp, pg8::MoeSched<true, 2>, 127, 127, false, true>(F.lds, S, E); }
        else if (MK_HM) { MOE_SCHED(S, true, 1, F.ws + WS_H, D / 2, F.ws + WS_WGU, D / 2, 4096, 16, mtsmall); pg8::gemm_phase<2, EpiGateUp, pg8::MoeSched<true, 1>, 127, 127, false, true>(F.lds, S, E); }
        REPBAR(8);
    } SEAM(8);
    if (IN(9)) REP(9) {
        moe_table(F, mcnt, mtstart, mtfull, mtsmall, mthalf);
        EpiDown E{args.in[16], F.ws, mcnt};
        if (!MK_HM_TEST) { MOE_SCHED(S, false, 0, F.ws + WS_ACT, DFF / 2, F.ws + WS_WDN, DFF / 2, 2048, 8, mtfull); pg8::gemm_phase<1, EpiDown, pg8::MoeSched<false, 0>, 117, 125>(F.lds, S, E); }
        __syncthreads();
        if (MK_HM_TEST) { MOE_SCHED(S, false, 2, F.ws + WS_ACT, DFF / 2, F.ws + WS_WDN, DFF / 2, 2048, 8, mthalf); pg8::gemm_phase<1, EpiDown, pg8::MoeSched<false, 2>, 117, 125, false, true>(F.lds, S, E); }
        else if (MK_HM) { MOE_SCHED(S, false, 1, F.ws + WS_ACT, DFF / 2, F.ws + WS_WDN, DFF / 2, 2048, 8, mtsmall); pg8::gemm_phase<1, EpiDown, pg8::MoeSched<false, 1>, 117, 125, false, true>(F.lds, S, E); }
        REPBAR(9);
    } SEAM(9);
#undef MOE_SCHED
    if (IN(10)) REP(10) { combine_phase(F, args); REPBAR(10); }
#undef REP
#undef REFRAME
#undef REPBAR
#undef IN
#undef SEAM
}

#include <cmath>
extern "C" void kernel_launch(void* const* d_in, const int* in_sizes, int n_in, void* d_out, int out_size, void* d_ws, size_t ws_size, hipStream_t stream) {
    static int grid = 0;
    if (grid == 0) {
        if (n_in != 18 || out_size != T * D || ws_size < WS_END) { fprintf(stderr, "kernel_launch: unexpected shapes (n_in %d out %d ws %zu need %zu)\n", n_in, out_size, ws_size, (size_t)WS_END); grid = -1; return; }
        int dev = 0, cus = 0, per_cu = 0;
        if (hipGetDevice(&dev) != hipSuccess || hipDeviceGetAttribute(&cus, hipDeviceAttributeMultiprocessorCount, dev) != hipSuccess) { grid = -1; return; }
        if (hipFuncSetAttribute((const void*)mk_fwd, hipFuncAttributeMaxDynamicSharedMemorySize, LDS_BYTES) != hipSuccess) { fprintf(stderr, "kernel_launch: hipFuncSetAttribute failed\n"); grid = -1; return; }
        if (hipOccupancyMaxActiveBlocksPerMultiprocessor(&per_cu, (const void*)mk_fwd, NTHREADS, LDS_BYTES) != hipSuccess || per_cu < 1) fprintf(stderr, "kernel_launch: occupancy query says %d\n", per_cu);
        (void)hipGetLastError();
        grid = cus;
    }
    if (grid < 0) return;
    (void)hipMemsetAsync((char*)d_ws + WS_CTL, 0, CTL_ZERO_BYTES, stream);
    Args a{};
    for (int i = 0; i < 18; ++i) a.in[i] = (const float*)d_in[i];
    a.out = (float*)d_out; a.ws = (unsigned char*)d_ws;
    for (int h = 0; h < 8; ++h) a.l2g[h] = (float)std::log2(1.0 - std::exp2(-5.0 - (double)h));
#if MK_N_LAUNCHES == 1
    a.ph_lo = 0; a.ph_hi = N_PHASES;
    hipLaunchKernelGGL(mk_fwd, dim3(grid), dim3(NTHREADS), LDS_BYTES, stream, a);
#else
    for (int p = 0; p < 11; ++p) { a.ph_lo = p; a.ph_hi = p + 1; hipLaunchKernelGGL(mk_fwd, dim3(grid), dim3(NTHREADS), LDS_BYTES, stream, a); }
#endif
}
```

```cpp
#include <hip/hip_runtime.h>
#include <cstdio>
#include <cstdint>

#ifndef MK_N_LAUNCHES
#define MK_N_LAUNCHES 1
#endif
#ifndef MK_PHASES
#define MK_PHASES 0xFFFF
#endif
#ifndef MK_NCONV
#define MK_NCONV 64
#endif
#ifndef MK_CONV_IN_P0
#define MK_CONV_IN_P0 0
#endif
#ifndef MK_RSYNC
#define MK_RSYNC 0
#endif
#ifndef MK_NSCAN
#define MK_NSCAN 0
#endif
#ifndef MK_HM
#define MK_HM 1
#endif
#ifndef MK_HM_TEST
#define MK_HM_TEST 0
#endif
#ifndef MK_DUP
#define MK_DUP 0
#endif

#define GAS __attribute__((address_space(1)))
#define LAS __attribute__((address_space(3)))
typedef unsigned short bf16_t;
typedef short bf16x8 __attribute__((ext_vector_type(8)));
typedef short s16x4 __attribute__((ext_vector_type(4)));
typedef float f32x4 __attribute__((ext_vector_type(4)));
typedef float f32x2 __attribute__((ext_vector_type(2)));
typedef float f32x16 __attribute__((ext_vector_type(16)));
typedef unsigned u32x4 __attribute__((ext_vector_type(4)));
typedef unsigned u32x2 __attribute__((ext_vector_type(2)));

constexpr int T = 16384, D = 2048, GW = 1024, QKW = 1024, INW = 12288, NE = 32, DFF = 2048;
constexpr int NCHUNK = 128, NH = 8;
constexpr float EPS = 1e-6f;
constexpr int NWAVES = 8, NTHREADS = 512;
constexpr int ACT_ROWS = 73728;
constexpr float W8_SCALE = 1024.0f, H8_SCALE = 16.0f, A8_SCALE = 4.0f, Y8_SCALE = 32.0f;

constexpr size_t MiB = 1u << 20;
constexpr size_t WS_CTL = 0, CTL_ZERO_BYTES = 1 * MiB;
constexpr size_t WS_WIN = 2 * MiB;
constexpr size_t WS_WPA = WS_WIN + 48 * MiB;
constexpr size_t WS_WPR = WS_WPA + 4 * MiB;
constexpr size_t WS_WOUT = WS_WPR + 8 * MiB;
constexpr size_t WS_WGU = WS_WOUT + 8 * MiB;
constexpr size_t WS_WDN = WS_WGU + 512 * MiB;
constexpr size_t WS_H = WS_WDN + 256 * MiB;
constexpr size_t WS_U = WS_H + 64 * MiB;
constexpr size_t WS_V = WS_U + 32 * MiB;
constexpr size_t WS_Q = WS_V + 32 * MiB;
constexpr size_t WS_K = WS_Q + 32 * MiB;
constexpr size_t WS_RV = WS_K + 32 * MiB;
constexpr size_t WS_RG = WS_RV + 64 * MiB;
constexpr size_t WS_GA = WS_RG + 64 * MiB;
constexpr size_t WS_GR = WS_GA + 64 * MiB;
constexpr size_t WS_VSTAT = WS_GR + 64 * MiB;
constexpr size_t WS_ROPEC = WS_VSTAT + 2 * MiB;
constexpr size_t WS_ROPES = WS_ROPEC + 4 * MiB;
constexpr size_t WS_SG = WS_ROPES + 4 * MiB;
constexpr size_t WS_KV = WS_SG + 32 * MiB;
constexpr size_t WS_ST = WS_KV + 128 * MiB;
constexpr size_t WS_RO = WS_ST + 64 * MiB;
constexpr size_t WS_MRG = WS_RO + 64 * MiB;
constexpr size_t WS_X1 = WS_MRG + 64 * MiB;
constexpr size_t WS_SS = WS_X1 + 128 * MiB;
constexpr size_t WS_TOKE = WS_SS + 2 * MiB;
constexpr size_t WS_TOKR = WS_TOKE + 1 * MiB;
constexpr size_t WS_TOKW = WS_TOKR + 1 * MiB;
constexpr size_t WS_ROWTOK = WS_TOKW + 1 * MiB;
constexpr size_t WS_ACT = WS_ROWTOK + 2 * MiB;
constexpr size_t WS_Y = WS_ACT + 288 * MiB;
constexpr size_t WS_END = WS_Y + 288 * MiB;
constexpr int CW_TMO = 0;
constexpr int CW_BAR = 4096;
constexpr int CW_CNT = 8192;
constexpr int CW_DBG = 12288;

constexpr int RING_BYTES = 131072;
constexpr int AUX_OFF = RING_BYTES;
constexpr int MISC_OFF = AUX_OFF + 12288;
constexpr int LDS_BYTES = 147456;

typedef __bf16 bf16x2_t __attribute__((ext_vector_type(2)));
__device__ __forceinline__ unsigned cvt_pk_bf16(float lo, float hi) { f32x2 v = {lo, hi}; bf16x2_t b = __builtin_convertvector(v, bf16x2_t); return __builtin_bit_cast(unsigned, b); }
__device__ __forceinline__ unsigned pk4_fp8(float a, float b, float c, float d) { int w = 0; w = __builtin_amdgcn_cvt_pk_fp8_f32(a, b, w, false); w = __builtin_amdgcn_cvt_pk_fp8_f32(c, d, w, true); return (unsigned)w; }
__device__ __forceinline__ float bf_lo(unsigned w) { return __uint_as_float(w << 16); }
__device__ __forceinline__ float bf_hi(unsigned w) { return __uint_as_float(w & 0xffff0000u); }
__device__ __forceinline__ float bf2f(bf16_t b) { return __uint_as_float(((unsigned)b) << 16); }
__device__ __forceinline__ float wave_sum(float v) {
#pragma unroll
    for (int o = 1; o < 64; o <<= 1) v += __shfl_xor(v, o);
    return v;
}
__device__ __forceinline__ float sigmoid_f(float x) { return __builtin_amdgcn_rcpf(1.0f + __expf(-x)); }
__device__ __forceinline__ f32x2 gelu_pk(f32x2 v) {
    const f32x2 av = __builtin_elementwise_abs(v), d = av * 0.2316418882f + 1.0f;
    f32x2 t; t.x = __builtin_amdgcn_rcpf(d.x); t.y = __builtin_amdgcn_rcpf(d.y);
    f32x2 q = t * 0.5307027145f + (-0.7265760135f); q = q * t + 0.7107068705f; q = q * t + (-0.142248368f); q = q * t + 0.127414796f; q = q * t;
    const f32x2 s = (v * v) * (-0.72134752044f);
    f32x2 e; e.x = __builtin_amdgcn_exp2f(s.x); e.y = __builtin_amdgcn_exp2f(s.y);
    const f32x2 m = v * (q * e), r = v - m;
    f32x2 o; o.x = v.x < 0.f ? m.x : r.x; o.y = v.y < 0.f ? m.y : r.y; return o;
}
__device__ __forceinline__ f32x4 gelu4(f32x4 v) { f32x2 a = gelu_pk((f32x2){v[0], v[1]}), b = gelu_pk((f32x2){v[2], v[3]}); return (f32x4){a.x, a.y, b.x, b.y}; }

#define XB_TMO      128
#define XB_XCNT(j)  (256  + 64 * (j))
#define XB_XSUB(j)  (1280 + 64 * (j))
#define XB_XGEN(j)  (2304 + 64 * (j))
#define XB_TOP      3328
#define XB_TOPGEN   3392
#define XCD_BAR_WORDS 3456
#define XB_SPIN_CAP (1u << 18)
__device__ __forceinline__ unsigned xb_ld(unsigned* p)              { return __hip_atomic_load(p, __ATOMIC_RELAXED, __HIP_MEMORY_SCOPE_AGENT); }
__device__ __forceinline__ unsigned xb_add(unsigned* p, unsigned v) { return __hip_atomic_fetch_add(p, v, __ATOMIC_RELAXED, __HIP_MEMORY_SCOPE_AGENT); }
__device__ __forceinline__ unsigned xb_xcc_id() { return (unsigned)__builtin_amdgcn_s_getreg((3 << 11) | 20) & 0xFu; }
#define XB_SPIN(cond, bar) do { unsigned _sp = 0; while (cond) { __builtin_amdgcn_s_sleep(1); \
    if ((++_sp & 255u) == 0u) { if (xb_ld(&(bar)[XB_TMO])) break; if (_sp > XB_SPIN_CAP) { atomicAdd(&(bar)[XB_TMO], 1u); break; } } } } while (0)
struct XcdBarrier { unsigned* bar; unsigned x; volatile LAS unsigned* st; };
__device__ __forceinline__ XcdBarrier xcd_barrier_post(unsigned* bar, volatile LAS unsigned* st) {
    XcdBarrier b; b.bar = bar; b.x = xb_xcc_id(); b.st = st;
    if (threadIdx.x == 0) (void)xb_add(&bar[XB_XCNT(b.x)], 1u);
    return b;
}
__device__ __forceinline__ void xcd_barrier_complete(unsigned* bar, unsigned x, unsigned& nloc, unsigned& nx) {
    const unsigned G = gridDim.x * gridDim.y * gridDim.z;
    unsigned sum, cnt, mine, sp = 0u;
    for (;;) {
        sum = 0u; cnt = 0u; mine = 0u;
#pragma unroll
        for (unsigned j = 0; j < 16; ++j) { const unsigned c = xb_ld(&bar[XB_XCNT(j)]); sum += c; cnt += (c > 0u) ? 1u : 0u; mine = (j == x) ? c : mine; }
        if (sum == G) break;
        __builtin_amdgcn_s_sleep(1);
        if ((++sp & 255u) == 0u) { if (xb_ld(&bar[XB_TMO])) break; if (sp > XB_SPIN_CAP) { atomicAdd(&bar[XB_TMO], 1u); break; } }
    }
    nloc = mine > 0u ? mine : 1u; nx = cnt > 0u ? cnt : 1u;
}
__device__ __forceinline__ void xcd_barrier(const XcdBarrier& b) {
    asm volatile("s_waitcnt vmcnt(0)" ::: "memory");
    __syncthreads();
    if (threadIdx.x == 0) {
        unsigned* bar = b.bar;
        __builtin_amdgcn_s_waitcnt(0);
        unsigned nloc = b.st[0], nx = b.st[1];
        if (nloc == 0u) { xcd_barrier_complete(bar, b.x, nloc, nx); b.st[0] = nloc; b.st[1] = nx; }
        const unsigned old = xb_add(&bar[XB_XSUB(b.x)], 1u);
        const unsigned gen = old / nloc;
        if (old + 1u == (gen + 1u) * nloc) {
            __builtin_amdgcn_fence(__ATOMIC_RELEASE, "agent");
            asm volatile("s_waitcnt vmcnt(0)" ::: "memory");
            const unsigned og = xb_add(&bar[XB_TOP], 1u);
            const unsigned tg = og / nx;
            if (og + 1u == (tg + 1u) * nx) xb_add(&bar[XB_TOPGEN], 1u);
            else XB_SPIN(xb_ld(&bar[XB_TOPGEN]) == tg, bar);
            __builtin_amdgcn_fence(__ATOMIC_ACQUIRE, "agent");
            xb_add(&bar[XB_XGEN(b.x)], 1u);
            asm volatile("s_waitcnt vmcnt(0)" ::: "memory");
        } else {
            XB_SPIN(xb_ld(&bar[XB_XGEN(b.x)]) == gen, bar);
            __builtin_amdgcn_fence(__ATOMIC_ACQUIRE, "agent");
            asm volatile("s_waitcnt vmcnt(0)" ::: "memory");
        }
    }
    __syncthreads();
}

namespace pg8 {
constexpr int BM = 256, BK = 64, HALF = 128, HTB = HALF * BK * 2, STAGE_BYTES = 8 * HTB, NXCD = 8, WGM = 4;
__host__ __device__ __forceinline__ int lds_byte(int r, int c) { const int st = (r >> 4) * 2 + (c >> 5), rr = r & 15, cc = c & 31, ob = rr * 64 + cc * 2; return st * 1024 + (ob ^ (((ob >> 9) & 1) << 5)); }
__host__ __device__ __forceinline__ void stage_rc(int b, int& R, int& C) { const int st = b / 1024, sb = b % 1024, swz = sb ^ (((sb >> 9) & 1) << 5); R = (st >> 1) * 16 + swz / 64; C = (st & 1) * 32 + (swz % 64) / 2; }
__host__ __device__ __forceinline__ int perm32(int rho) { const int n = rho >> 4, i = rho & 15; return 8 * (i >> 2) + 4 * n + (i & 3); }

struct Unit { int pm, pn, e, mt, hx; };

struct DenseSched {
    const bf16_t* A; int lda; const bf16_t* Bt; int K; int nM, nN, nwg, G, c;
    static constexpr bool kGather = false;
    __device__ __forceinline__ void init(const bf16_t* A_, int lda_, const bf16_t* Bt_, int K_, int M, int N, int G_, int c_) { A = A_; lda = lda_; Bt = Bt_; K = K_; nM = M / BM; nN = N / BM; nwg = nM * nN; G = G_; c = c_; }
    __device__ __forceinline__ bool next(int i, Unit& u) const {
        const long L = (long)i * G + c; if (L >= nwg) return false;
        int wgid = (int)L; { const int q = nwg / NXCD, r = nwg % NXCD, xcd = wgid % NXCD, off = wgid / NXCD; wgid = (xcd < r ? xcd * (q + 1) : r * (q + 1) + (xcd - r) * q) + off; }
        const int nig = WGM * nN, gid = wgid / nig, fm = gid * WGM, gsz = (nM - fm) < WGM ? (nM - fm) : WGM;
        u.pm = fm + ((wgid % nig) % gsz); u.pn = (wgid % nig) / gsz; u.e = 0; u.mt = u.pm; u.hx = 0; return true;
    }
    __device__ __forceinline__ const char* a_base(const Unit& u) const { return (const char*)A + (size_t)u.pm * BM * lda * 2; }
    __device__ __forceinline__ const char* b_base(const Unit& u) const { return (const char*)Bt + (size_t)u.pn * BM * K * 2; }
    __device__ __forceinline__ void a_offs(const Unit&, const int (&R)[2], const int (&C)[2], unsigned (&off)[2][2]) const {
#pragma unroll
        for (int h = 0; h < 2; ++h)
#pragma unroll
            for (int i = 0; i < 2; ++i) off[h][i] = (unsigned)((h * HALF + R[i]) * lda + C[i]) * 2u;
    }
};
template <bool GATHER, int MODE = 0> struct MoeSched {
    const bf16_t* A; int lda; const bf16_t* Bt; int K; int NB  ; int nN; const LAS int* tstart  ; const LAS int* tall  ; const LAS int* cnt  ; const int* rowtok; LAS unsigned char* aux  ;
    int nwg, G, c; mutable int ecur;
    static constexpr bool kGather = GATHER;
    __device__ __forceinline__ bool next(int i, Unit& u) const {
        const long L = (long)i * G + c; if (L >= nwg) return false;
        int wgid = (int)L; { const int q = nwg / NXCD, r = nwg % NXCD, xcd = wgid % NXCD, off = wgid / NXCD; wgid = (xcd < r ? xcd * (q + 1) : r * (q + 1) + (xcd - r) * q) + off; }
        int e = ecur;
#pragma unroll 1
        while (e < NE - 1 && wgid >= __builtin_amdgcn_readfirstlane(tstart[e + 1]) * nN) ++e;
        ecur = e;
        const int t0 = __builtin_amdgcn_readfirstlane(tstart[e]), t1 = __builtin_amdgcn_readfirstlane(tstart[e + 1]);
        const int local = wgid - t0 * nN, tiles = t1 - t0, idx = local % tiles;
        const int a0 = __builtin_amdgcn_readfirstlane(tall[e]), a1 = __builtin_amdgcn_readfirstlane(tall[e + 1]);
        u.pn = local / tiles; u.e = e;
        if (MODE == 0) { u.mt = idx; u.hx = 0; } else if (MODE == 1) { u.mt = a1 - a0 - 1; u.hx = 0; } else { u.mt = idx >> 1; u.hx = idx & 1; }
        u.pm = a0 + u.mt; return true;
    }
    __device__ __forceinline__ const char* a_base(const Unit& u) const { return GATHER ? (const char*)A : (const char*)A + ((size_t)u.pm * BM + (size_t)u.hx * HALF) * lda * 2; }
    __device__ __forceinline__ const char* b_base(const Unit& u) const { return (const char*)Bt + ((size_t)u.e * NB + (size_t)u.pn * BM) * K * 2; }
    __device__ __forceinline__ void a_tokptrs(const Unit& u, const int (&R)[2], const int* (&gp)[4]) const {
        const int ce = __builtin_amdgcn_readfirstlane(cnt[u.e]);
#pragma unroll
        for (int h = 0; h < 2; ++h)
#pragma unroll
            for (int i = 0; i < 2; ++i) { const int g = u.mt * BM + u.hx * HALF + h * HALF + R[i]; gp[2 * h + i] = rowtok + (size_t)u.e * T + (g < ce ? g : 0); }
    }
    __device__ __forceinline__ void a_offs(const Unit& u, const int (&R)[2], const int (&C)[2], unsigned (&off)[2][2]) const {
        if constexpr (GATHER) {
            const int ce = __builtin_amdgcn_readfirstlane(cnt[u.e]);
#pragma unroll
            for (int h = 0; h < 2; ++h)
#pragma unroll
                for (int i = 0; i < 2; ++i) { const int g = u.mt * BM + u.hx * HALF + h * HALF + R[i]; const int tok = rowtok[u.e * T + (g < ce ? g : 0)] >> 2; off[h][i] = (unsigned)(tok * lda + C[i]) * 2u; }
        } else {
#pragma unroll
            for (int h = 0; h < 2; ++h)
#pragma unroll
                for (int i = 0; i < 2; ++i) off[h][i] = (unsigned)((h * HALF + R[i]) * lda + C[i]) * 2u;
        }
    }
};

__device__ __forceinline__ void glds16(const char* sbase, unsigned voff, unsigned lds_dst) {
    unsigned keep;
    asm volatile("s_mov_b32 %0, m0\n\ts_mov_b32 m0, %3\n\ts_nop 0\n\tglobal_load_lds_dwordx4 %1, %2\n\ts_mov_b32 m0, %0" : "=&s"(keep) : "v"(voff), "s"(sbase), "s"(lds_dst) : "memory");
}
typedef int v8i32 __attribute__((ext_vector_type(8)));
typedef int v4i32 __attribute__((ext_vector_type(4)));
__device__ __forceinline__ v8i32 cat8(bf16x8 a, bf16x8 b) { return __builtin_shufflevector(__builtin_bit_cast(v4i32, a), __builtin_bit_cast(v4i32, b), 0, 1, 2, 3, 4, 5, 6, 7); }
template <int FP8, class Epi, class Sched, int SCW = 127, int SCA = 127, bool RSYNC = false, bool HM = false>
__device__ __forceinline__ void gemm_phase(LAS unsigned char* lds, const Sched& S, const Epi& E, const XcdBarrier* rbar = nullptr) {
    int sclw = SCW * 0x01010101, scla = SCA * 0x01010101; asm volatile("" : "+v"(sclw), "+v"(scla));
    int tid_ = threadIdx.x; asm volatile("" : "+v"(tid_));
    const int tid = tid_, wid = __builtin_amdgcn_readfirstlane(tid >> 6), lane = tid & 63, wr = wid >> 2, wc = wid & 3, fr = lane & 15, fq = lane >> 4;
    const int K = S.K, nt = K / BK;
    unsigned voffB[2];
    { int R[2], C[2];
#pragma unroll
      for (int i = 0; i < 2; ++i) { stage_rc(tid * 16 + i * 8192, R[i], C[i]); voffB[i] = (unsigned)(R[i] * K + C[i]) * 2u; } }
#define PG8_RC() int R[2], C[2]; { int t_ = threadIdx.x; asm volatile("" : "+v"(t_)); _Pragma("unroll") for (int i = 0; i < 2; ++i) stage_rc(t_ * 16 + i * 8192, R[i], C[i]); }
    const size_t kstep = (size_t)(BK * 2);
    const size_t hstepB = (size_t)HALF * K * 2;
    const unsigned ldsbase = (unsigned)__builtin_amdgcn_readfirstlane((int)((unsigned)(size_t)lds + (unsigned)wid * 1024u));
    const int aoff = lds_byte(wr * 64 + fr, fq * 8), boff = lds_byte(wc * 32 + fr, fq * 8);
#define PG8_SA(b, h) (((b) * 2 + (h)) * HTB)
#define PG8_SB(b, h) ((4 + (b) * 2 + (h)) * HTB)
#define PG8_STAGE2(bufoff, gbase, o0, o1) do { glds16((const char*)(gbase), (o0), ldsbase + (unsigned)(bufoff)); glds16((const char*)(gbase), (o1), ldsbase + (unsigned)(bufoff) + 8192u); } while (0)
#define PG8_STAGEB(bufoff, gbase) PG8_STAGE2(bufoff, gbase, voffB[0], voffB[1])
#define PG8_STAGEA(bufoff, gbase, h) PG8_STAGE2(bufoff, gbase, voffA[h][0], voffA[h][1])
#define PG8_STAGEAS(bufoff, gbase, h) PG8_STAGE2(bufoff, gbase, voffA[h][0], voffA[h][1])
#define PG8_LDA(dst, b, h) do { _Pragma("unroll") for (int m = 0; m < 4; ++m) _Pragma("unroll") for (int k = 0; k < 2; ++k) dst[m][k] = *(const LAS bf16x8*)(lds + PG8_SA(b, h) + aoff + m * 2048 + k * 1024); } while (0)
#define PG8_LDB(dst, b, h) do { _Pragma("unroll") for (int n = 0; n < 2; ++n) _Pragma("unroll") for (int k = 0; k < 2; ++k) dst[n][k] = *(const LAS bf16x8*)(lds + PG8_SB(b, h) + boff + n * 2048 + k * 1024); } while (0)
#define PG8_MMA(ai, bj, At, Bt) do { __builtin_amdgcn_s_setprio(1); if constexpr (FP8 == 2) { _Pragma("unroll") for (int m = 0; m < 4; ++m) _Pragma("unroll") for (int n = 0; n < 2; ++n) { \
        const v8i32 wa_ = cat8(Bt[n][0], Bt[n][1]), xa_ = cat8(At[m][0], At[m][1]); \
        asm volatile("s_nop 1\n\tv_mfma_scale_f32_16x16x128_f8f6f4 %0, %1, %2, %0, %3, %4 op_sel_hi:[0,0,0] cbsz:2 blgp:2" : "+v"(acc[ai][bj][m][n]) \
                     : "v"(__builtin_shufflevector(wa_, wa_, 0, 1, 2, 3, 4, 5)), "v"(__builtin_shufflevector(xa_, xa_, 0, 1, 2, 3, 4, 5)), "v"(wa_[6]), "v"(xa_[6])); } } else if constexpr (FP8 == 1) { _Pragma("unroll") for (int m = 0; m < 4; ++m) _Pragma("unroll") for (int n = 0; n < 2; ++n) \
        asm volatile("v_mfma_scale_f32_16x16x128_f8f6f4 %0, %1, %2, %0, %3, %4 op_sel_hi:[0,0,0]" : "+v"(acc[ai][bj][m][n]) : "v"(cat8(Bt[n][0], Bt[n][1])), "v"(cat8(At[m][0], At[m][1])), "v"(sclw), "v"(scla)); } else { \
        _Pragma("unroll") for (int m = 0; m < 4; ++m) _Pragma("unroll") for (int n = 0; n < 2; ++n) _Pragma("unroll") for (int k = 0; k < 2; ++k) \
        acc[ai][bj][m][n] = __builtin_amdgcn_mfma_f32_16x16x32_bf16(Bt[n][k], At[m][k], acc[ai][bj][m][n], 0, 0, 0); } __builtin_amdgcn_s_setprio(0); } while (0)
#define PG8_WAIT_V(n) asm volatile("s_waitcnt vmcnt(" #n ")" ::: "memory")
#define PG8_WAIT_K() do { if constexpr (HM) PG8_WAIT_V(6); else PG8_WAIT_V(8); } while (0)
    constexpr int EST = HM ? Epi::kStoresHM : Epi::kStores;
#define PG8_WAIT_K0() do { if (EST > 0 && t == 0 && ui > 0) asm volatile("s_waitcnt vmcnt(%0)" :: "n"((HM ? 6 : 8) + EST) : "memory"); else PG8_WAIT_K(); } while (0)
#define PG8_WAIT_L(n) asm volatile("s_waitcnt lgkmcnt(" #n ")" ::: "memory")
#define PG8_BAR __builtin_amdgcn_s_barrier()
#define PG8_SCHED __builtin_amdgcn_sched_barrier(0)
    Unit cur, nxt; int ui = 0;
    if (!S.next(0, cur)) return;
    unsigned voffA[2][2];
    { PG8_RC(); S.a_offs(cur, R, C, voffA); }
    f32x4 acc[2][2][4][2];
#pragma unroll
    for (int a = 0; a < 2; ++a)
#pragma unroll
        for (int b = 0; b < 2; ++b)
#pragma unroll
            for (int m = 0; m < 4; ++m)
#pragma unroll
                for (int n = 0; n < 2; ++n) acc[a][b][m][n] = (f32x4){0.f, 0.f, 0.f, 0.f};
    bf16x8 At[4][2], B0[2][2], B1[2][2];
    const char* cA = S.a_base(cur); const char* cB = S.b_base(cur);
    const unsigned bias_lds = (unsigned)__builtin_amdgcn_readfirstlane((int)((unsigned)(size_t)lds + (unsigned)(AUX_OFF + 8192) + (unsigned)wid * 256u));
    if constexpr (Epi::kBiasDMA) { if (lane < 16) glds16(E.bias_base(cur), E.bias_off(cur, wc, lane), bias_lds); }
    const unsigned rowid_lds = (unsigned)__builtin_amdgcn_readfirstlane((int)((unsigned)(size_t)lds + (unsigned)AUX_OFF + (unsigned)wid * 512u));
    if constexpr (Epi::kRowDMA) { if (lane < 32) glds16(E.row_base(cur), E.row_off(cur, wr, lane), rowid_lds); }
    PG8_STAGEB(PG8_SB(0, 0), cB); PG8_STAGEB(PG8_SB(0, 1), cB + hstepB); PG8_STAGEA(PG8_SA(0, 0), cA, 0); if constexpr (!HM) PG8_STAGEA(PG8_SA(0, 1), cA, 1);
    if (wr == 1) PG8_BAR;
    if constexpr (HM) PG8_WAIT_V(0); else PG8_WAIT_V(2);
    PG8_BAR;
    PG8_STAGEB(PG8_SB(1, 0), cB + kstep); PG8_STAGEA(PG8_SA(1, 0), cA + kstep, 0); PG8_STAGEB(PG8_SB(1, 1), cB + hstepB + kstep);
    PG8_WAIT_V(6); PG8_BAR;
    for (;;) {
        const bool has_next = S.next(ui + 1, nxt);
        const char* nA = cA; const char* nB = cB;
        if (has_next) { nA = S.a_base(nxt); nB = S.b_base(nxt); }
        unsigned gtok0 = 0, gtok1 = 0, gtok2 = 0, gtok3 = 0;
        if constexpr (Sched::kGather) {
            if (has_next) { PG8_RC(); const int* gp[4]; S.a_tokptrs(nxt, R, gp);
                asm volatile("global_load_dword %0, %4, off\n\tglobal_load_dword %1, %5, off\n\tglobal_load_dword %2, %6, off\n\tglobal_load_dword %3, %7, off"
                             : "=&v"(gtok0), "=&v"(gtok1), "=&v"(gtok2), "=&v"(gtok3) : "v"(gp[0]), "v"(gp[1]), "v"(gp[2]), "v"(gp[3]) : "memory"); }
        }
        for (int t = 0; t < nt; t += 2) {
            const bool last = (t == nt - 2);
            if constexpr (Sched::kGather) {
                if (t == 2 && has_next) {
                    if constexpr (HM) asm volatile("s_waitcnt vmcnt(12)" : "+v"(gtok0), "+v"(gtok1), "+v"(gtok2), "+v"(gtok3) :: "memory");
                    else asm volatile("s_waitcnt vmcnt(16)" : "+v"(gtok0), "+v"(gtok1), "+v"(gtok2), "+v"(gtok3) :: "memory");
                    PG8_RC(); *(LAS u32x4*)(S.aux + tid * 16) = (u32x4){(unsigned)(((int)gtok0 >> 2) * S.lda + C[0]) * 2u, (unsigned)(((int)gtok1 >> 2) * S.lda + C[1]) * 2u, (unsigned)(((int)gtok2 >> 2) * S.lda + C[0]) * 2u, (unsigned)(((int)gtok3 >> 2) * S.lda + C[1]) * 2u};
                }
            }
            const char* a1 = cA + (size_t)(t + 1) * kstep;
            const char* a2 = last ? nA : cA + (size_t)(t + 2) * kstep; const char* b2 = last ? nB : cB + (size_t)(t + 2) * kstep;
            const char* a3 = a2 + kstep; const char* b3 = b2 + kstep;
            PG8_LDB(B0, 0, 0); PG8_LDB(B1, 0, 1); PG8_SCHED; PG8_LDA(At, 0, 0); if constexpr (!HM) PG8_STAGEA(PG8_SA(1, 1), a1, 1);
            if constexpr (Sched::kGather) { if (last && has_next) { const u32x4 tn = *(const LAS u32x4*)(S.aux + tid * 16); voffA[0][0] = tn.x; voffA[0][1] = tn.y; voffA[1][0] = tn.z; voffA[1][1] = tn.w; } }
            PG8_WAIT_K0(); PG8_WAIT_L(0); PG8_BAR; PG8_MMA(0, 0, At, B0); PG8_MMA(0, 1, At, B1); PG8_BAR; PG8_SCHED;
            if constexpr (!HM) PG8_LDA(At, 0, 1);
            PG8_STAGEB(PG8_SB(0, 0), b2); PG8_STAGEB(PG8_SB(0, 1), b2 + hstepB); PG8_STAGEAS(PG8_SA(0, 0), a2, 0);
            PG8_WAIT_K0(); PG8_WAIT_L(0); PG8_BAR; if constexpr (!HM) { PG8_MMA(1, 0, At, B0); PG8_MMA(1, 1, At, B1); } PG8_BAR; PG8_SCHED;
            PG8_LDB(B0, 1, 0); PG8_LDB(B1, 1, 1); PG8_SCHED; PG8_LDA(At, 1, 0); if constexpr (!HM) PG8_STAGEAS(PG8_SA(0, 1), a2, 1);
            PG8_WAIT_K(); PG8_WAIT_L(0); PG8_BAR; PG8_MMA(0, 0, At, B0); PG8_MMA(0, 1, At, B1); PG8_BAR; PG8_SCHED;
            if constexpr (!HM) PG8_LDA(At, 1, 1);
            PG8_STAGEB(PG8_SB(1, 0), b3); PG8_STAGEB(PG8_SB(1, 1), b3 + hstepB); PG8_STAGEAS(PG8_SA(1, 0), a3, 0);
            PG8_WAIT_K(); PG8_WAIT_L(0); PG8_BAR; if constexpr (!HM) { PG8_MMA(1, 0, At, B0); PG8_MMA(1, 1, At, B1); } PG8_BAR; PG8_SCHED;
        }
        if (wr == 0) PG8_BAR;
        if constexpr (FP8 >= 1) asm volatile("s_nop 15\n\ts_nop 15" ::: "memory");
        if constexpr (Epi::kRowDMA) E(acc, cur, wr, wc, fr, fq, (const LAS float*)(lds + AUX_OFF + 8192 + wid * 256), (const LAS int*)(lds + AUX_OFF + wid * 512), HM ? 1 : 2);
        else if constexpr (Epi::kBiasDMA) E(acc, cur, wr, wc, fr, fq, (const LAS float*)(lds + AUX_OFF + 8192 + wid * 256), HM ? 1 : 2); else E(acc, cur, wr, wc, fr, fq);
        if (!has_next) break;
        if constexpr (RSYNC) xcd_barrier(*rbar);
#pragma unroll
        for (int a = 0; a < 2; ++a)
#pragma unroll
            for (int b = 0; b < 2; ++b)
#pragma unroll
                for (int m = 0; m < 4; ++m)
#pragma unroll
                    for (int n = 0; n < 2; ++n) acc[a][b][m][n] = (f32x4){0.f, 0.f, 0.f, 0.f};
        cur = nxt; cA = nA; cB = nB; ++ui;
        if constexpr (Epi::kBiasDMA) { if (lane < 16) glds16(E.bias_base(cur), E.bias_off(cur, wc, lane), bias_lds); }
        if constexpr (Epi::kRowDMA) { if (lane < 32) glds16(E.row_base(cur), E.row_off(cur, wr, lane), rowid_lds); }
        if (wr == 1) PG8_BAR;
    }
    PG8_WAIT_V(0);
    PG8_BAR;
#undef PG8_SA
#undef PG8_RC
#undef PG8_SB
#undef PG8_STAGE2
#undef PG8_STAGEB
#undef PG8_STAGEA
#undef PG8_STAGEAS
#undef PG8_LDA
#undef PG8_LDB
#undef PG8_MMA
#undef PG8_WAIT_V
#undef PG8_WAIT_K
#undef PG8_WAIT_K0
#undef PG8_WAIT_L
#undef PG8_BAR
#undef PG8_SCHED
}
}

struct Args {
    const float* in[18]; float* out; unsigned char* ws;
    float l2g[8];
    int ph_lo, ph_hi;
};
struct Frame {
    LAS unsigned char* lds;
    int tid, lane, wave, G, vcu;
    unsigned char* ws;
};

enum { CM_NAT = 0, CM_STD = 1, CM_ROPE = 2, CM_SWIGLU = 3, CM_WIN = 4, CM_DN = 5 };
__device__ __forceinline__ int src_col(int mode, int n) {
    if (mode == CM_WIN) mode = (n >= 2048 && n < 4096) ? CM_ROPE : CM_STD;
    if (mode == CM_NAT) return n;
    if (mode == CM_DN) return n;
    if (mode == CM_STD) return (n & ~31) + pg8::perm32(n & 31);
    if (mode == CM_ROPE) { const int p = n & 127, wc = p >> 5, nn = (p >> 4) & 1, i = p & 15; return (n & ~127) + 16 * wc + i + 64 * nn; }
    { const int pn = n >> 8, p = n & 255, bj = p >> 7, g = (p >> 5) & 3, rho = p & 31; return bj * 2048 + 128 * pn + 32 * g + pg8::perm32(rho); }
}
__device__ __forceinline__ int dst_row(int mode, int c) {
    if (mode != CM_DN) return c;
    const int q = c & 255, wc = q >> 6, fq = (q >> 4) & 3, bj = (q >> 3) & 1, nn = (q >> 2) & 1, j = q & 3;
    return (c & ~255) + 128 * bj + 32 * wc + 16 * nn + 4 * fq + j;
}
__device__ __forceinline__ void transpose_item(const float* W, int K, int N, bf16_t* WT, int mode, int item, LAS unsigned* scr, int lane) {
    const int nblk = N / 32, kb = item / nblk, nb = item % nblk, k0 = 64 * kb, n0 = 32 * nb;
    const int g = lane & 7, r = lane >> 3;
    const int sc = src_col(mode, n0 + 4 * g);
    const float* p = W + (size_t)(k0 + 2 * r) * N + sc;
    f32x4 a[4], b[4];
#pragma unroll
    for (int i = 0; i < 4; ++i) { a[i] = *(const f32x4*)(p + (size_t)(16 * i) * N); b[i] = *(const f32x4*)(p + (size_t)(16 * i + 1) * N); }
#pragma unroll
    for (int i = 0; i < 4; ++i)
#pragma unroll
        for (int j = 0; j < 4; ++j) scr[(4 * g + j) * 33 + r + 8 * i] = cvt_pk_bf16(a[i][j], b[i][j]);
    asm volatile("s_waitcnt lgkmcnt(0)" ::: "memory");
    const int c = lane & 7;
#pragma unroll
    for (int ii = 0; ii < 4; ++ii) { const int n = 8 * ii + (lane >> 3); const LAS unsigned* s = scr + n * 33 + 4 * c;
        u32x4 o; o.x = s[0]; o.y = s[1]; o.z = s[2]; o.w = s[3];
        __builtin_nontemporal_store(o, (u32x4*)(WT + (size_t)(n0 + n) * K + k0 + 8 * c)); }
    asm volatile("s_waitcnt lgkmcnt(0)" ::: "memory");
}

typedef float f32x16v __attribute__((ext_vector_type(16)));
typedef unsigned u32x6 __attribute__((ext_vector_type(6)));
#ifndef MK_F6_SCALE_INV
#define MK_F6_SCALE_INV 0
#endif
__device__ __forceinline__ void q6_block(const float (&v)[32], u32x4& lo, u32x4& hi) {
    float amax = 0.f;
#pragma unroll
    for (int t = 0; t < 32; ++t) amax = fmaxf(amax, fabsf(v[t]));
    const unsigned eb = ((__float_as_uint(amax * 0.13333334f) >> 23) & 255u) + 1u;
    const float sc = __uint_as_float(eb << 23);
    f32x16v a, b;
#pragma unroll
    for (int t = 0; t < 16; ++t) { a[t] = v[t]; b[t] = v[16 + t]; }
    const u32x6 q = __builtin_amdgcn_cvt_scalef32_2xpk16_fp6_f32(a, b, MK_F6_SCALE_INV ? __uint_as_float((254u - eb) << 23) : sc);
    lo = (u32x4){q[0], q[1], q[2], q[3]};
    hi = (u32x4){q[4], q[5], eb * 0x01010101u, 0u};
}
__device__ __forceinline__ void t8_load(const float* W, int N, int mode, int item, int lane, f32x4 (&a)[4][4]) {
    const int nblk = N / 32, kb = item / nblk, nb = item % nblk, k0 = 128 * kb, n0 = 32 * nb;
    const int g = lane & 7, r = lane >> 3;
    const float* p = W + (size_t)(k0 + 4 * r) * N + src_col(mode, n0 + 4 * g);
#pragma unroll
    for (int i = 0; i < 4; ++i)
#pragma unroll
        for (int q = 0; q < 4; ++q) a[i][q] = __builtin_nontemporal_load((const f32x4*)(p + (size_t)(32 * i + q) * N));
}
__device__ __forceinline__ void t8_store(const f32x4 (&a)[4][4], int K, int N, unsigned char* WT, int mode, int item, float scale, LAS unsigned* scr, int lane) {
    const int nblk = N / 32, kb = item / nblk, nb = item % nblk, k0 = 128 * kb, n0 = 32 * nb;
    const int g = lane & 7, r = lane >> 3;
#pragma unroll
    for (int i = 0; i < 4; ++i)
#pragma unroll
        for (int j = 0; j < 4; ++j) scr[(4 * g + j) * 33 + r + 8 * i] = pk4_fp8(a[i][0][j] * scale, a[i][1][j] * scale, a[i][2][j] * scale, a[i][3][j] * scale);
    asm volatile("s_waitcnt lgkmcnt(0)" ::: "memory");
    const int c = lane & 7;
#pragma unroll
    for (int ii = 0; ii < 4; ++ii) { const int n = 8 * ii + (lane >> 3); const LAS unsigned* s = scr + n * 33 + 4 * c;
        u32x4 o; o.x = s[0]; o.y = s[1]; o.z = s[2]; o.w = s[3];
        __builtin_nontemporal_store(o, (u32x4*)(WT + (size_t)dst_row(mode, n0 + n) * K + k0 + 16 * c)); }
    asm volatile("s_waitcnt lgkmcnt(0)" ::: "memory");
}
__device__ __forceinline__ void t6_store(const f32x4 (&a)[4][4], int K, int N, unsigned char* WT, int item, LAS float* scr, int lane) {
    const int nblk = N / 32, kbi = item / nblk, nb = item % nblk, k0 = 128 * kbi, n0 = 32 * nb;
    const int g = lane & 7, r = lane >> 3, n = lane & 31, kb = lane >> 5;
    LAS unsigned char* outl = (LAS unsigned char*)(scr + 64 * 36);
#pragma unroll
    for (int h = 0; h < 2; ++h) {
#pragma unroll
        for (int i = 0; i < 2; ++i)
#pragma unroll
            for (int q = 0; q < 4; ++q) *(LAS f32x4*)(scr + (4 * r + 32 * i + q) * 36 + 4 * g) = a[2 * h + i][q];
        asm volatile("s_waitcnt lgkmcnt(0)" ::: "memory");
        float v[32];
#pragma unroll
        for (int t = 0; t < 32; ++t) v[t] = scr[(32 * kb + t) * 36 + n];
        u32x4 lo, hi; q6_block(v, lo, hi);
        *(LAS u32x4*)(outl + n * 144 + 16 * (2 * h + kb)) = lo; *(LAS u32x4*)(outl + n * 144 + 64 + 16 * (2 * h + kb)) = hi;
        asm volatile("s_waitcnt lgkmcnt(0)" ::: "memory");
    }
    const int c = lane & 7;
#pragma unroll
    for (int ii = 0; ii < 4; ++ii) { const int rr = 8 * ii + (lane >> 3);
        const u32x4 o = *(const LAS u32x4*)(outl + rr * 144 + 16 * c);
        __builtin_nontemporal_store(o, (u32x4*)(WT + (size_t)(n0 + rr) * K + k0 + 16 * c)); }
    asm volatile("s_waitcnt lgkmcnt(0)" ::: "memory");
}
template <bool FP6> __device__ __forceinline__ void t8_stream(const float* W, int K, int N, unsigned char* WT, int mode, int items_per_e, int gw, int NGW, LAS unsigned* scr, int lane) {
    const int NIT = NE * items_per_e; const size_t estride = (size_t)K * N;
    f32x4 A[4][4], B[4][4];
#define T8_LD(buf, idx) do { const int i_ = (idx) < NIT ? (idx) : NIT - 1; t8_load(W + (size_t)(i_ / items_per_e) * estride, N, mode, i_ % items_per_e, lane, buf); } while (0)
#define T8_ST(buf, idx) do { if constexpr (FP6) t6_store(buf, K, N, WT + (size_t)((idx) / items_per_e) * estride, (idx) % items_per_e, (LAS float*)scr, lane); else t8_store(buf, K, N, WT + (size_t)((idx) / items_per_e) * estride, mode, (idx) % items_per_e, W8_SCALE, scr, lane); } while (0)
    T8_LD(A, gw);
    for (int it = gw; it < NIT; it += 2 * NGW) {
        T8_LD(B, it + NGW);
        T8_ST(A, it);
        T8_LD(A, it + 2 * NGW);
        if (it + NGW < NIT) T8_ST(B, it + NGW);
    }
#undef T8_LD
#undef T8_ST
}

__device__ __forceinline__ void conv_rest(Frame& F, const Args& a, int gw, int NGW) {
    LAS unsigned* scr = (LAS unsigned*)(F.lds + F.wave * 13824);
    bf16_t* Wpa = (bf16_t*)(F.ws + WS_WPA); bf16_t* Wpr = (bf16_t*)(F.ws + WS_WPR); bf16_t* Wout = (bf16_t*)(F.ws + WS_WOUT);
    unsigned char* Wgu = (unsigned char*)(F.ws + WS_WGU); unsigned char* Wdn = (unsigned char*)(F.ws + WS_WDN);
    constexpr int I_PA = (GW / 64) * (D / 32), I_PR = (D / 64) * (D / 32), I_OUT = I_PR, I_GU1 = (D / 128) * (4096 / 32), I_DN1 = (DFF / 128) * (D / 32);
    constexpr int NITEMS = I_PA + I_PR + I_OUT;
    for (int it = gw; it < NITEMS; it += NGW) {
        int r = it;
        if (r < I_PA) { transpose_item(a.in[7], GW, D, Wpa, CM_STD, r, scr, F.lane); continue; } r -= I_PA;
        if (r < I_PR) { transpose_item(a.in[8], D, D, Wpr, CM_STD, r, scr, F.lane); continue; } r -= I_PR;
        transpose_item(a.in[9], D, D, Wout, CM_NAT, r, scr, F.lane);
    }
    t8_stream<true>(a.in[13], D, 4096, Wgu, CM_SWIGLU, I_GU1, gw, NGW, scr, F.lane);
    t8_stream<false>(a.in[15], DFF, D, Wdn, CM_DN, I_DN1, gw, NGW, scr, F.lane);
}
__device__ __forceinline__ void t16_load(const float* W, int N, int mode, int item, int lane, f32x4 (&a)[4], f32x4 (&b)[4]) {
    const int nblk = N / 32, kb = item / nblk, nb = item % nblk, k0 = 64 * kb, n0 = 32 * nb;
    const int g = lane & 7, r = lane >> 3;
    const float* p = W + (size_t)(k0 + 2 * r) * N + src_col(mode, n0 + 4 * g);
#pragma unroll
    for (int i = 0; i < 4; ++i) { a[i] = __builtin_nontemporal_load((const f32x4*)(p + (size_t)(16 * i) * N)); b[i] = __builtin_nontemporal_load((const f32x4*)(p + (size_t)(16 * i + 1) * N)); }
}
__device__ __forceinline__ void t16_store(const f32x4 (&a)[4], const f32x4 (&b)[4], int K, int N, bf16_t* WT, int item, LAS unsigned* scr, int lane) {
    const int nblk = N / 32, kb = item / nblk, nb = item % nblk, k0 = 64 * kb, n0 = 32 * nb;
    const int g = lane & 7, r = lane >> 3;
#pragma unroll
    for (int i = 0; i < 4; ++i)
#pragma unroll
        for (int j = 0; j < 4; ++j) scr[(4 * g + j) * 33 + r + 8 * i] = cvt_pk_bf16(a[i][j], b[i][j]);
    asm volatile("s_waitcnt lgkmcnt(0)" ::: "memory");
    const int c = lane & 7;
#pragma unroll
    for (int ii = 0; ii < 4; ++ii) { const int n = 8 * ii + (lane >> 3); const LAS unsigned* s = scr + n * 33 + 4 * c;
        u32x4 o; o.x = s[0]; o.y = s[1]; o.z = s[2]; o.w = s[3];
        *(u32x4*)(WT + (size_t)(n0 + n) * K + k0 + 8 * c) = o; }
    asm volatile("s_waitcnt lgkmcnt(0)" ::: "memory");
}
__device__ __forceinline__ void p0_prologue(Frame& F, const Args& a) {
    LAS unsigned* scr = (LAS unsigned*)(F.lds + F.wave * 4352);
    const int gw = F.vcu * NWAVES + F.wave, NGW = F.G * NWAVES;
    bf16_t* Win = (bf16_t*)(F.ws + WS_WIN);
    constexpr int I_IN = (D / 64) * (INW / 32);
    {
        f32x4 A0[4], A1[4], B0[4], B1[4];
        t16_load(a.in[2], INW, CM_WIN, gw < I_IN ? gw : I_IN - 1, F.lane, A0, A1);
        for (int it = gw; it < I_IN; it += 2 * NGW) {
            { const int n1 = it + NGW; t16_load(a.in[2], INW, CM_WIN, n1 < I_IN ? n1 : I_IN - 1, F.lane, B0, B1); }
            t16_store(A0, A1, D, INW, Win, it, scr, F.lane);
            { const int n2 = it + 2 * NGW; t16_load(a.in[2], INW, CM_WIN, n2 < I_IN ? n2 : I_IN - 1, F.lane, A0, A1); }
            if (it + NGW < I_IN) t16_store(B0, B1, D, INW, Win, it + NGW, scr, F.lane);
        }
    }
    const float* x = a.in[0]; const float* g1 = a.in[1]; bf16_t* H = (bf16_t*)(F.ws + WS_H);
    float* rc = (float*)(F.ws + WS_ROPEC); float* rs = (float*)(F.ws + WS_ROPES);
    LAS double* invf = (LAS double*)(F.lds + 40960);
    __syncthreads();
    if (F.tid < 64) invf[F.tid] = exp2(-(double)(2 * F.tid) / 128.0 * 13.287712379549449);
    __syncthreads();
    int ridx = blockIdx.x * NTHREADS + F.tid;
#define ROPE_ENTRY() do { if (ridx < T * 64) { const int pos = ridx >> 6, i_ = ridx & 63; double ang = (double)pos * invf[i_]; const double k_ = rint(ang * 0.15915494309189535); ang = ang - k_ * 6.283185307179586; \
        const float af = (float)ang; rc[ridx] = cosf(af); rs[ridx] = sinf(af); } ridx += F.G * NTHREADS; } while (0)
    {
        f32x4 g1v[8];
#pragma unroll
        for (int j = 0; j < 8; ++j) g1v[j] = ((const f32x4*)g1)[F.lane + 64 * j];
        f32x4 vc[8];
        { const f32x4* xr = (const f32x4*)(x + (size_t)(gw < T ? gw : T - 1) * D) + F.lane;
#pragma unroll
          for (int j = 0; j < 8; ++j) vc[j] = __builtin_nontemporal_load(xr + 64 * j); }
        for (int m = gw; m < T; m += NGW) {
            f32x4 vn[8];
            { const int mn = (m + NGW) < T ? (m + NGW) : T - 1; const f32x4* xr = (const f32x4*)(x + (size_t)mn * D) + F.lane;
#pragma unroll
              for (int j = 0; j < 8; ++j) vn[j] = __builtin_nontemporal_load(xr + 64 * j); }
            float s = 0.f;
#pragma unroll
            for (int j = 0; j < 8; ++j) s += (vc[j].x * vc[j].x + vc[j].y * vc[j].y) + (vc[j].z * vc[j].z + vc[j].w * vc[j].w);
            const float rstd = 1.0f / sqrtf(wave_sum(s) * (1.f / D) + EPS);
            u32x2* o8 = (u32x2*)(H + (size_t)m * D) + F.lane;
#pragma unroll
            for (int j = 0; j < 8; ++j) { const f32x4 g = g1v[j]; u32x2 w; w.x = cvt_pk_bf16(vc[j].x * rstd * g.x, vc[j].y * rstd * g.y); w.y = cvt_pk_bf16(vc[j].z * rstd * g.z, vc[j].w * rstd * g.w); o8[64 * j] = w; }
#pragma unroll
            for (int j = 0; j < 8; ++j) vc[j] = vn[j];
            ROPE_ENTRY();
        }
    }
    while (ridx < T * 64) ROPE_ENTRY();
#undef ROPE_ENTRY
}

typedef f32x4 AccT[2][2][4][2];
struct EpiInProj {
    static constexpr bool kBiasDMA = false; static constexpr bool kRowDMA = false; static constexpr int kStores = 0, kStoresHM = 0;
    unsigned char* ws;
    __device__ __forceinline__ void operator()(const AccT& acc, const pg8::Unit& u, int wr, int wc, int fr, int fq) const {
        const int row0 = u.pm * 256 + wr * 64 + fr; const int pn = u.pn;
        if (pn < 8) {
            bf16_t* dst = (bf16_t*)(ws + (pn < 4 ? WS_U : WS_V)); const int col0 = (pn & 3) * 256 + wc * 32 + 8 * fq;
            float* vstat = (float*)(ws + WS_VSTAT);
#pragma unroll
            for (int ai = 0; ai < 2; ++ai)
#pragma unroll
                for (int m = 0; m < 4; ++m) { const int row = row0 + ai * 128 + m * 16; float s = 0.f, q = 0.f;
#pragma unroll
                    for (int bj = 0; bj < 2; ++bj) { const f32x4 v0 = gelu4(acc[ai][bj][m][0]), v1 = gelu4(acc[ai][bj][m][1]);
                        s += (v0[0] + v0[1]) + (v0[2] + v0[3]) + (v1[0] + v1[1]) + (v1[2] + v1[3]);
                        q += (v0[0] * v0[0] + v0[1] * v0[1]) + (v0[2] * v0[2] + v0[3] * v0[3]) + (v1[0] * v1[0] + v1[1] * v1[1]) + (v1[2] * v1[2] + v1[3] * v1[3]);
                        u32x4 w; w.x = cvt_pk_bf16(v0[0], v0[1]); w.y = cvt_pk_bf16(v0[2], v0[3]); w.z = cvt_pk_bf16(v1[0], v1[1]); w.w = cvt_pk_bf16(v1[2], v1[3]);
                        *(u32x4*)(dst + (size_t)row * GW + col0 + bj * 128) = w; }
                    if (pn >= 4) { s += __shfl_xor(s, 16); s += __shfl_xor(s, 32); q += __shfl_xor(q, 16); q += __shfl_xor(q, 32);
                        if (fq == 0) *(f32x2*)(vstat + (size_t)row * 32 + ((pn - 4) * 4 + wc) * 2) = (f32x2){s, q}; } }
        } else if (pn < 16) {
            bf16_t* dst = (bf16_t*)(ws + (pn < 12 ? WS_Q : WS_K)); const float sc = pn < 12 ? 1.0f : 0.08838834764831845f;
            const float* rc = (const float*)(ws + WS_ROPEC); const float* rs = (const float*)(ws + WS_ROPES);
            const int dd = 16 * wc + 4 * fq;
#pragma unroll
            for (int ai = 0; ai < 2; ++ai) {
                f32x4 cc[4], ss[4];
#pragma unroll
                for (int m = 0; m < 4; ++m) { const int row = row0 + ai * 128 + m * 16; cc[m] = *(const f32x4*)(rc + (size_t)row * 64 + dd); ss[m] = *(const f32x4*)(rs + (size_t)row * 64 + dd); }
#pragma unroll
                for (int m = 0; m < 4; ++m) { const int row = row0 + ai * 128 + m * 16;
                    const f32x4 c = cc[m] * sc, s = ss[m] * sc;
#pragma unroll
                    for (int bj = 0; bj < 2; ++bj) { const f32x4 t1 = acc[ai][bj][m][0], t2 = acc[ai][bj][m][1];
                        const f32x4 o1 = t1 * c - t2 * s, o2 = t2 * c + t1 * s;
                        bf16_t* p = dst + (size_t)row * QKW + (pn & 3) * 256 + bj * 128 + dd;
                        u32x2 w1, w2; w1.x = cvt_pk_bf16(o1[0], o1[1]); w1.y = cvt_pk_bf16(o1[2], o1[3]); w2.x = cvt_pk_bf16(o2[0], o2[1]); w2.y = cvt_pk_bf16(o2[2], o2[3]);
                        if (pn < 12) { __builtin_nontemporal_store(w1, (u32x2*)p); __builtin_nontemporal_store(w2, (u32x2*)(p + 64)); }
                        else { *(u32x2*)p = w1; *(u32x2*)(p + 64) = w2; } } } }
        } else {
            const int kind = (pn - 16) >> 3;
            bf16_t* dst = (bf16_t*)(ws + (kind == 0 ? WS_RV : kind == 1 ? WS_RG : kind == 2 ? WS_GA : WS_GR)); const int col0 = ((pn - 16) & 7) * 256 + wc * 32 + 8 * fq;
#pragma unroll
            for (int ai = 0; ai < 2; ++ai)
#pragma unroll
                for (int m = 0; m < 4; ++m) { const int row = row0 + ai * 128 + m * 16;
#pragma unroll
                    for (int bj = 0; bj < 2; ++bj) { f32x4 v0 = acc[ai][bj][m][0], v1 = acc[ai][bj][m][1];
                        if (kind == 1) {
#pragma unroll
                            for (int j = 0; j < 4; ++j) { v0[j] = v0[j] * sigmoid_f(v0[j]); v1[j] = v1[j] * sigmoid_f(v1[j]); } }
                        else if (kind >= 2) {
#pragma unroll
                            for (int j = 0; j < 4; ++j) { v0[j] = sigmoid_f(v0[j]); v1[j] = sigmoid_f(v1[j]); } }
                        u32x4 w; w.x = cvt_pk_bf16(v0[0], v0[1]); w.y = cvt_pk_bf16(v0[2], v0[3]); w.z = cvt_pk_bf16(v1[0], v1[1]); w.w = cvt_pk_bf16(v1[2], v1[3]);
                        if (kind >= 1) __builtin_nontemporal_store(w, (u32x4*)(dst + (size_t)row * D + col0 + bj * 128));
                        else *(u32x4*)(dst + (size_t)row * D + col0 + bj * 128) = w; } }
        }
    }
};
template <int MODE> struct EpiMerge {
    static constexpr bool kBiasDMA = false; static constexpr bool kRowDMA = false; static constexpr int kStores = 16, kStoresHM = 0;
    unsigned char* ws;
    __device__ __forceinline__ void operator()(const AccT& acc, const pg8::Unit& u, int wr, int wc, int fr, int fq) const {
        const int row0 = u.pm * 256 + wr * 64 + fr, col0 = u.pn * 256 + wc * 32 + 8 * fq;
        const bf16_t* gate = (const bf16_t*)(ws + (MODE == 0 ? WS_GA : WS_GR)); bf16_t* mrg = (bf16_t*)(ws + WS_MRG);
#pragma unroll
        for (int ai = 0; ai < 2; ++ai) {
            u32x4 gg[4][2], pp[4][2];
#pragma unroll
            for (int m = 0; m < 4; ++m)
#pragma unroll
                for (int bj = 0; bj < 2; ++bj) { const size_t ro = (size_t)(row0 + ai * 128 + m * 16) * D + col0 + bj * 128; gg[m][bj] = *(const u32x4*)(gate + ro); if (MODE == 1) pp[m][bj] = *(const u32x4*)(mrg + ro); }
#pragma unroll
            for (int m = 0; m < 4; ++m)
#pragma unroll
                for (int bj = 0; bj < 2; ++bj) { const size_t ro = (size_t)(row0 + ai * 128 + m * 16) * D + col0 + bj * 128; const u32x4 g = gg[m][bj]; const f32x4 v0 = acc[ai][bj][m][0], v1 = acc[ai][bj][m][1];
                    float o[8] = {v0[0] * bf_lo(g.x), v0[1] * bf_hi(g.x), v0[2] * bf_lo(g.y), v0[3] * bf_hi(g.y), v1[0] * bf_lo(g.z), v1[1] * bf_hi(g.z), v1[2] * bf_lo(g.w), v1[3] * bf_hi(g.w)};
                    if (MODE == 1) { const u32x4 p = pp[m][bj];
                        o[0] += bf_lo(p.x); o[1] += bf_hi(p.x); o[2] += bf_lo(p.y); o[3] += bf_hi(p.y); o[4] += bf_lo(p.z); o[5] += bf_hi(p.z); o[6] += bf_lo(p.w); o[7] += bf_hi(p.w); }
                    u32x4 w; w.x = cvt_pk_bf16(o[0], o[1]); w.y = cvt_pk_bf16(o[2], o[3]); w.z = cvt_pk_bf16(o[4], o[5]); w.w = cvt_pk_bf16(o[6], o[7]);
                    *(u32x4*)(mrg + ro) = w; } }
    }
};
struct EpiOut {
    static constexpr bool kBiasDMA = false; static constexpr bool kRowDMA = false; static constexpr int kStores = 32, kStoresHM = 0;
    const float* x; unsigned char* ws;
    __device__ __forceinline__ void operator()(const AccT& acc, const pg8::Unit& u, int wr, int wc, int fr, int fq) const {
        const int row0 = u.pm * 256 + wr * 64 + fr, col0 = u.pn * 256 + wc * 32 + 4 * fq;
        float* x1 = (float*)(ws + WS_X1); float* ss = (float*)(ws + WS_SS);
#pragma unroll
        for (int ai = 0; ai < 2; ++ai) {
            f32x4 xx[4][2][2];
#pragma unroll
            for (int m = 0; m < 4; ++m)
#pragma unroll
                for (int bj = 0; bj < 2; ++bj)
#pragma unroll
                    for (int n = 0; n < 2; ++n) xx[m][bj][n] = *(const f32x4*)(x + (size_t)(row0 + ai * 128 + m * 16) * D + col0 + bj * 128 + n * 16);
#pragma unroll
            for (int m = 0; m < 4; ++m) { const int row = row0 + ai * 128 + m * 16; const size_t ro = (size_t)row * D + col0; float q = 0.f;
#pragma unroll
                for (int bj = 0; bj < 2; ++bj)
#pragma unroll
                    for (int n = 0; n < 2; ++n) { const f32x4 o = xx[m][bj][n] + acc[ai][bj][m][n];
                        q += (o[0] * o[0] + o[1] * o[1]) + (o[2] * o[2] + o[3] * o[3]);
                        *(f32x4*)(x1 + ro + bj * 128 + n * 16) = o; }
                q += __shfl_xor(q, 16); q += __shfl_xor(q, 32);
                if (fq == 0) ss[(size_t)row * 32 + u.pn * 4 + wc] = q; } }
    }
};
struct EpiGateUp {
    static constexpr bool kBiasDMA = true; static constexpr bool kRowDMA = false; static constexpr int kStores = 8, kStoresHM = 4;
    const float* bgu; unsigned char* ws;
    __device__ __forceinline__ const char* bias_base(const pg8::Unit& u) const { return (const char*)(bgu + (size_t)u.e * 4096 + u.pn * 128); }
    __device__ __forceinline__ unsigned bias_off(const pg8::Unit&, int wc, int lane) const { return (unsigned)(((lane >> 3) & 1) * 2048 + wc * 32 + (lane & 7) * 4) * 4u; }
    __device__ __forceinline__ void operator()(const AccT& acc, const pg8::Unit& u, int wr, int wc, int fr, int fq, const LAS float* bl, int nai) const {
        const int row0 = u.pm * 256 + u.hx * 128 + wr * 64 + fr, a0 = u.pn * 128 + wc * 32 + 8 * fq;
        unsigned char* act = (unsigned char*)(ws + WS_ACT);
        const f32x4 bg0 = *(const LAS f32x4*)(bl + 8 * fq), bg1 = *(const LAS f32x4*)(bl + 8 * fq + 4), bu0 = *(const LAS f32x4*)(bl + 32 + 8 * fq), bu1 = *(const LAS f32x4*)(bl + 32 + 8 * fq + 4);
#pragma unroll
        for (int ai = 0; ai < 2; ++ai) if (ai < nai)
#pragma unroll
            for (int m = 0; m < 4; ++m) { const size_t ro = (size_t)(row0 + ai * 128 + m * 16) * DFF + a0; float o[8];
#pragma unroll
                for (int n = 0; n < 2; ++n) {
                    f32x4 g4 = acc[ai][0][m][n] + (n ? bg1 : bg0), u4 = acc[ai][1][m][n] + (n ? bu1 : bu0);
#pragma unroll
                    for (int j = 0; j < 4; ++j) { g4[j] = fminf(g4[j], 7.0f); u4[j] = __builtin_amdgcn_fmed3f(u4[j], -7.0f, 7.0f); }
                    const f32x4 t4 = g4 * (-1.702f * 1.4426950408889634f);
                    f32x4 e4;
#pragma unroll
                    for (int j = 0; j < 4; ++j) e4[j] = __builtin_amdgcn_exp2f(t4[j]);
                    e4 = e4 + 1.0f;
                    f32x4 r4;
#pragma unroll
                    for (int j = 0; j < 4; ++j) r4[j] = __builtin_amdgcn_rcpf(e4[j]);
                    const f32x4 o4 = (u4 * A8_SCALE + A8_SCALE) * (g4 * r4);
#pragma unroll
                    for (int j = 0; j < 4; ++j) o[4 * n + j] = o4[j]; }
                u32x2 w; w.x = pk4_fp8(o[0], o[1], o[2], o[3]); w.y = pk4_fp8(o[4], o[5], o[6], o[7]);
                *(u32x2*)(act + ro) = w; }
    }
};
struct EpiDown {
    static constexpr bool kBiasDMA = true; static constexpr bool kRowDMA = true; static constexpr int kStores = 0, kStoresHM = 0;
    const float* bdn; unsigned char* ws; const LAS int* cnt;
    __device__ __forceinline__ const char* bias_base(const pg8::Unit& u) const { return (const char*)(bdn + (size_t)u.e * D + u.pn * 256); }
    __device__ __forceinline__ unsigned bias_off(const pg8::Unit&, int wc, int lane) const { return (unsigned)(wc * 64 + lane * 4) * 4u; }
    __device__ __forceinline__ const char* row_base(const pg8::Unit& u) const { return (const char*)((const int*)(ws + WS_ROWTOK) + (size_t)u.e * T + u.mt * 256 + u.hx * 128); }
    __device__ __forceinline__ unsigned row_off(const pg8::Unit&, int wr, int lane) const { return (unsigned)(((lane >> 4) & 1) * 128 + wr * 64 + (lane & 15) * 4) * 4u; }
    __device__ __forceinline__ void operator()(const AccT& acc, const pg8::Unit& u, int wr, int wc, int fr, int fq, const LAS float* bl, const LAS int* rid, int nai) const {
        const int col0 = u.pn * 256 + wc * 64 + 16 * fq;
        unsigned char* y = (unsigned char*)(ws + WS_Y);
        const int nvalid = __builtin_amdgcn_readfirstlane(cnt[u.e]) - u.mt * 256;
        f32x4 bv[2][2];
#pragma unroll
        for (int bj = 0; bj < 2; ++bj) { bv[bj][0] = *(const LAS f32x4*)(bl + 16 * fq + 8 * bj) * Y8_SCALE; bv[bj][1] = *(const LAS f32x4*)(bl + 16 * fq + 8 * bj + 4) * Y8_SCALE; }
#pragma unroll
        for (int ai = 0; ai < 2; ++ai) if (ai < nai)
#pragma unroll
            for (int m = 0; m < 4; ++m) { const int rl = u.hx * 128 + ai * 128 + wr * 64 + m * 16 + fr; const int dst = rid[ai * 64 + m * 16 + fr];
                if (rl < nvalid) { const size_t ro = (size_t)dst * D + col0; unsigned wv[4];
#pragma unroll
                    for (int bj = 0; bj < 2; ++bj) { const f32x4 v0 = acc[ai][bj][m][0] * Y8_SCALE + bv[bj][0], v1 = acc[ai][bj][m][1] * Y8_SCALE + bv[bj][1];
                        wv[2 * bj] = pk4_fp8(v0[0], v0[1], v0[2], v0[3]); wv[2 * bj + 1] = pk4_fp8(v1[0], v1[1], v1[2], v1[3]); }
                    *(u32x4*)(y + ro) = (u32x4){wv[0], wv[1], wv[2], wv[3]}; } }
    }
};

__device__ __forceinline__ unsigned off_b(unsigned row, unsigned ch) { return 256u * row + 16u * (ch ^ (((row & 3) << 2) | ((row >> 2) & 3))); }
__device__ __forceinline__ unsigned row_addr16(unsigned lane, unsigned rb, unsigned s) { return off_b((lane & 15) + 16 * rb, 4 * s + (lane >> 4)); }
__device__ __forceinline__ unsigned tr_addr16(unsigned lane, unsigned c, unsigned ks, unsigned t) {
    const unsigned g = lane >> 4, q = (lane & 15) >> 2, p = lane & 3;
    return off_b(32 * ks + 8 * g + 4 * t + q, 2 * c + (p >> 1)) + 8 * (p & 1);
}
__device__ __forceinline__ bf16x8 tr_frag(LAS unsigned char* img, unsigned lane, unsigned c, unsigned ks) {
    const s16x4 a = __builtin_amdgcn_ds_read_tr16_b64_v4i16((LAS s16x4*)(img + tr_addr16(lane, c, ks, 0)));
    const s16x4 b = __builtin_amdgcn_ds_read_tr16_b64_v4i16((LAS s16x4*)(img + tr_addr16(lane, c, ks, 1)));
    return __builtin_shufflevector(a, b, 0, 1, 2, 3, 4, 5, 6, 7);
}
__device__ __forceinline__ bf16x8 row_frag(LAS unsigned char* img, unsigned lane, unsigned rb, unsigned s) { return *(const LAS bf16x8*)(img + row_addr16(lane, rb, s)); }
#define MFMA16(a, b, c) __builtin_amdgcn_mfma_f32_16x16x32_bf16(a, b, c, 0, 0, 0)
__device__ __forceinline__ unsigned row_base(unsigned lane, unsigned s) { return row_addr16(lane, 0, s); }
__device__ __forceinline__ unsigned tr_base(unsigned lane, unsigned c, unsigned t) { return tr_addr16(lane, c, 0, t); }
#define ROWF(img, base, off) (*(const LAS bf16x8*)((img) + (base) + (off)))
__device__ __forceinline__ bf16x8 trf(LAS unsigned char* img, unsigned b0, unsigned b1, unsigned off) {
    const s16x4 a = __builtin_amdgcn_ds_read_tr16_b64_v4i16((LAS s16x4*)(img + b0 + off));
    const s16x4 b = __builtin_amdgcn_ds_read_tr16_b64_v4i16((LAS s16x4*)(img + b1 + off));
    return __builtin_shufflevector(a, b, 0, 1, 2, 3, 4, 5, 6, 7);
}

__device__ __forceinline__ void spatial_unit(Frame& F, const Args& a, int n, int g) {
    LAS unsigned char* Wimg = F.lds; LAS unsigned char* Vimg = F.lds + 32768; LAS float* stats = (LAS float*)(F.lds + 65536);
    const int t0 = n * 128, ch0 = g * 128, tid = F.tid, lane = F.lane, w = F.wave;
    const bf16_t* V = (const bf16_t*)(F.ws + WS_V); const bf16_t* U = (const bf16_t*)(F.ws + WS_U); bf16_t* SG = (bf16_t*)(F.ws + WS_SG);
    const float* vstat = (const float*)(F.ws + WS_VSTAT);
    if (tid < 128) { const f32x4* p = (const f32x4*)(vstat + (size_t)(t0 + tid) * 32); float s = 0.f, q = 0.f;
#pragma unroll
        for (int j = 0; j < 8; ++j) { const f32x4 v = p[j]; s += v[0] + v[2]; q += v[1] + v[3]; }
        const float mean = s * (1.f / GW), var = q * (1.f / GW) - mean * mean;
        stats[2 * tid] = mean; stats[2 * tid + 1] = 1.0f / sqrtf(fmaxf(var, 0.f) + EPS); }
    const float* ws_g = a.in[5] + (size_t)g * 128 * 128;
#pragma unroll
    for (int i = 0; i < 4; ++i) { const int id = tid + 512 * i, t = id >> 4, ch = id & 15;
        const f32x4 x0 = *(const f32x4*)(ws_g + t * 128 + 8 * ch), x1 = *(const f32x4*)(ws_g + t * 128 + 8 * ch + 4);
        float v[8] = {x0[0], x0[1], x0[2], x0[3], x1[0], x1[1], x1[2], x1[3]};
#pragma unroll
        for (int j = 0; j < 8; ++j) v[j] = (8 * ch + j <= t) ? v[j] : 0.f;
        u32x4 o; o.x = cvt_pk_bf16(v[0], v[1]); o.y = cvt_pk_bf16(v[2], v[3]); o.z = cvt_pk_bf16(v[4], v[5]); o.w = cvt_pk_bf16(v[6], v[7]);
        *(LAS u32x4*)(Wimg + off_b(t, ch)) = o; }
    __syncthreads();
    const float* lng = a.in[3]; const float* lnb = a.in[4];
    {
        u32x4 xv[4]; const int ch = tid & 15;
#pragma unroll
        for (int i = 0; i < 4; ++i) xv[i] = __builtin_nontemporal_load((const u32x4*)(V + (size_t)(t0 + (tid >> 4) + 32 * i) * GW + ch0 + 8 * ch));
        const f32x4 g0 = *(const f32x4*)(lng + ch0 + 8 * ch), g1 = *(const f32x4*)(lng + ch0 + 8 * ch + 4), b0 = *(const f32x4*)(lnb + ch0 + 8 * ch), b1 = *(const f32x4*)(lnb + ch0 + 8 * ch + 4);
#pragma unroll
        for (int i = 0; i < 4; ++i) { const int s = (tid >> 4) + 32 * i; const u32x4 x = xv[i];
            const float mean = stats[2 * s], rstd = stats[2 * s + 1];
            float v[8] = {bf_lo(x.x), bf_hi(x.x), bf_lo(x.y), bf_hi(x.y), bf_lo(x.z), bf_hi(x.z), bf_lo(x.w), bf_hi(x.w)};
#pragma unroll
            for (int j = 0; j < 4; ++j) { v[j] = (v[j] - mean) * rstd * g0[j] + b0[j]; v[4 + j] = (v[4 + j] - mean) * rstd * g1[j] + b1[j]; }
            u32x4 o; o.x = cvt_pk_bf16(v[0], v[1]); o.y = cvt_pk_bf16(v[2], v[3]); o.z = cvt_pk_bf16(v[4], v[5]); o.w = cvt_pk_bf16(v[6], v[7]);
            *(LAS u32x4*)(Vimg + off_b(s, ch)) = o; }
    }
    __syncthreads();
    f32x4 acc[8];
#pragma unroll
    for (int c = 0; c < 8; ++c) acc[c] = (f32x4){0.f, 0.f, 0.f, 0.f};
    const int ksmax = w >> 1;
    {
        unsigned vb[8][2];
#pragma unroll
        for (int c = 0; c < 8; ++c) { vb[c][0] = tr_base(lane, c, 0); vb[c][1] = tr_base(lane, c, 1); }
        LAS unsigned char* Wrow = Wimg + 4096 * w;
#pragma unroll
        for (int ks = 0; ks < 4; ++ks) if (ks <= ksmax) {
            const bf16x8 y = ROWF(Wrow, row_base(lane, ks), 0);
            bf16x8 xf[8];
#pragma unroll
            for (int c = 0; c < 8; ++c) xf[c] = trf(Vimg, vb[c][0], vb[c][1], 8192 * ks);
            __builtin_amdgcn_sched_barrier(0);
#pragma unroll
            for (int c = 0; c < 8; ++c) acc[c] = MFMA16(xf[c], y, acc[c]);
            __builtin_amdgcn_sched_barrier(0);
        }
    }
    {
        LAS unsigned char* MT = F.lds + 66560;
        const int t = 16 * w + (lane & 15); const float bias = a.in[6][g * 128 + t];
#pragma unroll
        for (int c = 0; c < 8; ++c) *(LAS f32x4*)(MT + t * 528 + (16 * c + 4 * (lane >> 4)) * 4) = acc[c] + bias;
        __syncthreads();
        u32x4 uu[4];
#pragma unroll
        for (int i = 0; i < 4; ++i) uu[i] = __builtin_nontemporal_load((const u32x4*)(U + (size_t)(t0 + (tid >> 4) + 32 * i) * GW + ch0 + 8 * (tid & 15)));
#pragma unroll
        for (int i = 0; i < 4; ++i) { const int tt = (tid >> 4) + 32 * i, ch = tid & 15;
            const f32x4 m0 = *(const LAS f32x4*)(MT + tt * 528 + ch * 32), m1 = *(const LAS f32x4*)(MT + tt * 528 + ch * 32 + 16);
            const u32x4 u4 = uu[i];
            u32x4 r; r.x = cvt_pk_bf16(bf_lo(u4.x) * m0[0], bf_hi(u4.x) * m0[1]); r.y = cvt_pk_bf16(bf_lo(u4.y) * m0[2], bf_hi(u4.y) * m0[3]);
            r.z = cvt_pk_bf16(bf_lo(u4.z) * m1[0], bf_hi(u4.z) * m1[1]); r.w = cvt_pk_bf16(bf_lo(u4.w) * m1[2], bf_hi(u4.w) * m1[3]);
            *(u32x4*)(SG + (size_t)(t0 + tt) * GW + ch0 + 8 * ch) = r; }
    }
    __syncthreads();
}

__device__ __forceinline__ void kv_unit(Frame& F, const Args& a, int c, int h) {
    LAS unsigned char* Kimg = F.lds; LAS unsigned char* Vimg = F.lds + 32768;
    const int t0 = c * 128, tid = F.tid, lane = F.lane, w = F.wave;
    const bf16_t* Kb = (const bf16_t*)(F.ws + WS_K); const bf16_t* RV = (const bf16_t*)(F.ws + WS_RV); float* KV = (float*)(F.ws + WS_KV);
    const float l2g = a.l2g[h];
    {
        u32x4 kx[4], vx[8];
#pragma unroll
        for (int i = 0; i < 4; ++i) kx[i] = *(const u32x4*)(Kb + (size_t)(t0 + (tid >> 4) + 32 * i) * QKW + h * 128 + 8 * (tid & 15));
#pragma unroll
        for (int i = 0; i < 8; ++i) vx[i] = *(const u32x4*)(RV + (size_t)(t0 + (tid >> 5) + 16 * i) * D + h * 256 + 8 * (tid & 31));
#pragma unroll
        for (int i = 0; i < 4; ++i) *(LAS u32x4*)(Kimg + off_b((tid >> 4) + 32 * i, tid & 15)) = kx[i];
#pragma unroll
        for (int i = 0; i < 8; ++i) { const int s = (tid >> 5) + 16 * i, ch = tid & 31; const u32x4 x = vx[i]; const float z = exp2f((float)(127 - s) * l2g);
            u32x4 o; o.x = cvt_pk_bf16(bf_lo(x.x) * z, bf_hi(x.x) * z); o.y = cvt_pk_bf16(bf_lo(x.y) * z, bf_hi(x.y) * z); o.z = cvt_pk_bf16(bf_lo(x.z) * z, bf_hi(x.z) * z); o.w = cvt_pk_bf16(bf_lo(x.w) * z, bf_hi(x.w) * z);
            *(LAS u32x4*)(Vimg + (ch >> 4) * 32768 + off_b(s, ch & 15)) = o; }
    }
    __syncthreads();
    f32x4 acc[2][8];
#pragma unroll
    for (int j = 0; j < 2; ++j)
#pragma unroll
        for (int cd = 0; cd < 8; ++cd) acc[j][cd] = (f32x4){0.f, 0.f, 0.f, 0.f};
    LAS unsigned char* vi = Vimg + (w >> 2) * 32768; const int cimg = (2 * w) & 7;
    {
        unsigned kb[8][2], vb[2][2];
#pragma unroll
        for (int cd = 0; cd < 8; ++cd) { kb[cd][0] = tr_base(lane, cd, 0); kb[cd][1] = tr_base(lane, cd, 1); }
#pragma unroll
        for (int j = 0; j < 2; ++j) { vb[j][0] = tr_base(lane, cimg + j, 0); vb[j][1] = tr_base(lane, cimg + j, 1); }
#pragma unroll
        for (int ks = 0; ks < 4; ++ks) {
            const bf16x8 y0 = trf(vi, vb[0][0], vb[0][1], 8192 * ks), y1 = trf(vi, vb[1][0], vb[1][1], 8192 * ks);
            bf16x8 xf[8];
#pragma unroll
            for (int cd = 0; cd < 8; ++cd) xf[cd] = trf(Kimg, kb[cd][0], kb[cd][1], 8192 * ks);
            __builtin_amdgcn_sched_barrier(0);
#pragma unroll
            for (int cd = 0; cd < 8; ++cd) { acc[0][cd] = MFMA16(xf[cd], y0, acc[0][cd]); acc[1][cd] = MFMA16(xf[cd], y1, acc[1][cd]); }
            __builtin_amdgcn_sched_barrier(0);
        }
    }
    bf16_t* out = (bf16_t*)KV + (size_t)(c * 8 + h) * 32768;
    __syncthreads();
    LAS unsigned char* KT = F.lds;
#pragma unroll
    for (int j = 0; j < 2; ++j)
#pragma unroll
        for (int cd = 0; cd < 8; ++cd) { const int e = 16 * (2 * w + j) + (lane & 15), d = 16 * cd + 4 * (lane >> 4);
            u32x2 o; o.x = cvt_pk_bf16(acc[j][cd][0], acc[j][cd][1]); o.y = cvt_pk_bf16(acc[j][cd][2], acc[j][cd][3]); *(LAS u32x2*)(KT + e * 272 + d * 2) = o; }
    __syncthreads();
#pragma unroll
    for (int i = 0; i < 8; ++i) { const int id = tid + 512 * i, e = id >> 4, ch = id & 15;
        *(u32x4*)(out + e * 128 + 8 * ch) = *(const LAS u32x4*)(KT + e * 272 + 16 * ch); }
    __syncthreads();
}

__device__ __forceinline__ void scan_phase(Frame& F, const Args& a, int bi, int nb) {
    const unsigned* KV = (const unsigned*)(F.ws + WS_KV); unsigned* ST = (unsigned*)(F.ws + WS_ST);
    for (int pb = bi * NTHREADS; pb < 131072; pb += nb * NTHREADS) {
        const int h = __builtin_amdgcn_readfirstlane(pb >> 14); const unsigned qo = (unsigned)(pb & 16383) + (unsigned)F.tid; const float dh = exp2f(128.0f * a.l2g[h]);
        const unsigned* kvb = KV + (size_t)h * 16384; unsigned* stb = ST + (size_t)h * 16384;
        float s0 = 0.f, s1 = 0.f;
        {
            unsigned kv[NCHUNK];
#pragma unroll
            for (int j = 0; j < NCHUNK; ++j) kv[j] = __builtin_nontemporal_load(kvb + (size_t)j * 131072 + qo);
#pragma unroll
            for (int j = 0; j < NCHUNK; ++j) { (stb + (size_t)j * 131072)[qo] = cvt_pk_bf16(s0, s1); s0 = s0 * dh + bf_lo(kv[j]); s1 = s1 * dh + bf_hi(kv[j]); }
        }
    }
}

__device__ __forceinline__ void ret_unit(Frame& F, const Args& a, int c, int h) {
    LAS unsigned char* Qimg = F.lds; LAS unsigned char* Kimg = F.lds + 32768; LAS unsigned char* Vimg = F.lds + 65536;
    LAS float* part = (LAS float*)(F.lds + AUX_OFF); LAS float* stats = (LAS float*)(F.lds + AUX_OFF + 8192);
    const int t0 = c * 128, tid = F.tid, lane = F.lane, w = F.wave;
    const bf16_t* Qb = (const bf16_t*)(F.ws + WS_Q); const bf16_t* Kb = (const bf16_t*)(F.ws + WS_K); const bf16_t* RV = (const bf16_t*)(F.ws + WS_RV);
    const bf16_t* RG = (const bf16_t*)(F.ws + WS_RG); const bf16_t* ST = (const bf16_t*)(F.ws + WS_ST); bf16_t* RO = (bf16_t*)(F.ws + WS_RO);
    const float l2g = a.l2g[h];
    bf16x8 stf[2][4];
#pragma unroll
    for (int j = 0; j < 2; ++j)
#pragma unroll
        for (int ks = 0; ks < 4; ++ks) stf[j][ks] = __builtin_nontemporal_load((const bf16x8*)(ST + (size_t)(c * 8 + h) * 32768 + (16 * (2 * w + j) + (lane & 15)) * 128 + 32 * ks + 8 * (lane >> 4)));
    {
        u32x4 qx[4], kx[4], vx[8];
#pragma unroll
        for (int i = 0; i < 4; ++i) { const size_t o = (size_t)(t0 + (tid >> 4) + 32 * i) * QKW + h * 128 + 8 * (tid & 15); qx[i] = __builtin_nontemporal_load((const u32x4*)(Qb + o)); kx[i] = __builtin_nontemporal_load((const u32x4*)(Kb + o)); }
#pragma unroll
        for (int i = 0; i < 8; ++i) vx[i] = __builtin_nontemporal_load((const u32x4*)(RV + (size_t)(t0 + (tid >> 5) + 16 * i) * D + h * 256 + 8 * (tid & 31)));
#pragma unroll
        for (int i = 0; i < 4; ++i) { const unsigned o = off_b((tid >> 4) + 32 * i, tid & 15); *(LAS u32x4*)(Qimg + o) = qx[i]; *(LAS u32x4*)(Kimg + o) = kx[i]; }
#pragma unroll
        for (int i = 0; i < 8; ++i) *(LAS u32x4*)(Vimg + ((tid & 31) >> 4) * 32768 + off_b((tid >> 5) + 16 * i, tid & 15)) = vx[i];
    }
    __syncthreads();
    u32x2 pk[8];
    const int csmax = (w | 1);
    unsigned rb4[4];
#pragma unroll
    for (int ks = 0; ks < 4; ++ks) rb4[ks] = row_base(lane, ks);
    {
        bf16x8 yq[4];
#pragma unroll
        for (int ks = 0; ks < 4; ++ks) yq[ks] = ROWF(Qimg + 4096 * w, rb4[ks], 0);
        const int tt = 16 * w + (lane & 15);
#pragma unroll
        for (int cs = 0; cs < 8; ++cs) {
            pk[cs] = (u32x2){0u, 0u};
            if (cs <= csmax) {
                f32x4 sacc = (f32x4){0.f, 0.f, 0.f, 0.f};
                bf16x8 kf[4];
#pragma unroll
                for (int ks = 0; ks < 4; ++ks) kf[ks] = ROWF(Kimg, rb4[ks], 4096 * cs);
                __builtin_amdgcn_sched_barrier(0);
#pragma unroll
                for (int ks = 0; ks < 4; ++ks) sacc = MFMA16(kf[ks], yq[ks], sacc);
                float v[4];
#pragma unroll
                for (int r = 0; r < 4; ++r) { const int ss = 16 * cs + 4 * (lane >> 4) + r; v[r] = (tt >= ss) ? sacc[r] * exp2f((float)(tt - ss) * l2g) : 0.f; }
                pk[cs].x = cvt_pk_bf16(v[0], v[1]); pk[cs].y = cvt_pk_bf16(v[2], v[3]);
            }
        }
    }
    f32x4 acc[2][8];
#pragma unroll
    for (int j = 0; j < 2; ++j)
#pragma unroll
        for (int ct = 0; ct < 8; ++ct) acc[j][ct] = (f32x4){0.f, 0.f, 0.f, 0.f};
#pragma unroll
    for (int ct = 0; ct < 8; ++ct) {
        bf16x8 yy[4];
#pragma unroll
        for (int ks = 0; ks < 4; ++ks) yy[ks] = ROWF(Qimg, rb4[ks], 4096 * ct);
        __builtin_amdgcn_sched_barrier(0);
#pragma unroll
        for (int ks = 0; ks < 4; ++ks) { acc[0][ct] = MFMA16(stf[0][ks], yy[ks], acc[0][ct]); acc[1][ct] = MFMA16(stf[1][ks], yy[ks], acc[1][ct]); }
        const float xi = exp2f((float)(16 * ct + (lane & 15) + 1) * l2g);
        acc[0][ct] *= xi; acc[1][ct] *= xi;
        __builtin_amdgcn_sched_barrier(0);
    }
    __syncthreads();
    LAS unsigned char* Pimg = Kimg;
    {
        const int tt = 16 * w + (lane & 15);
#pragma unroll
        for (int cs = 0; cs < 8; ++cs) if (cs <= csmax) *(LAS u32x2*)(Pimg + off_b(tt, 2 * cs + (lane >> 5)) + 8 * ((lane >> 4) & 1)) = pk[cs];
    }
    __syncthreads();
    {
        LAS unsigned char* vi = Vimg + (w >> 2) * 32768; const int cimg = (2 * w) & 7;
        unsigned vb[2][2];
#pragma unroll
        for (int j = 0; j < 2; ++j) { vb[j][0] = tr_base(lane, cimg + j, 0); vb[j][1] = tr_base(lane, cimg + j, 1); }
        bf16x8 xv[2][4];
#pragma unroll
        for (int ks = 0; ks < 4; ++ks) { xv[0][ks] = trf(vi, vb[0][0], vb[0][1], 8192 * ks); xv[1][ks] = trf(vi, vb[1][0], vb[1][1], 8192 * ks); }
#pragma unroll
        for (int ct = 0; ct < 8; ++ct) {
            bf16x8 yy[4];
#pragma unroll
            for (int ks = 0; ks < 4; ++ks) if (ks <= (ct >> 1)) yy[ks] = ROWF(Pimg, rb4[ks], 4096 * ct);
            __builtin_amdgcn_sched_barrier(0);
#pragma unroll
            for (int ks = 0; ks < 4; ++ks) if (ks <= (ct >> 1)) { acc[0][ct] = MFMA16(xv[0][ks], yy[ks], acc[0][ct]); acc[1][ct] = MFMA16(xv[1][ks], yy[ks], acc[1][ct]); }
            __builtin_amdgcn_sched_barrier(0);
        }
    }
    {
        float s8[8], q8[8];
#pragma unroll
        for (int ct = 0; ct < 8; ++ct) { float s = 0.f, q = 0.f;
#pragma unroll
            for (int j = 0; j < 2; ++j)
#pragma unroll
                for (int r = 0; r < 4; ++r) { const float v = acc[j][ct][r]; s += v; q += v * v; }
            s8[ct] = s; q8[ct] = q; }
        float s16[8], q16[8];
#pragma unroll
        for (int ct = 0; ct < 8; ++ct) { s16[ct] = __shfl_xor(s8[ct], 16); q16[ct] = __shfl_xor(q8[ct], 16); }
        __builtin_amdgcn_sched_barrier(0);
#pragma unroll
        for (int ct = 0; ct < 8; ++ct) { s8[ct] += s16[ct]; q8[ct] += q16[ct]; }
#pragma unroll
        for (int ct = 0; ct < 8; ++ct) { s16[ct] = __shfl_xor(s8[ct], 32); q16[ct] = __shfl_xor(q8[ct], 32); }
        __builtin_amdgcn_sched_barrier(0);
#pragma unroll
        for (int ct = 0; ct < 8; ++ct) { const float s = s8[ct] + s16[ct], q = q8[ct] + q16[ct];
            if ((lane >> 4) == 0) { part[((16 * ct + lane) * 8 + w) * 2] = s; part[((16 * ct + lane) * 8 + w) * 2 + 1] = q; } }
    }
    __syncthreads();
    if (tid < 128) { float s = 0.f, q = 0.f;
#pragma unroll
        for (int j = 0; j < 8; ++j) { s += part[(tid * 8 + j) * 2]; q += part[(tid * 8 + j) * 2 + 1]; }
        const float mean = s * (1.f / 256.f), var = q * (1.f / 256.f) - mean * mean;
        stats[2 * tid] = mean; stats[2 * tid + 1] = 1.0f / sqrtf(fmaxf(var, 0.f) + EPS); }
    __syncthreads();
    {
        LAS unsigned char* OT = F.lds;
#pragma unroll
        for (int ct = 0; ct < 8; ++ct) { const int tt = 16 * ct + (lane & 15); const float mean = stats[2 * tt], rstd = stats[2 * tt + 1];
#pragma unroll
            for (int j = 0; j < 2; ++j) { const f32x4 v = (acc[j][ct] - mean) * rstd; u32x2 r; r.x = cvt_pk_bf16(v[0], v[1]); r.y = cvt_pk_bf16(v[2], v[3]);
                *(LAS u32x2*)(OT + tt * 528 + (16 * (2 * w + j) + 4 * (lane >> 4)) * 2) = r; } }
        __syncthreads();
        u32x4 gx[8];
#pragma unroll
        for (int i = 0; i < 8; ++i) gx[i] = __builtin_nontemporal_load((const u32x4*)(RG + (size_t)(t0 + (tid >> 5) + 16 * i) * D + h * 256 + 8 * (tid & 31)));
#pragma unroll
        for (int i = 0; i < 8; ++i) { const int tt = (tid >> 5) + 16 * i, ch = tid & 31;
            const u32x4 v = *(const LAS u32x4*)(OT + tt * 528 + ch * 16); const u32x4 g = gx[i];
            u32x4 r; r.x = cvt_pk_bf16(bf_lo(v.x) * bf_lo(g.x), bf_hi(v.x) * bf_hi(g.x)); r.y = cvt_pk_bf16(bf_lo(v.y) * bf_lo(g.y), bf_hi(v.y) * bf_hi(g.y));
            r.z = cvt_pk_bf16(bf_lo(v.z) * bf_lo(g.z), bf_hi(v.z) * bf_hi(g.z)); r.w = cvt_pk_bf16(bf_lo(v.w) * bf_lo(g.w), bf_hi(v.w) * bf_hi(g.w));
            *(u32x4*)(RO + (size_t)(t0 + tt) * D + h * 256 + 8 * ch) = r; }
    }
    __syncthreads();
}

__device__ __forceinline__ void router_tile(Frame& F, const Args& a, int tile) {
    LAS float* part = (LAS float*)F.lds;
    LAS int* cntl = (LAS int*)(F.lds + 40960); LAS int* basel = cntl + 32;
    const int tid = F.tid, lane = F.lane, w = F.wave, ts = w & 1, kq = w >> 1, i = lane & 31, kh = lane >> 5;
    const int tok = tile * 64 + 32 * ts + i;
    const float* X1 = (const float*)(F.ws + WS_X1); const float* SS = (const float*)(F.ws + WS_SS); unsigned char* H2 = (unsigned char*)(F.ws + WS_H);
    const float* g2 = a.in[10]; const float* rw = a.in[11]; const float* rb = a.in[12];
    if (tid < 32) cntl[tid] = 0;
    float ssum = 0.f;
#pragma unroll
    for (int j = 0; j < 8; ++j) { const f32x4 v = *(const f32x4*)(SS + (size_t)tok * 32 + 4 * j); ssum += (v[0] + v[1]) + (v[2] + v[3]); }
    const float rstd = 1.0f / sqrtf(ssum * (1.f / D) + EPS);
    f32x16 acc;
#pragma unroll
    for (int r = 0; r < 16; ++r) acc[r] = 0.f;
    LAS float* rwl = (LAS float*)(F.lds + 49152); LAS float* g2l = (LAS float*)(F.lds + 114688);
    { const f32x4 gv = *(const f32x4*)(g2 + 4 * tid); *(LAS f32x4*)(g2l + 4 * tid) = gv; }
    const unsigned rwl_u = (unsigned)__builtin_amdgcn_readfirstlane((int)((unsigned)(size_t)rwl + (unsigned)(kq * 8192 + ts * 4096)));
#define RW_STAGE(p_) do { const char* src_ = (const char*)(rw + (size_t)(512 * kq + 64 * (p_) + 32 * ts) * NE); const unsigned dst_ = rwl_u + (unsigned)(((p_) & 1) * 32768); \
        _Pragma("unroll") for (int j = 0; j < 4; ++j) pg8::glds16(src_, (unsigned)(lane * 16 + j * 1024), dst_ + (unsigned)(j * 1024)); } while (0)
    RW_STAGE(0);
    asm volatile("s_waitcnt vmcnt(0)" ::: "memory");
    {
        f32x4 xc[4]; float avp[16];
#pragma unroll
        for (int q = 0; q < 16; ++q) avp[q] = 0.f;
#define RT_LOAD(sc_, X) do { const int kb_ = 512 * kq + 64 * ((sc_) >> 1) + 32 * kh + 16 * ((sc_) & 1); \
            _Pragma("unroll") for (int q = 0; q < 4; ++q) X[q] = *(const f32x4*)(X1 + (size_t)tok * D + kb_ + 4 * q); } while (0)
        RT_LOAD(0, xc);
#pragma unroll 1
        for (int sc = 0; sc < 16; ++sc) {
            if ((sc & 1) == 0) {
                asm volatile("s_waitcnt lgkmcnt(0)" ::: "memory"); __builtin_amdgcn_s_barrier(); asm volatile("" ::: "memory");
                if (sc < 14) RW_STAGE((sc >> 1) + 1); }
            const int kb = 512 * kq + 64 * (sc >> 1) + 32 * kh + 16 * (sc & 1);
            f32x4 xn[4];
            { const int sn = sc < 15 ? sc + 1 : 15; RT_LOAD(sn, xn); }
            f32x4 gc[4]; float bc[16];
#pragma unroll
            for (int q = 0; q < 4; ++q) gc[q] = *(const LAS f32x4*)(g2l + kb + 4 * q);
            { const LAS float* rwb = rwl + ((sc >> 1) & 1) * 8192 + kq * 2048 + (32 * kh + 16 * (sc & 1)) * 32 + i;
#pragma unroll
              for (int q = 0; q < 16; ++q) bc[q] = rwb[q * 32]; }
            float av[16];
#pragma unroll
            for (int q = 0; q < 4; ++q) { av[4 * q] = xc[q][0] * rstd * gc[q][0]; av[4 * q + 1] = xc[q][1] * rstd * gc[q][1]; av[4 * q + 2] = xc[q][2] * rstd * gc[q][2]; av[4 * q + 3] = xc[q][3] * rstd * gc[q][3]; }
            if (sc & 1) {
                float v32[32];
#pragma unroll
                for (int q = 0; q < 16; ++q) { v32[q] = avp[q]; v32[16 + q] = av[q]; }
                u32x4 lo, hi; q6_block(v32, lo, hi);
                const int k0 = kb - 16, b32 = k0 >> 5;
                unsigned char* base = H2 + (size_t)tok * D + 128 * (b32 >> 2) + 16 * (b32 & 3);
                *(u32x4*)base = lo; *(u32x4*)(base + 64) = hi;
            }
#pragma unroll
            for (int q = 0; q < 16; ++q) avp[q] = av[q];
#pragma unroll
            for (int q = 0; q < 16; ++q) acc = __builtin_amdgcn_mfma_f32_32x32x2f32(av[q], bc[q], acc, 0, 0, 0);
#pragma unroll
            for (int q = 0; q < 4; ++q) xc[q] = xn[q];
        }
#undef RT_LOAD
#undef RW_STAGE
    }
#pragma unroll
    for (int r = 0; r < 16; ++r) { const int row = (r & 3) + 8 * (r >> 2) + 4 * kh; part[((kq * 2 + ts) * 32 + row) * 33 + i] = acc[r]; }
    __syncthreads();
    int te[4] = {0, 0, 0, 0}; float tv[4] = {-3.0e38f, -3.0e38f, -3.0e38f, -3.0e38f}; int lr[4] = {0, 0, 0, 0};
    if (tid < 64) {
        const int tsl = tid >> 5, rowl = tid & 31;
        for (int e = 0; e < NE; ++e) {
            float lg = rb[e];
#pragma unroll
            for (int q = 0; q < 4; ++q) lg += part[((q * 2 + tsl) * 32 + rowl) * 33 + e];
            if (lg > tv[3]) { tv[3] = lg; te[3] = e;
#pragma unroll
                for (int j = 3; j > 0; --j) if (tv[j] > tv[j - 1]) { const float fv = tv[j]; tv[j] = tv[j - 1]; tv[j - 1] = fv; const int iv = te[j]; te[j] = te[j - 1]; te[j - 1] = iv; } }
        }
#pragma unroll
        for (int k = 0; k < 4; ++k) lr[k] = __hip_atomic_fetch_add(&cntl[te[k]], 1, __ATOMIC_RELAXED, __HIP_MEMORY_SCOPE_WORKGROUP);
    }
    __syncthreads();
    if (tid < 32) { const int cn = cntl[tid]; int base = 0; if (cn > 0) base = (int)__hip_atomic_fetch_add((unsigned*)(F.ws + WS_CTL) + CW_CNT + 16 * tid, (unsigned)cn, __ATOMIC_RELAXED, __HIP_MEMORY_SCOPE_AGENT); basel[tid] = base; }
    __syncthreads();
    if (tid < 64) {
        const int t = tile * 64 + tid;
        int* TOKE = (int*)(F.ws + WS_TOKE); int* TOKR = (int*)(F.ws + WS_TOKR); float* TOKW = (float*)(F.ws + WS_TOKW); int* ROWTOK = (int*)(F.ws + WS_ROWTOK);
        float ex[4], sum = 0.f;
#pragma unroll
        for (int k = 0; k < 4; ++k) { ex[k] = __expf(tv[k] - tv[0]); sum += ex[k]; }
        const float inv = 1.0f / sum;
#pragma unroll
        for (int k = 0; k < 4; ++k) { const int rank = basel[te[k]] + lr[k]; TOKE[t * 4 + k] = te[k]; TOKR[t * 4 + k] = rank; TOKW[t * 4 + k] = ex[k] * inv; ROWTOK[te[k] * T + rank] = t * 4 + k; }
    }
    __syncthreads();
}

__device__ __forceinline__ void moe_table(Frame& F, LAS int* cnt, LAS int* tall, LAS int* tfull, LAS int* tsmall, LAS int* thalf) {
    if (F.tid < 64) {
        const int e = F.lane; int c = 0;
        if (e < NE) c = (int)__hip_atomic_load((unsigned*)(F.ws + WS_CTL) + CW_CNT + 16 * e, __ATOMIC_RELAXED, __HIP_MEMORY_SCOPE_AGENT);
        const int tl = (c + 255) >> 8; const int rem = c - 256 * (tl - 1); const int sm = (MK_HM && tl > 0 && rem <= 128) ? 1 : 0;
        int ia = tl, is = sm;
#pragma unroll
        for (int o = 1; o < 32; o <<= 1) { const int va = __shfl_up(ia, o), vs = __shfl_up(is, o); if ((F.lane & 31) >= o) { ia += va; is += vs; } }
        if (e < NE) { cnt[e] = c; tall[e + 1] = ia; tsmall[e + 1] = is; tfull[e + 1] = ia - is; thalf[e + 1] = 2 * ia; }
        if (e == 0) { tall[0] = 0; tsmall[0] = 0; tfull[0] = 0; thalf[0] = 0; }
    }
    __syncthreads();
}

__device__ __forceinline__ void combine_phase(Frame& F, const Args& a) {
    const int gw = F.vcu * NWAVES + F.wave, NGW = F.G * NWAVES, lane = F.lane;
    const float* X1 = (const float*)(F.ws + WS_X1); const unsigned char* Y = (const unsigned char*)(F.ws + WS_Y);
    const int* TOKE = (const int*)(F.ws + WS_TOKE); const int* TOKR = (const int*)(F.ws + WS_TOKR); const float* TOKW = (const float*)(F.ws + WS_TOKW);
    const float* gf = a.in[17];
    f32x4 gfv[8];
#pragma unroll
    for (int j = 0; j < 8; ++j) gfv[j] = ((const f32x4*)gf)[lane + 64 * j];
    for (int t = gw; t < T; t += NGW) {
        f32x4 v[8]; unsigned yy[4][8];
#pragma unroll
        for (int j = 0; j < 8; ++j) v[j] = __builtin_nontemporal_load((const f32x4*)(X1 + (size_t)t * D) + lane + 64 * j);
        const f32x4 w4 = *(const f32x4*)(TOKW + (size_t)t * 4);
#pragma unroll
        for (int k = 0; k < 4; ++k) { const unsigned* yr = (const unsigned*)(Y + ((size_t)t * 4 + k) * D) + lane;
#pragma unroll
            for (int j = 0; j < 8; ++j) yy[k][j] = __builtin_nontemporal_load(yr + 64 * j); }
#pragma unroll
        for (int k = 0; k < 4; ++k) { const float wq = w4[k] * (1.0f / Y8_SCALE);
#pragma unroll
            for (int j = 0; j < 8; ++j) { const unsigned y = yy[k][j]; const f32x2 lo = __builtin_amdgcn_cvt_pk_f32_fp8((int)y, false), hi = __builtin_amdgcn_cvt_pk_f32_fp8((int)y, true);
                v[j][0] += wq * lo.x; v[j][1] += wq * lo.y; v[j][2] += wq * hi.x; v[j][3] += wq * hi.y; } }
        float s = 0.f;
#pragma unroll
        for (int j = 0; j < 8; ++j) s += (v[j][0] * v[j][0] + v[j][1] * v[j][1]) + (v[j][2] * v[j][2] + v[j][3] * v[j][3]);
        const float rstd = 1.0f / sqrtf(wave_sum(s) * (1.f / D) + EPS);
#pragma unroll
        for (int j = 0; j < 8; ++j) __builtin_nontemporal_store(v[j] * rstd * gfv[j], (f32x4*)(a.out + (size_t)t * D) + lane + 64 * j);
    }
}

__device__ __forceinline__ int reframe(Frame& F) { int t_ = threadIdx.x; asm volatile("" : "+v"(t_)); F.tid = t_; F.lane = t_ & 63; F.wave = __builtin_amdgcn_readfirstlane(t_ >> 6); return 0; }
constexpr int N_PHASES = 12;
__global__ void __launch_bounds__(NTHREADS, 2) mk_fwd(Args args) {
    extern __shared__ __attribute__((aligned(16))) unsigned char lds[];
    Frame F;
    F.lds = (LAS unsigned char*)lds;
    F.tid = threadIdx.x; F.lane = F.tid & 63; F.wave = __builtin_amdgcn_readfirstlane(F.tid >> 6);
    F.G = gridDim.x; { const int bx = blockIdx.x; F.vcu = (F.G % 8 == 0) ? (bx % 8) * (F.G / 8) + bx / 8 : bx; }
    F.ws = args.ws;
    volatile LAS unsigned* MISC = (volatile LAS unsigned*)(F.lds + MISC_OFF);
    for (int u = F.tid; u < (LDS_BYTES - MISC_OFF) / 4; u += NTHREADS) MISC[u] = 0u;
    __syncthreads();
    unsigned* ctl = (unsigned*)(F.ws + WS_CTL);
    XcdBarrier bar; bar.bar = ctl + CW_BAR; bar.x = 0; bar.st = nullptr;
    if (MK_N_LAUNCHES == 1) bar = xcd_barrier_post(ctl + CW_BAR, MISC + 8);
    const int lo = args.ph_lo, hi = args.ph_hi;
#define IN(k) ((((MK_PHASES) >> (k)) & 1) && lo <= (k) && (k) < hi)
#define SEAM(k) do { if (IN(k) && IN((k) + 1)) xcd_barrier(bar); } while (0)
    LAS int* mcnt = (LAS int*)(F.lds + MISC_OFF + 256); LAS int* mtstart = mcnt + 32; LAS int* mtfull = mcnt + 96; LAS int* mtsmall = mcnt + 160; LAS int* mthalf = mcnt + 224;

#define REFRAME() do { int t_ = threadIdx.x; asm volatile("" : "+v"(t_)); F.tid = t_; F.lane = t_ & 63; F.wave = __builtin_amdgcn_readfirstlane(t_ >> 6); } while (0)
#define REP(k) for (int rep_ = reframe(F); rep_ < (((MK_DUP) >> (k)) & 1) + 1; ++rep_)
#define REPBAR(k) do { if ((((MK_DUP) >> (k)) & 1) && rep_ == 0) xcd_barrier(bar); } while (0)
    if (IN(0)) REP(0) { p0_prologue(F, args); if (MK_CONV_IN_P0) conv_rest(F, args, F.vcu * NWAVES + F.wave, F.G * NWAVES); REPBAR(0); } SEAM(0);
    if (IN(1)) REP(1) {
        const int nconv = (MK_NCONV * F.G) / 256, ngemm = F.G - nconv;
        if ((int)blockIdx.x < ngemm) {
            pg8::DenseSched S; S.init((const bf16_t*)(F.ws + WS_H), D, (const bf16_t*)(F.ws + WS_WIN), D, T, INW, ngemm, (int)blockIdx.x);
            EpiInProj E{F.ws};
            if (MK_RSYNC) pg8::gemm_phase<0, EpiInProj, pg8::DenseSched, 127, 127, true>(F.lds, S, E, &bar); else pg8::gemm_phase<0>(F.lds, S, E);
        } else if (!MK_CONV_IN_P0) conv_rest(F, args, ((int)blockIdx.x - ngemm) * NWAVES + F.wave, nconv * NWAVES);
        REPBAR(1);
    } SEAM(1);
    if (IN(2)) REP(2) {
        if (MK_NSCAN == 0) for (int u = blockIdx.x; u < 1024; u += F.G) spatial_unit(F, args, u >> 3, u & 7);
        for (int u = blockIdx.x; u < 1024; u += F.G) kv_unit(F, args, u >> 3, u & 7);
        REPBAR(2);
    } SEAM(2);
    if (IN(3)) REP(3) {
        const int nscan = (MK_NSCAN * F.G) / 256, nsp = F.G - nscan;
        if (MK_NSCAN == 0) scan_phase(F, args, (int)blockIdx.x, F.G);
        else if ((int)blockIdx.x < nsp) { for (int u = blockIdx.x; u < 1024; u += nsp) spatial_unit(F, args, u >> 3, u & 7); }
        else scan_phase(F, args, (int)blockIdx.x - nsp, nscan);
        REPBAR(3);
    } SEAM(3);
    if (IN(4)) REP(4) { for (int u = blockIdx.x; u < 1024; u += F.G) ret_unit(F, args, u >> 3, u & 7); REPBAR(4); } SEAM(4);
    if (IN(5)) REP(5) {
        { pg8::DenseSched S; S.init((const bf16_t*)(F.ws + WS_SG), GW, (const bf16_t*)(F.ws + WS_WPA), GW, T, D, F.G, (int)blockIdx.x); EpiMerge<0> E{F.ws}; pg8::gemm_phase<0>(F.lds, S, E); }
        __syncthreads();
        { pg8::DenseSched S; S.init((const bf16_t*)(F.ws + WS_RO), D, (const bf16_t*)(F.ws + WS_WPR), D, T, D, F.G, (int)blockIdx.x); EpiMerge<1> E{F.ws}; pg8::gemm_phase<0>(F.lds, S, E); }
        REPBAR(5);
    } SEAM(5);
    if (IN(6)) REP(6) {
        pg8::DenseSched S; S.init((const bf16_t*)(F.ws + WS_MRG), D, (const bf16_t*)(F.ws + WS_WOUT), D, T, D, F.G, (int)blockIdx.x);
        EpiOut E{args.in[0], F.ws};
        pg8::gemm_phase<0>(F.lds, S, E); REPBAR(6);
    } SEAM(6);
    if (IN(7)) { REFRAME(); for (int tile = blockIdx.x; tile < T / 64; tile += F.G) router_tile(F, args, tile); } SEAM(7);
#define MOE_SCHED(SV, GATHER_, MODE_, A_, LDA_, BT_, K_, NB_, NN_, TS_) pg8::MoeSched<GATHER_, MODE_> SV; SV.A = (const bf16_t*)(A_); SV.lda = (LDA_); SV.Bt = (const bf16_t*)(BT_); SV.K = (K_); SV.NB = (NB_); SV.nN = (NN_); SV.tstart = (TS_); SV.tall = mtstart; \
        SV.cnt = mcnt; SV.rowtok = (GATHER_) ? (const int*)(F.ws + WS_ROWTOK) : nullptr; SV.aux = F.lds + AUX_OFF; SV.nwg = __builtin_amdgcn_readfirstlane((TS_)[NE]) * (NN_); SV.G = F.G; SV.c = (int)blockIdx.x; SV.ecur = 0
    if (IN(8)) REP(8) {
        moe_table(F, mcnt, mtstart, mtfull, mtsmall, mthalf);
        EpiGateUp E{args.in[14], F.ws};
        if (!MK_HM_TEST) { MOE_SCHED(S, true, 0, F.ws + WS_H, D / 2, F.ws + WS_WGU, D / 2, 4096, 16, mtfull); pg8::gemm_phase<2, EpiGateUp, pg8::MoeSched<true, 0>>(F.lds, S, E); }
        __syncthreads();
        if (MK_HM_TEST) { MOE_SCHED(S, true, 2, F.ws + WS_H, D / 2, F.ws + WS_WGU, D / 2, 4096, 16, mthalf); pg8::gemm_phase<2, EpiGateUp, pg8::MoeSched<true, 2>, 127, 127, false, true>(F.lds, S, E); }
        else if (MK_HM) { MOE_SCHED(S, true, 1, F.ws + WS_H, D / 2, F.ws + WS_WGU, D / 2, 4096, 16, mtsmall); pg8::gemm_phase<2, EpiGateUp, pg8::MoeSched<true, 1>, 127, 127, false, true>(F.lds, S, E); }
        REPBAR(8);
    } SEAM(8);
    if (IN(9)) REP(9) {
        moe_table(F, mcnt, mtstart, mtfull, mtsmall, mthalf);
        EpiDown E{args.in[16], F.ws, mcnt};
        if (!MK_HM_TEST) { MOE_SCHED(S, false, 0, F.ws + WS_ACT, DFF / 2, F.ws + WS_WDN, DFF / 2, 2048, 8, mtfull); pg8::gemm_phase<1, EpiDown, pg8::MoeSched<false, 0>, 117, 125>(F.lds, S, E); }
        __syncthreads();
        if (MK_HM_TEST) { MOE_SCHED(S, false, 2, F.ws + WS_ACT, DFF / 2, F.ws + WS_WDN, DFF / 2, 2048, 8, mthalf); pg8::gemm_phase<1, EpiDown, pg8::MoeSched<false, 2>, 117, 125, false, true>(F.lds, S, E); }
        else if (MK_HM) { MOE_SCHED(S, false, 1, F.ws + WS_ACT, DFF / 2, F.ws + WS_WDN, DFF / 2, 2048, 8, mtsmall); pg8::gemm_phase<1, EpiDown, pg8::MoeSched<false, 1>, 117, 125, false, true>(F.lds, S, E); }
        REPBAR(9);
    } SEAM(9);
#undef MOE_SCHED
    if (IN(10)) REP(10) { combine_phase(F, args); REPBAR(10); }
#undef REP
#undef REFRAME
#undef REPBAR
#undef IN
#undef SEAM
}

#include <cmath>
extern "C" void kernel_launch(void* const* d_in, const int* in_sizes, int n_in, void* d_out, int out_size, void* d_ws, size_t ws_size, hipStream_t stream) {
    static int grid = 0;
    if (grid == 0) {
        if (n_in != 18 || out_size != T * D || ws_size < WS_END) { fprintf(stderr, "kernel_launch: unexpected shapes (n_in %d out %d ws %zu need %zu)\n", n_in, out_size, ws_size, (size_t)WS_END); grid = -1; return; }
        int dev = 0, cus = 0, per_cu = 0;
        if (hipGetDevice(&dev) != hipSuccess || hipDeviceGetAttribute(&cus, hipDeviceAttributeMultiprocessorCount, dev) != hipSuccess) { grid = -1; return; }
        if (hipFuncSetAttribute((const void*)mk_fwd, hipFuncAttributeMaxDynamicSharedMemorySize, LDS_BYTES) != hipSuccess) { fprintf(stderr, "kernel_launch: hipFuncSetAttribute failed\n"); grid = -1; return; }
        if (hipOccupancyMaxActiveBlocksPerMultiprocessor(&per_cu, (const void*)mk_fwd, NTHREADS, LDS_BYTES) != hipSuccess || per_cu < 1) fprintf(stderr, "kernel_launch: occupancy query says %d\n", per_cu);
        (void)hipGetLastError();
        grid = cus;
    }
    if (grid < 0) return;
    (void)hipMemsetAsync((char*)d_ws + WS_CTL, 0, CTL_ZERO_BYTES, stream);
    Args a{};
    for (int i = 0; i < 18; ++i) a.in[i] = (const float*)d_in[i];
    a.out = (float*)d_out; a.ws = (unsigned char*)d_ws;
    for (int h = 0; h < 8; ++h) a.l2g[h] = (float)std::log2(1.0 - std::exp2(-5.0 - (double)h));
#if MK_N_LAUNCHES == 1
    a.ph_lo = 0; a.ph_hi = N_PHASES;
    hipLaunchKernelGGL(mk_fwd, dim3(grid), dim3(NTHREADS), LDS_BYTES, stream, a);
#else
    for (int p = 0; p < 11; ++p) { a.ph_lo = p; a.ph_hi = p + 1; hipLaunchKernelGGL(mk_fwd, dim3(grid), dim3(NTHREADS), LDS_BYTES, stream, a); }
#endif
}
```
